# Optimizing an MI355X kernel written in HIP

```python
import math
import jax
import jax.numpy as jnp
from jax import lax
import numpy as np

D_MODEL = 2048
BATCH = 2
SEQ = 4096
DEPTH = 2

HEAD_DIM = 128
DILATION_PATTERNS = ((128, 1), (512, 4), (2048, 16))
N_ATTN_GROUPS = len(DILATION_PATTERNS)
ATTN_WIDTH = 3 * D_MODEL // 4
N_ATTN_HEADS = ATTN_WIDTH // HEAD_DIM
HEADS_PER_GROUP = N_ATTN_HEADS // N_ATTN_GROUPS
ATTN_OUT_WIDTH = HEADS_PER_GROUP * HEAD_DIM
Q_BLOCK = 128
POOL_SIZES = (2, 4, 8, 16)
N_POOL_GROUPS = len(POOL_SIZES)
POOL_WIDTH = D_MODEL // 4
POOL_GROUP_WIDTH = POOL_WIDTH // N_POOL_GROUPS
N_BRANCHES = 2
IN_WIDTH = 3 * ATTN_WIDTH + POOL_WIDTH + N_BRANCHES * D_MODEL
N_BUCKETS = 32
MAX_DISTANCE = 2048
D_FF = 11 * D_MODEL // 4
N_EXPERTS = 8
TOP_K = 2
D_FF_EXPERT = 7 * D_MODEL // 2
N_DENSE = (DEPTH + 1) // 2
N_MOE = DEPTH // 2
RMS_EPS = 1e-6

kernel_name = "hybrid_dilated_attn_pool_moe_block"


def rms_norm(x, gain):
    xf = x.astype(jnp.float32)
    y = xf * lax.rsqrt(jnp.mean(xf * xf, axis=-1, keepdims=True) + RMS_EPS)
    return (y * gain.astype(jnp.float32)).astype(x.dtype)


def t5_causal_bucket(dist):
    max_exact = N_BUCKETS // 2
    df = jnp.maximum(dist, 1).astype(jnp.float32)
    large = max_exact + (jnp.log(df / max_exact) / math.log(MAX_DISTANCE / max_exact)
                         * (N_BUCKETS - max_exact)).astype(jnp.int32)
    large = jnp.minimum(large, N_BUCKETS - 1)
    return jnp.where(dist < max_exact, dist, large)


def from_streams(t, n_stream):
    b, d = t.shape[:2]
    rest = t.shape[4:]
    t = t.reshape((b, d, -1) + rest)[:, :, :n_stream]
    return jnp.moveaxis(t, 1, 2).reshape((b, n_stream * d) + rest)


def dilated_window_attention(q, k, v, bias_table, window, dilation):
    b, s, h, e = q.shape
    span = window // dilation
    n_stream = s // dilation
    n_blk = -(-n_stream // Q_BLOCK)
    pad = n_blk * Q_BLOCK - n_stream

    def to_streams(t):
        t = jnp.moveaxis(t.reshape(b, n_stream, dilation, h, e), 2, 1)
        t = jnp.pad(t, ((0, 0), (0, 0), (0, pad), (0, 0), (0, 0)))
        return t.reshape(b, dilation, n_blk, Q_BLOCK, h, e)

    def with_prev(t):
        prev = jnp.pad(t, ((0, 0), (0, 0), (1, 0), (0, 0), (0, 0), (0, 0)))[:, :, :-1]
        return jnp.concatenate([prev, t], axis=3)

    qb = to_streams(q)
    kw = with_prev(to_streams(k))
    vw = with_prev(to_streams(v))

    qi = jnp.arange(Q_BLOCK)[:, None]
    kj = jnp.arange(2 * Q_BLOCK)[None, :]
    step = qi + Q_BLOCK - kj
    key_idx = jnp.arange(n_blk)[:, None, None] * Q_BLOCK - Q_BLOCK + kj[None]
    valid = (step >= 0) & (step <= span) & (key_idx >= 0)
    bucket = t5_causal_bucket(jnp.clip(step, 0, span) * dilation)
    bias = jnp.moveaxis(bias_table[bucket], -1, 0).astype(jnp.float32)

    scores = jnp.einsum("brnqhe,brnkhe->brnhqk", qb, kw, preferred_element_type=jnp.float32)
    scores = scores * (HEAD_DIM ** -0.5) + bias[None, None, None]
    scores = jnp.where(valid[None, None, :, None], scores, -jnp.inf)
    m = jnp.max(scores, axis=-1, keepdims=True)
    p = jnp.exp(scores - m)
    denom = jnp.sum(p, axis=-1, keepdims=True)
    o = jnp.einsum("brnhqk,brnkhe->brnqhe", p.astype(v.dtype), vw,
                   preferred_element_type=jnp.float32)
    o = o / jnp.swapaxes(denom, 3, 4)
    lse = jnp.swapaxes((m + jnp.log(denom))[..., 0], 3, 4)
    return from_streams(o, n_stream), from_streams(lse, n_stream)


def multiscale_pool(p_in, w_pool, pool_scale):
    b, s, _ = p_in.shape
    pf = p_in.astype(jnp.float32).reshape(b, s, N_POOL_GROUPS, POOL_GROUP_WIDTH)
    csum = jnp.pad(jnp.cumsum(pf, axis=1), ((0, 0), (1, 0), (0, 0), (0, 0)))
    t = jnp.arange(s)
    sizes = jnp.array(POOL_SIZES, dtype=jnp.int32)
    starts = jnp.maximum(t[:, None] + 1 - sizes[None, :], 0)
    window_sum = csum[:, 1:] - csum[:, starts, jnp.arange(N_POOL_GROUPS)]
    count = (t[:, None] + 1 - starts).astype(jnp.float32)
    y = (window_sum / count[None, :, :, None] - pf).astype(p_in.dtype)
    y = jnp.einsum("bsgc,gcd->bsgd", y, w_pool)
    return y.reshape(b, s, POOL_WIDTH) * pool_scale


def hybrid_mixer(u, w_in, rel_bias, w_pool, pool_scale, w_attn_out, w_pool_out, w_out):
    b, s, _ = u.shape
    z = u @ w_in
    q, k, v, p_in, g_in = jnp.split(
        z, [ATTN_WIDTH, 2 * ATTN_WIDTH, 3 * ATTN_WIDTH, 3 * ATTN_WIDTH + POOL_WIDTH], axis=-1)
    head_shape = (b, s, N_ATTN_GROUPS, HEADS_PER_GROUP, HEAD_DIM)
    q = q.reshape(head_shape)
    k = k.reshape(head_shape)
    v = v.reshape(head_shape)
    outs, lses = [], []
    for gi, (window, dilation) in enumerate(DILATION_PATTERNS):
        heads = slice(gi * HEADS_PER_GROUP, (gi + 1) * HEADS_PER_GROUP)
        o, lse = dilated_window_attention(q[:, :, gi], k[:, :, gi], v[:, :, gi],
                                          rel_bias[:, heads], window, dilation)
        outs.append(o)
        lses.append(lse)
    mix_w = jax.nn.softmax(jnp.stack(lses, axis=0), axis=0)
    o_attn = jnp.sum(mix_w[..., None] * jnp.stack(outs, axis=0), axis=0)
    o_attn = o_attn.astype(u.dtype).reshape(b, s, ATTN_OUT_WIDTH)
    o_pool = multiscale_pool(p_in, w_pool, pool_scale)
    gates = jax.nn.sigmoid(g_in.astype(jnp.float32)).astype(u.dtype).reshape(b, s, N_BRANCHES, D_MODEL)
    merged = gates[:, :, 0] * (o_attn @ w_attn_out) + gates[:, :, 1] * (o_pool @ w_pool_out)
    return merged @ w_out


def dense_swiglu(u, w_gate, w_up, w_down):
    return (jax.nn.silu(u @ w_gate) * (u @ w_up)) @ w_down


def moe_swiglu(u, w_router, w_gate, w_up, w_down):
    b, s, d = u.shape
    tok = u.reshape(b * s, d)
    logits = (tok @ w_router).astype(jnp.float32)
    top_vals, top_idx = lax.top_k(logits, TOP_K)
    top_w = jax.nn.softmax(top_vals, axis=-1)
    combine = jnp.sum(jax.nn.one_hot(top_idx, N_EXPERTS, dtype=jnp.float32) * top_w[..., None], axis=1)
    y = jnp.zeros((b * s, d), jnp.float32)
    for e in range(N_EXPERTS):
        h = jax.nn.silu(tok @ w_gate[e]) * (tok @ w_up[e])
        y = y + combine[:, e:e + 1] * (h @ w_down[e]).astype(jnp.float32)
    return y.astype(u.dtype).reshape(b, s, d)


def setup_inputs(seed: int = 0) -> dict:
    key = jax.random.key(seed)
    ks = jax.random.split(key, 16)
    f32 = jnp.float32

    def normal(k, shape, fan_in):
        return jax.random.normal(k, shape, f32) * (fan_in ** -0.5)

    return {
        "x": jax.random.normal(ks[0], (BATCH, SEQ, D_MODEL), f32),
        "w_in": normal(ks[1], (DEPTH, D_MODEL, IN_WIDTH), D_MODEL),
        "rel_bias": 0.5 * jax.random.normal(ks[2], (N_BUCKETS, N_ATTN_HEADS), f32),
        "w_pool": normal(ks[3], (DEPTH, N_POOL_GROUPS, POOL_GROUP_WIDTH, POOL_GROUP_WIDTH), POOL_GROUP_WIDTH),
        "pool_scale": 1.0 + 0.02 * jax.random.normal(ks[4], (DEPTH, POOL_WIDTH), f32),
        "w_attn_out": normal(ks[5], (DEPTH, ATTN_OUT_WIDTH, D_MODEL), ATTN_OUT_WIDTH),
        "w_pool_out": normal(ks[6], (DEPTH, POOL_WIDTH, D_MODEL), POOL_WIDTH),
        "w_out": normal(ks[7], (DEPTH, D_MODEL, D_MODEL), D_MODEL),
        "norm_gains": 1.0 + 0.05 * jax.random.normal(ks[8], (DEPTH, 4, D_MODEL), f32),
        "dense_w_gate": normal(ks[9], (N_DENSE, D_MODEL, D_FF), D_MODEL),
        "dense_w_up": normal(ks[10], (N_DENSE, D_MODEL, D_FF), D_MODEL),
        "dense_w_down": normal(ks[11], (N_DENSE, D_FF, D_MODEL), D_FF),
        "moe_w_router": normal(ks[12], (N_MOE, D_MODEL, N_EXPERTS), D_MODEL),
        "moe_w_gate": normal(ks[13], (N_MOE, N_EXPERTS, D_MODEL, D_FF_EXPERT), D_MODEL),
        "moe_w_up": normal(ks[14], (N_MOE, N_EXPERTS, D_MODEL, D_FF_EXPERT), D_MODEL),
        "moe_w_down": normal(ks[15], (N_MOE, N_EXPERTS, D_FF_EXPERT, D_MODEL), D_FF_EXPERT),
    }


def reference(x, w_in, rel_bias, w_pool, pool_scale, w_attn_out, w_pool_out, w_out, norm_gains,
              dense_w_gate, dense_w_up, dense_w_down, moe_w_router, moe_w_gate, moe_w_up, moe_w_down):
    h = x
    for layer in range(DEPTH):
        gains = norm_gains[layer]
        u = rms_norm(h, gains[0])
        mix = hybrid_mixer(u, w_in[layer], rel_bias, w_pool[layer], pool_scale[layer],
                           w_attn_out[layer], w_pool_out[layer], w_out[layer])
        h = h + rms_norm(mix, gains[1])
        u = rms_norm(h, gains[2])
        j = layer // 2
        if layer % 2 == 0:
            f = dense_swiglu(u, dense_w_gate[j], dense_w_up[j], dense_w_down[j])
        else:
            f = moe_swiglu(u, moe_w_router[j], moe_w_gate[j], moe_w_up[j], moe_w_down[j])
        h = h + rms_norm(f, gains[3])
    return h
```

```cpp
#include <hip/hip_runtime.h>
#include <cstdio>
#include <cstdint>
#ifndef MK_SPLIT
#define MK_SPLIT 0
#endif
namespace pg8 {
#define PG8_LAS __attribute__((address_space(3)))
typedef unsigned short bf16_t;
typedef short bf16x8 __attribute__((ext_vector_type(8)));
typedef float f32x4 __attribute__((ext_vector_type(4)));
typedef unsigned u32x4 __attribute__((ext_vector_type(4)));
constexpr int BM = 256, BK = 64, HALF = 128, HTB = HALF * BK * 2  , STAGE_BYTES = 8 * HTB, NXCD = 8, WGM = 8;

__host__ __device__ __forceinline__ int lds_byte(int r, int c) { const int st = (r >> 4) * 2 + (c >> 5), rr = r & 15, cc = c & 31, ob = rr * 64 + cc * 2; return st * 1024 + (ob ^ (((ob >> 9) & 1) << 5)); }
__host__ __device__ __forceinline__ void stage_rc(int b, int& R, int& C) { const int st = b / 1024, sb = b % 1024, swz = sb ^ (((sb >> 9) & 1) << 5); R = (st >> 1) * 16 + swz / 64; C = (st & 1) * 32 + (swz % 64) / 2; }
__host__ __device__ __forceinline__ int perm32(int rho) { const int n = rho >> 4, i = rho & 15; return 8 * (i >> 2) + 4 * n + (i & 3); }

struct Unit { int pm, pn, pb; };
struct Gemm { const bf16_t* A; const bf16_t* Bt; int M, N, K; };

struct StaticOrder {
    int nM, nN, nwg, G, c;
    __host__ __device__ void init(int M, int N, int G_, int c_) { nM = M / BM; nN = N / BM; nwg = nM * nN; G = G_; c = c_; }
    __host__ __device__ bool next(int i, Unit& u) const {
        const long L = (long)i * G + c; if (L >= nwg) return false;
        int wgid = (int)L; { const int q = nwg / NXCD, r = nwg % NXCD, xcd = wgid % NXCD, off = wgid / NXCD; wgid = (xcd < r ? xcd * (q + 1) : r * (q + 1) + (xcd - r) * q) + off; }
        const int nig = WGM * nN, gid = wgid / nig, fm = gid * WGM, gsz = (nM - fm) < WGM ? (nM - fm) : WGM;
        u.pm = fm + ((wgid % nig) % gsz); u.pn = (wgid % nig) / gsz; u.pb = u.pn; return true;
    }
    __device__ __forceinline__ void a_ready(const Unit&) const {}
    __device__ __forceinline__ void done(const Unit&) const {}
};

__device__ __forceinline__ unsigned cvt_pk_bf16(float lo, float hi) { unsigned r; asm volatile("v_cvt_pk_bf16_f32 %0, %1, %2" : "=v"(r) : "v"(lo), "v"(hi)); return r; }
typedef float f32x2 __attribute__((ext_vector_type(2)));
__device__ __forceinline__ f32x2 gelu_pk(f32x2 v) {
    const f32x2 av = __builtin_elementwise_abs(v), d = av * 0.2316418882f + 1.0f;
    f32x2 t; t.x = __builtin_amdgcn_rcpf(d.x); t.y = __builtin_amdgcn_rcpf(d.y);
    f32x2 q = t * 0.5307027145f + (-0.7265760135f); q = q * t + 0.7107068705f; q = q * t + (-0.142248368f); q = q * t + 0.127414796f; q = q * t;
    const f32x2 s = (v * v) * (-0.72134752044f);
    f32x2 e; e.x = __builtin_amdgcn_exp2f(s.x); e.y = __builtin_amdgcn_exp2f(s.y);
    const f32x2 m = v * (q * e), r = v - m;
    f32x2 o; o.x = v.x < 0.f ? m.x : r.x; o.y = v.y < 0.f ? m.y : r.y; return o;
}

__device__ __forceinline__ float sigmoid_f(float v) { return __builtin_amdgcn_rcpf(1.0f + __builtin_amdgcn_exp2f(-1.4426950408889634f * v)); }
__device__ __forceinline__ float bf_lo(unsigned w) { return __uint_as_float(w << 16); }
__device__ __forceinline__ float bf_hi(unsigned w) { return __uint_as_float(w & 0xffff0000u); }
struct EpiZ {
    static constexpr bool PERM = true, AFTER_DRAIN = false;
    bf16_t* O; int ldc; int sig_from;
    __device__ __forceinline__ void operator()(const f32x4 (&acc)[2][2][4][2], const Unit& u, int wr, int wc, int fr, int fq) const {
        const int row0 = u.pm * BM + wr * 64 + fr, col0 = u.pn * BM + wc * 32 + 8 * fq; const bool sg = u.pn >= sig_from;
#pragma unroll
        for (int ai = 0; ai < 2; ++ai)
#pragma unroll
            for (int m = 0; m < 4; ++m) { bf16_t* rowp = O + (size_t)(row0 + ai * HALF + m * 16) * ldc + col0;
#pragma unroll
                for (int bj = 0; bj < 2; ++bj) { f32x4 v0 = acc[ai][bj][m][0], v1 = acc[ai][bj][m][1];
                    if (sg) {
#pragma unroll
                        for (int j = 0; j < 4; ++j) { v0[j] = sigmoid_f(v0[j]); v1[j] = sigmoid_f(v1[j]); } }
                    u32x4 w; w.x = cvt_pk_bf16(v0[0], v0[1]); w.y = cvt_pk_bf16(v0[2], v0[3]); w.z = cvt_pk_bf16(v1[0], v1[1]); w.w = cvt_pk_bf16(v1[2], v1[3]);
                    *(u32x4*)(rowp + bj * HALF) = w; } }
    }
};
template <int MODE> struct EpiGate {
    static constexpr bool PERM = true, AFTER_DRAIN = false;
    const bf16_t* G; int ldg; const bf16_t* Tin; bf16_t* O; int ldc;
    __device__ __forceinline__ void operator()(const f32x4 (&acc)[2][2][4][2], const Unit& u, int wr, int wc, int fr, int fq) const {
        const int row0 = u.pm * BM + wr * 64 + fr, col0 = u.pn * BM + wc * 32 + 8 * fq;
#pragma unroll
        for (int ai = 0; ai < 2; ++ai)
#pragma unroll
            for (int m = 0; m < 4; ++m) { const size_t row = (size_t)(row0 + ai * HALF + m * 16);
#pragma unroll
                for (int bj = 0; bj < 2; ++bj) { const int col = col0 + bj * HALF;
                    const u32x4 gw = *(const u32x4*)(G + row * ldg + col);
                    f32x4 v0 = acc[ai][bj][m][0], v1 = acc[ai][bj][m][1];
                    v0[0] *= bf_lo(gw.x); v0[1] *= bf_hi(gw.x); v0[2] *= bf_lo(gw.y); v0[3] *= bf_hi(gw.y);
                    v1[0] *= bf_lo(gw.z); v1[1] *= bf_hi(gw.z); v1[2] *= bf_lo(gw.w); v1[3] *= bf_hi(gw.w);
                    if (MODE == 1) { const u32x4 tw = *(const u32x4*)(Tin + row * ldc + col);
                        v0[0] += bf_lo(tw.x); v0[1] += bf_hi(tw.x); v0[2] += bf_lo(tw.y); v0[3] += bf_hi(tw.y);
                        v1[0] += bf_lo(tw.z); v1[1] += bf_hi(tw.z); v1[2] += bf_lo(tw.w); v1[3] += bf_hi(tw.w); }
                    u32x4 w; w.x = cvt_pk_bf16(v0[0], v0[1]); w.y = cvt_pk_bf16(v0[2], v0[3]); w.z = cvt_pk_bf16(v1[0], v1[1]); w.w = cvt_pk_bf16(v1[2], v1[3]);
                    *(u32x4*)(O + row * ldc + col) = w; } }
    }
};
struct EpiF32 {
    static constexpr bool PERM = false, AFTER_DRAIN = false;
    float* C; int ldc;
    __device__ __forceinline__ void operator()(const f32x4 (&acc)[2][2][4][2], const Unit& u, int wr, int wc, int fr, int fq) const {
        const int row0 = u.pm * BM + wr * 64 + fr, col0 = u.pn * BM + wc * 32 + 4 * fq;
#pragma unroll
        for (int ai = 0; ai < 2; ++ai)
#pragma unroll
            for (int m = 0; m < 4; ++m) { float* rowp = C + (size_t)(row0 + ai * HALF + m * 16) * ldc + col0;
#pragma unroll
                for (int bj = 0; bj < 2; ++bj)
#pragma unroll
                    for (int n = 0; n < 2; ++n) *(f32x4*)(rowp + bj * HALF + n * 16) = acc[ai][bj][m][n]; }
    }
};
struct EpiSwiGLU {
    static constexpr bool PERM = true, AFTER_DRAIN = false;
    bf16_t* O; int ldo;
    __device__ __forceinline__ void operator()(const f32x4 (&acc)[2][2][4][2], const Unit& u, int wr, int wc, int fr, int fq) const {
        const int row0 = u.pm * BM + wr * 64 + fr, col0 = u.pn * HALF + wc * 32 + 8 * fq;
#pragma unroll
        for (int ai = 0; ai < 2; ++ai)
#pragma unroll
            for (int m = 0; m < 4; ++m) { bf16_t* rowp = O + (size_t)(row0 + ai * HALF + m * 16) * ldo + col0;
                f32x4 v0, v1;
#pragma unroll
                for (int j = 0; j < 4; ++j) { const float g0 = acc[ai][0][m][0][j], g1 = acc[ai][0][m][1][j];
                    v0[j] = g0 * sigmoid_f(g0) * acc[ai][1][m][0][j]; v1[j] = g1 * sigmoid_f(g1) * acc[ai][1][m][1][j]; }
                u32x4 w; w.x = cvt_pk_bf16(v0[0], v0[1]); w.y = cvt_pk_bf16(v0[2], v0[3]); w.z = cvt_pk_bf16(v1[0], v1[1]); w.w = cvt_pk_bf16(v1[2], v1[3]);
                *(u32x4*)rowp = w; __builtin_amdgcn_sched_barrier(0); }
    }
};
struct MoeOrder {
    int P, NT, G, c; const PG8_LAS int* pexp;
    __device__ __forceinline__ bool next(int i, Unit& u) const {
        const long L = (long)i * G + c; if (L >= (long)P * NT) return false;
        u.pm = (int)(L % P); u.pn = (int)(L / P); u.pb = __builtin_amdgcn_readfirstlane(pexp[u.pm]) * NT + u.pn; return true;
    }
    __device__ __forceinline__ void a_ready(const Unit&) const {}
    __device__ __forceinline__ void done(const Unit&) const {}
};

template <class Epi, class Sched, bool ALIGN_EPI = false, bool SP2 = false>
__device__ __forceinline__ void gemm_phase(PG8_LAS unsigned char* lds, const Gemm g, const Sched& S, const Epi& E) {
    int tid = threadIdx.x; asm volatile("" : "+v"(tid));
    const int wid = __builtin_amdgcn_readfirstlane(tid >> 6), lane = tid & 63, wr = wid >> 2, wc = wid & 3, fr = lane & 15, fq = lane >> 4;
    const int K = g.K, nt = K / BK;
    unsigned voffA[2], voffB[2];
#pragma unroll
    for (int i = 0; i < 2; ++i) { int R, C; stage_rc(tid * 16 + i * 8192, R, C); const int Rb = Epi::PERM ? ((R & ~31) + perm32(R & 31)) : R;
        voffA[i] = (unsigned)(R * K + C) * 2u; voffB[i] = (unsigned)(Rb * K + C) * 2u; }
    const size_t kstep = (size_t)(BK * 2);
    const size_t hstep = (size_t)HALF * K * 2;
    const size_t tstep = 2 * hstep;
    const unsigned ldsw = (unsigned)wid * 1024u;
    const int aoff = lds_byte(wr * 64 + fr, fq * 8), boff = lds_byte(wc * 32 + fr, fq * 8);
#define PG8_SA(b, h) (((b) * 2 + (h)) * HTB)
#define PG8_SB(b, h) ((4 + (b) * 2 + (h)) * HTB)
#define PG8_STAGE(bufoff, gbase, voff) do { _Pragma("unroll") for (int _i = 0; _i < 2; ++_i) \
        __builtin_amdgcn_global_load_lds((const unsigned*)((const char*)(gbase) + (voff)[_i]), (PG8_LAS unsigned*)(lds + (bufoff) + ldsw + _i * 8192), 16, 0, 0); } while (0)
#define PG8_LDA(dst, b, h) do { _Pragma("unroll") for (int m = 0; m < 4; ++m) _Pragma("unroll") for (int k = 0; k < 2; ++k) dst[m][k] = *(const PG8_LAS bf16x8*)(lds + PG8_SA(b, h) + aoff + m * 2048 + k * 1024); } while (0)
#define PG8_LDB(dst, b, h) do { _Pragma("unroll") for (int n = 0; n < 2; ++n) _Pragma("unroll") for (int k = 0; k < 2; ++k) dst[n][k] = *(const PG8_LAS bf16x8*)(lds + PG8_SB(b, h) + boff + n * 2048 + k * 1024); } while (0)
#define PG8_MMA(ai, bj, At, Bt) do { __builtin_amdgcn_s_setprio(1); _Pragma("unroll") for (int m = 0; m < 4; ++m) _Pragma("unroll") for (int n = 0; n < 2; ++n) _Pragma("unroll") for (int k = 0; k < 2; ++k) \
        acc[ai][bj][m][n] = __builtin_amdgcn_mfma_f32_16x16x32_bf16(Bt[n][k], At[m][k], acc[ai][bj][m][n], 0, 0, 0); __builtin_amdgcn_s_setprio(0); } while (0)
#define PG8_WAIT_V(n) asm volatile("s_waitcnt vmcnt(" #n ")" ::: "memory")
#define PG8_WAIT_L(n) asm volatile("s_waitcnt lgkmcnt(" #n ")" ::: "memory")
#define PG8_BAR __builtin_amdgcn_s_barrier()
#define PG8_SCHED __builtin_amdgcn_sched_barrier(0)
    Unit cur, nxt; int ui = 0;
    if (!S.next(0, cur)) return;
    f32x4 acc[2][2][4][2];
#pragma unroll
    for (int a = 0; a < 2; ++a)
#pragma unroll
        for (int b = 0; b < 2; ++b)
#pragma unroll
            for (int m = 0; m < 4; ++m)
#pragma unroll
                for (int n = 0; n < 2; ++n) acc[a][b][m][n] = (f32x4){0.f, 0.f, 0.f, 0.f};
    bf16x8 At[4][2], B0[2][2], B1[2][2];
    const char* cA = (const char*)g.A + (size_t)cur.pm * tstep; const char* cB = (const char*)g.Bt + (size_t)cur.pb * tstep;
    asm volatile("" : "+v"(voffA[0]), "+v"(voffA[1]), "+v"(voffB[0]), "+v"(voffB[1]));
    S.a_ready(cur);
    if constexpr (SP2) {
        PG8_STAGE(PG8_SB(0, 0), cB, voffB); PG8_STAGE(PG8_SB(0, 1), cB + hstep, voffB); PG8_STAGE(PG8_SA(0, 0), cA, voffA); PG8_STAGE(PG8_SA(0, 1), cA + hstep, voffA);
        if (wr == 1) PG8_BAR;
        PG8_WAIT_V(2); PG8_BAR;
        PG8_STAGE(PG8_SB(1, 0), cB + kstep, voffB); PG8_STAGE(PG8_SA(1, 0), cA + kstep, voffA); PG8_STAGE(PG8_SB(1, 1), cB + hstep + kstep, voffB);
        PG8_WAIT_V(6); PG8_BAR;
    } else {
        PG8_STAGE(PG8_SB(0, 0), cB, voffB); PG8_STAGE(PG8_SA(0, 0), cA, voffA); PG8_STAGE(PG8_SB(0, 1), cB + hstep, voffB); PG8_STAGE(PG8_SA(0, 1), cA + hstep, voffA);
        if (wr == 1) PG8_BAR;
        PG8_WAIT_V(4); PG8_BAR;
        PG8_STAGE(PG8_SB(1, 0), cB + kstep, voffB); PG8_STAGE(PG8_SA(1, 0), cA + kstep, voffA); PG8_STAGE(PG8_SB(1, 1), cB + hstep + kstep, voffB);
        PG8_WAIT_V(6); PG8_BAR;
    }
    for (;;) {
        const bool has_next = S.next(ui + 1, nxt);
        const char* nA = has_next ? (const char*)g.A + (size_t)nxt.pm * tstep : cA; const char* nB = has_next ? (const char*)g.Bt + (size_t)nxt.pb * tstep : cB;
        for (int t = 0; t < nt; t += 2) {
            const bool last = (t == nt - 2);
            const char* a1 = cA + (size_t)(t + 1) * kstep;
            const char* a2 = last ? nA : cA + (size_t)(t + 2) * kstep; const char* b2 = last ? nB : cB + (size_t)(t + 2) * kstep;
            const char* a3 = a2 + kstep; const char* b3 = b2 + kstep;
            if (last && has_next) S.a_ready(nxt);
            if constexpr (SP2) {
            PG8_LDB(B0, 0, 0); PG8_LDB(B1, 0, 1); PG8_SCHED; PG8_LDA(At, 0, 0); PG8_STAGE(PG8_SA(1, 1), a1 + hstep, voffA);
            PG8_WAIT_V(8); PG8_WAIT_L(0); PG8_BAR; PG8_MMA(0, 0, At, B0); PG8_MMA(0, 1, At, B1); PG8_BAR; PG8_SCHED;
            PG8_LDA(At, 0, 1); PG8_STAGE(PG8_SB(0, 0), b2, voffB); PG8_STAGE(PG8_SB(0, 1), b2 + hstep, voffB); PG8_STAGE(PG8_SA(0, 0), a2, voffA);
            PG8_WAIT_V(8); PG8_WAIT_L(0); PG8_BAR; PG8_MMA(1, 0, At, B0); PG8_MMA(1, 1, At, B1); PG8_BAR; PG8_SCHED;
            PG8_LDB(B0, 1, 0); PG8_LDB(B1, 1, 1); PG8_SCHED; PG8_LDA(At, 1, 0); PG8_STAGE(PG8_SA(0, 1), a2 + hstep, voffA);
            PG8_WAIT_V(8); PG8_WAIT_L(0); PG8_BAR; PG8_MMA(0, 0, At, B0); PG8_MMA(0, 1, At, B1); PG8_BAR; PG8_SCHED;
            PG8_LDA(At, 1, 1); PG8_STAGE(PG8_SB(1, 0), b3, voffB); PG8_STAGE(PG8_SB(1, 1), b3 + hstep, voffB); PG8_STAGE(PG8_SA(1, 0), a3, voffA);
            PG8_WAIT_V(8); PG8_WAIT_L(0); PG8_BAR; PG8_MMA(1, 0, At, B0); PG8_MMA(1, 1, At, B1); PG8_BAR; PG8_SCHED;
            } else {
            PG8_LDB(B0, 0, 0); PG8_SCHED; PG8_LDA(At, 0, 0); PG8_STAGE(PG8_SA(1, 1), a1 + hstep, voffA);
            PG8_WAIT_L(8); PG8_BAR; PG8_WAIT_L(0); PG8_MMA(0, 0, At, B0); PG8_BAR; PG8_SCHED;
            PG8_LDB(B1, 0, 1); PG8_STAGE(PG8_SB(0, 0), b2, voffB);
            PG8_BAR; PG8_WAIT_L(0); PG8_MMA(0, 1, At, B1); PG8_BAR;
            PG8_LDA(At, 0, 1); PG8_STAGE(PG8_SA(0, 0), a2, voffA);
            PG8_BAR; PG8_WAIT_L(0); PG8_MMA(1, 0, At, B0); PG8_BAR; PG8_SCHED;
            PG8_STAGE(PG8_SB(0, 1), b2 + hstep, voffB);
            PG8_WAIT_V(6); PG8_BAR; PG8_MMA(1, 1, At, B1); PG8_BAR;
            PG8_LDB(B0, 1, 0); PG8_SCHED; PG8_LDA(At, 1, 0); PG8_STAGE(PG8_SA(0, 1), a2 + hstep, voffA);
            PG8_WAIT_L(8); PG8_BAR; PG8_WAIT_L(0); PG8_MMA(0, 0, At, B0); PG8_BAR; PG8_SCHED;
            PG8_LDB(B1, 1, 1); PG8_STAGE(PG8_SB(1, 0), b3, voffB);
            PG8_BAR; PG8_WAIT_L(0); PG8_MMA(0, 1, At, B1); PG8_BAR;
            PG8_LDA(At, 1, 1); PG8_STAGE(PG8_SA(1, 0), a3, voffA);
            PG8_BAR; PG8_WAIT_L(0); PG8_MMA(1, 0, At, B0); PG8_BAR; PG8_SCHED;
            PG8_STAGE(PG8_SB(1, 1), b3 + hstep, voffB);
            PG8_WAIT_V(6); PG8_BAR; PG8_MMA(1, 1, At, B1); PG8_BAR;
            }
        }
        if constexpr (ALIGN_EPI) { if (wr == 0) PG8_BAR; }
        if constexpr (!Epi::AFTER_DRAIN) { E(acc, cur, wr, wc, fr, fq); S.done(cur); }
        if (!has_next) break;
#pragma unroll
        for (int a = 0; a < 2; ++a)
#pragma unroll
            for (int b = 0; b < 2; ++b)
#pragma unroll
                for (int m = 0; m < 4; ++m)
#pragma unroll
                    for (int n = 0; n < 2; ++n) acc[a][b][m][n] = (f32x4){0.f, 0.f, 0.f, 0.f};
        cur = nxt; cA = nA; cB = nB; ++ui;
        if constexpr (ALIGN_EPI) { if (wr == 1) PG8_BAR; }
    }
    PG8_WAIT_V(0);
    if constexpr (!ALIGN_EPI) { if (wr == 0) PG8_BAR; }
    PG8_BAR;
    if constexpr (Epi::AFTER_DRAIN) { E.fused(acc, cur, wr, wc, fr, fq, lds, wid, lane); S.done(cur); }
#undef PG8_SA
#undef PG8_SB
#undef PG8_STAGE
#undef PG8_LDA
#undef PG8_LDB
#undef PG8_MMA
#undef PG8_WAIT_V
#undef PG8_WAIT_L
#undef PG8_BAR
#undef PG8_SCHED
}
}
constexpr int NWAVES = 8;
constexpr int BATCH = 2, SEQ = 4096, DM = 2048, M = BATCH * SEQ;
constexpr int INW = 9216, ZQ = 0, ZK = 1536, ZV = 3072, ZP = 4608, ZGA = 5120, ZGB = 7168;
constexpr int DFF = 5632, EFF = 7168, NEXP = 8;
constexpr int MPAD = 2 * M + NEXP * 256;
constexpr float RMS_EPS = 1e-6f;
constexpr int NPH = 20;
constexpr size_t MiB = 1u << 20;
constexpr size_t WS_CTL = 0, CTL_ZERO_BYTES = 1 * MiB;
constexpr size_t WS_LSE = 1 * MiB, WS_TOKE = WS_LSE + 512 * 1024, WS_TOKP = WS_TOKE + 64 * 1024, WS_TOKW = WS_TOKP + 64 * 1024;
constexpr size_t WS_WIN = 2 * MiB;
constexpr size_t WS_WAO = WS_WIN + 72 * MiB;
constexpr size_t WS_WPO = WS_WAO + 4 * MiB;
constexpr size_t WS_WOUT = WS_WPO + 4 * MiB;
constexpr size_t WS_WPOOL = WS_WOUT + 16 * MiB;
constexpr size_t WS_DGU = WS_WPOOL + 1 * MiB;
constexpr size_t WS_DD = WS_DGU + 44 * MiB;
constexpr size_t WS_MGU = WS_DD + 22 * MiB;
constexpr size_t WS_MD = WS_MGU + 448 * MiB;
constexpr size_t WS_XN = WS_MD + 224 * MiB;
constexpr size_t WS_A = WS_XN + 32 * MiB;
constexpr size_t WS_Z = WS_A, WS_OG = WS_A + 144 * MiB, WS_OA = WS_A + 168 * MiB, WS_OP = WS_A + 176 * MiB, WS_HM = WS_A, WS_HMP = WS_A;
constexpr size_t WS_B = WS_A + 252 * MiB;
constexpr size_t WS_T = WS_B, WS_MRG = WS_B + 32 * MiB, WS_MIX = WS_B + 64 * MiB, WS_XP = WS_B, WS_YP = WS_B;
constexpr size_t WS_END = WS_B + 144 * MiB;
static_assert((size_t)MPAD * EFF * 2 <= 252 * MiB && (size_t)MPAD * DM * 4 <= 144 * MiB && (size_t)M * INW * 2 <= 144 * MiB, "arena sizes");
constexpr int CW_TMO = 0, CW_CODE = 1;
constexpr int CW_BAR = 4096;
constexpr int CW_CNT = 8192;
constexpr int RING_OFF = 0, RING_BYTES = 131072;
constexpr int LDSCTL_OFF = RING_BYTES, MISC_OFF = LDSCTL_OFF + 320, TAB_OFF = LDSCTL_OFF + 512;
constexpr int LDS_BYTES = 147456;

#define GAS __attribute__((address_space(1)))
#define LAS __attribute__((address_space(3)))
typedef unsigned short bf16;
typedef unsigned v4u __attribute__((ext_vector_type(4)));
typedef unsigned v2u __attribute__((ext_vector_type(2)));
typedef float f32x4 __attribute__((ext_vector_type(4)));
typedef short bf16x8 __attribute__((ext_vector_type(8)));
typedef short bf16x4 __attribute__((ext_vector_type(4)));
typedef GAS unsigned gu32;
#define RLX_AGENT __ATOMIC_RELAXED, __HIP_MEMORY_SCOPE_AGENT
#define LDS_WAIT() asm volatile("s_waitcnt lgkmcnt(0)" ::: "memory")
#define VM_WAIT() asm volatile("s_waitcnt vmcnt(0)" ::: "memory")
__device__ __forceinline__ unsigned f2bf(float f) { unsigned u = __builtin_bit_cast(unsigned, f); return (u + 0x7fffu + ((u >> 16) & 1u)) >> 16; }
__device__ __forceinline__ unsigned pk2(float lo, float hi) { return f2bf(lo) | (f2bf(hi) << 16); }
__device__ __forceinline__ float bflo(unsigned w) { return __uint_as_float(w << 16); }
__device__ __forceinline__ float bfhi(unsigned w) { return __uint_as_float(w & 0xffff0000u); }
#define XB_TMO      128
#define XB_XCNT(j)  (256  + 64 * (j))
#define XB_XSUB(j)  (1280 + 64 * (j))
#define XB_XGEN(j)  (2304 + 64 * (j))
#define XB_TOP      3328
#define XB_TOPGEN   3392
#define XCD_BAR_WORDS 3456
#define XB_SPIN_CAP (1u << 18)

__device__ __forceinline__ unsigned xb_ld(unsigned* p)              { return __hip_atomic_load(p, __ATOMIC_RELAXED, __HIP_MEMORY_SCOPE_AGENT); }
__device__ __forceinline__ unsigned xb_add(unsigned* p, unsigned v) { return __hip_atomic_fetch_add(p, v, __ATOMIC_RELAXED, __HIP_MEMORY_SCOPE_AGENT); }
__device__ __forceinline__ unsigned xb_xcc_id() { return (unsigned)__builtin_amdgcn_s_getreg((3 << 11) | 20) & 0xFu; }
#define XB_SPIN(cond, bar) do { unsigned _sp = 0; while (cond) { __builtin_amdgcn_s_sleep(1); \
    if ((++_sp & 255u) == 0u) { if (xb_ld(&(bar)[XB_TMO])) break; if (_sp > XB_SPIN_CAP) { atomicAdd(&(bar)[XB_TMO], 1u); break; } } } } while (0)

struct XcdBarrier {
    unsigned* bar; unsigned x;
    volatile LAS unsigned* st;
};

__device__ __forceinline__ XcdBarrier xcd_barrier_post(unsigned* bar, volatile LAS unsigned* st) {
    XcdBarrier b; b.bar = bar; b.x = xb_xcc_id(); b.st = st;
    if (threadIdx.x == 0) (void)xb_add(&bar[XB_XCNT(b.x)], 1u);
    return b;
}
__device__ __forceinline__ void xcd_barrier_complete(unsigned* bar, unsigned x, unsigned& nloc, unsigned& nx) {
    const unsigned G = gridDim.x * gridDim.y * gridDim.z;
    unsigned sum, cnt, mine, sp = 0u;
    for (;;) {
        sum = 0u; cnt = 0u; mine = 0u;
#pragma unroll
        for (unsigned j = 0; j < 16; ++j) { const unsigned c = xb_ld(&bar[XB_XCNT(j)]); sum += c; cnt += (c > 0u) ? 1u : 0u; mine = (j == x) ? c : mine; }
        if (sum == G) break;
        __builtin_amdgcn_s_sleep(1);
        if ((++sp & 255u) == 0u) { if (xb_ld(&bar[XB_TMO])) break; if (sp > XB_SPIN_CAP) { atomicAdd(&bar[XB_TMO], 1u); break; } }
    }
    nloc = mine > 0u ? mine : 1u; nx = cnt > 0u ? cnt : 1u;
}

__device__ __forceinline__ void xcd_barrier(const XcdBarrier& b) {
    asm volatile("s_waitcnt vmcnt(0)" ::: "memory");
    __syncthreads();
    if (threadIdx.x == 0) {
        unsigned* bar = b.bar;
        __builtin_amdgcn_s_waitcnt(0);
        unsigned nloc = b.st[0], nx = b.st[1];
        if (nloc == 0u) { xcd_barrier_complete(bar, b.x, nloc, nx); b.st[0] = nloc; b.st[1] = nx; }
        const unsigned old = xb_add(&bar[XB_XSUB(b.x)], 1u);
        const unsigned gen = old / nloc;
        if (old + 1u == (gen + 1u) * nloc) {
            __builtin_amdgcn_fence(__ATOMIC_RELEASE, "agent");
            asm volatile("s_waitcnt vmcnt(0)" ::: "memory");
            const unsigned og = xb_add(&bar[XB_TOP], 1u);
            const unsigned tg = og / nx;
            if (og + 1u == (tg + 1u) * nx) xb_add(&bar[XB_TOPGEN], 1u);
            else XB_SPIN(xb_ld(&bar[XB_TOPGEN]) == tg, bar);
            __builtin_amdgcn_fence(__ATOMIC_ACQUIRE, "agent");
            xb_add(&bar[XB_XGEN(b.x)], 1u);
            asm volatile("s_waitcnt vmcnt(0)" ::: "memory");
        } else {
            XB_SPIN(xb_ld(&bar[XB_XGEN(b.x)]) == gen, bar);
            __builtin_amdgcn_fence(__ATOMIC_ACQUIRE, "agent");
            asm volatile("s_waitcnt vmcnt(0)" ::: "memory");
        }
    }
    __syncthreads();
}

__device__ __forceinline__ float wave_sum(float v) {
#pragma unroll
    for (int o = 1; o < 64; o <<= 1) v += __shfl_xor(v, o);
    return v;
}
__device__ __forceinline__ void conv_item(const float* W, int ldn, int k0, int n0, bf16* dst, int ldk, int drow0, LAS float* scr, int lane) {
#pragma unroll 8
    for (int i = 0; i < 32; ++i) { const int kk = 2 * i + (lane >> 5); scr[kk * 33 + (lane & 31)] = W[(size_t)(k0 + kk) * ldn + n0 + (lane & 31)]; }
    LDS_WAIT(); asm volatile("" ::: "memory");
    const int c = lane & 7;
#pragma unroll
    for (int j = 0; j < 4; ++j) { const int n = (lane >> 3) + 8 * j; const LAS float* s = scr + (8 * c) * 33 + n;
        v4u o; o.x = pk2(s[0 * 33], s[1 * 33]); o.y = pk2(s[2 * 33], s[3 * 33]); o.z = pk2(s[4 * 33], s[5 * 33]); o.w = pk2(s[6 * 33], s[7 * 33]);
        *(GAS v4u*)(dst + (size_t)(drow0 + n) * ldk + k0 + 8 * c) = o; }
    LDS_WAIT(); asm volatile("" ::: "memory");
}
struct Ptrs {
    const float *x, *w_in, *relb, *w_pool, *pscale, *w_ao, *w_po, *w_out, *gains, *dwg, *dwu, *dwd, *wr, *mwg, *mwu, *mwd;
    float* out; unsigned char* ws;
};
__device__ __forceinline__ void p0_convert(const Ptrs& P, LAS unsigned char* lds, int gw, int NGW, int wave, int lane) {
    LAS float* scr = (LAS float*)(lds + RING_OFF + wave * 16384);
    unsigned char* ws = P.ws;
    constexpr int I_WIN = 2 * 32 * 288, I_AO = 2 * 8 * 64, I_PO = I_AO, I_WOUT = 2 * 32 * 64, I_POOL = 8 * 2 * 4, I_DG = 32 * 176, I_DU = I_DG, I_DD = 88 * 64,
                  I_MG = 8 * 32 * 224, I_MU = I_MG, I_MD = 8 * 112 * 64;
    constexpr int NITEMS = I_WIN + I_AO + I_PO + I_WOUT + I_POOL + I_DG + I_DU + I_DD + I_MG + I_MU + I_MD;
    for (int it = gw; it < NITEMS; it += NGW) {
        int r = it;
        if (r < I_WIN) { const int l = r / (32 * 288), q = r % (32 * 288), kb = q / 288, nb = q % 288;
            conv_item(P.w_in + (size_t)l * DM * INW, INW, 64 * kb, 32 * nb, (bf16*)(ws + WS_WIN) + (size_t)l * INW * DM, DM, 32 * nb, scr, lane); continue; } r -= I_WIN;
        if (r < I_AO) { const int l = r / 512, q = r % 512, kb = q / 64, nb = q % 64;
            conv_item(P.w_ao + (size_t)l * 512 * DM, DM, 64 * kb, 32 * nb, (bf16*)(ws + WS_WAO) + (size_t)l * DM * 512, 512, 32 * nb, scr, lane); continue; } r -= I_AO;
        if (r < I_PO) { const int l = r / 512, q = r % 512, kb = q / 64, nb = q % 64;
            conv_item(P.w_po + (size_t)l * 512 * DM, DM, 64 * kb, 32 * nb, (bf16*)(ws + WS_WPO) + (size_t)l * DM * 512, 512, 32 * nb, scr, lane); continue; } r -= I_PO;
        if (r < I_WOUT) { const int l = r / 2048, q = r % 2048, kb = q / 64, nb = q % 64;
            conv_item(P.w_out + (size_t)l * DM * DM, DM, 64 * kb, 32 * nb, (bf16*)(ws + WS_WOUT) + (size_t)l * DM * DM, DM, 32 * nb, scr, lane); continue; } r -= I_WOUT;
        if (r < I_POOL) { const int mtx = r / 8, q = r % 8, kb = q / 4, nb = q % 4;
            conv_item(P.w_pool + (size_t)mtx * 128 * 128, 128, 64 * kb, 32 * nb, (bf16*)(ws + WS_WPOOL) + (size_t)mtx * 128 * 128, 128, 32 * nb, scr, lane); continue; } r -= I_POOL;
        if (r < I_DG + I_DU) { const int up = r >= I_DG; const int q = up ? r - I_DG : r; const int kb = q / 176, nb = q % 176, n0 = 32 * nb;
            conv_item(up ? P.dwu : P.dwg, DFF, 64 * kb, n0, (bf16*)(ws + WS_DGU), DM, (n0 >> 7) * 256 + (n0 & 127) + (up ? 128 : 0), scr, lane); continue; } r -= I_DG + I_DU;
        if (r < I_DD) { const int kb = r / 64, nb = r % 64;
            conv_item(P.dwd, DM, 64 * kb, 32 * nb, (bf16*)(ws + WS_DD), DFF, 32 * nb, scr, lane); continue; } r -= I_DD;
        if (r < I_MG + I_MU) { const int up = r >= I_MG; const int q0 = up ? r - I_MG : r; const int e = q0 / (32 * 224), q = q0 % (32 * 224), kb = q / 224, nb = q % 224, n0 = 32 * nb;
            conv_item((up ? P.mwu : P.mwg) + (size_t)e * DM * EFF, EFF, 64 * kb, n0, (bf16*)(ws + WS_MGU) + (size_t)e * 2 * EFF * DM, DM, (n0 >> 7) * 256 + (n0 & 127) + (up ? 128 : 0), scr, lane); continue; } r -= I_MG + I_MU;
        { const int e = r / (112 * 64), q = r % (112 * 64), kb = q / 64, nb = q % 64;
            conv_item(P.mwd + (size_t)e * EFF * DM, DM, 64 * kb, 32 * nb, (bf16*)(ws + WS_MD) + (size_t)e * DM * EFF, EFF, 32 * nb, scr, lane); }
    }
}
__device__ __forceinline__ void ld_row(const float* p, int lane, f32x4 (&v)[8]) { const GAS f32x4* r = (const GAS f32x4*)p + lane;
#pragma unroll
    for (int j = 0; j < 8; ++j) v[j] = r[64 * j]; }
__device__ __forceinline__ float sumsq(const f32x4 (&v)[8]) { float s = 0.f;
#pragma unroll
    for (int j = 0; j < 8; ++j) s += (v[j].x * v[j].x + v[j].y * v[j].y) + (v[j].z * v[j].z + v[j].w * v[j].w);
    return wave_sum(s); }
__device__ __forceinline__ void st_row_bf16(bf16* p, int lane, const f32x4 (&v)[8]) { GAS v2u* o = (GAS v2u*)p + lane;
#pragma unroll
    for (int j = 0; j < 8; ++j) { v2u w; w.x = pk2(v[j].x, v[j].y); w.y = pk2(v[j].z, v[j].w); o[64 * j] = w; } }
__device__ __forceinline__ void norm_first(const float* x, const float* g, bf16* XN, int gw, int NGW, int lane) {
    f32x4 gv[8]; ld_row(g, lane, gv);
#pragma unroll 1
    for (int m = gw; m < M; m += NGW) { f32x4 v[8]; ld_row(x + (size_t)m * DM, lane, v);
        const float r = 1.0f / sqrtf(sumsq(v) * (1.0f / DM) + RMS_EPS);
#pragma unroll
        for (int j = 0; j < 8; ++j) v[j] = v[j] * r * gv[j];
        st_row_bf16(XN + (size_t)m * DM, lane, v); }
}
template <bool ROUTER>
__device__ __forceinline__ void norm_mid(const float* src, const float* res, float* hout, const float* gpost, const float* gpre, bf16* XN,
                                         const LAS float* wrl, gu32* ctl, int* toke, int* tokp, float* tokw, int gw, int NGW, int lane) {
#pragma unroll 1
    for (int m = gw; m < M; m += NGW) {
        f32x4 v[8], h[8], gv[8]; ld_row(src + (size_t)m * DM, lane, v); ld_row(res + (size_t)m * DM, lane, h); ld_row(gpost, lane, gv);
        const float r = 1.0f / sqrtf(sumsq(v) * (1.0f / DM) + RMS_EPS);
#pragma unroll
        for (int j = 0; j < 8; ++j) h[j] = h[j] + v[j] * r * gv[j];
        { GAS f32x4* o = (GAS f32x4*)(hout + (size_t)m * DM) + lane;
#pragma unroll
          for (int j = 0; j < 8; ++j) o[64 * j] = h[j]; }
        const float r2 = 1.0f / sqrtf(sumsq(h) * (1.0f / DM) + RMS_EPS);
        ld_row(gpre, lane, gv);
#pragma unroll
        for (int j = 0; j < 8; ++j) h[j] = h[j] * r2 * gv[j];
        st_row_bf16(XN + (size_t)m * DM, lane, h);
        if (ROUTER) {
            int e1 = 0, e2 = 0; float v1 = -3.0e38f, v2 = -3.0e38f;
#pragma unroll 1
            for (int e = 0; e < NEXP; ++e) { float s = 0.f; const LAS f32x4* wp = (const LAS f32x4*)(wrl + e * DM) + lane;
#pragma unroll
                for (int j = 0; j < 8; ++j) { const f32x4 w = wp[64 * j]; s += (h[j].x * w.x + h[j].y * w.y) + (h[j].z * w.z + h[j].w * w.w); }
                s = wave_sum(s);
                if (s > v1) { v2 = v1; e2 = e1; v1 = s; e1 = e; } else if (s > v2) { v2 = s; e2 = e; } }
            if (lane == 0) {
                const float w1 = 1.0f / (1.0f + __expf(v2 - v1)), w2 = 1.0f - w1;
                const unsigned p1 = __hip_atomic_fetch_add(ctl + CW_CNT + 64 * e1, 1u, RLX_AGENT);
                const unsigned p2 = __hip_atomic_fetch_add(ctl + CW_CNT + 64 * e2, 1u, RLX_AGENT);
                toke[2 * m] = e1; toke[2 * m + 1] = e2; tokp[2 * m] = (int)p1; tokp[2 * m + 1] = (int)p2; tokw[2 * m] = w1; tokw[2 * m + 1] = w2;
            }
        }
    }
}
__device__ __forceinline__ void moe_tables(gu32* ctl, LAS int* tab, int tid) {
    if (tid == 0) { int off = 0, p = 0;
        for (int e = 0; e < NEXP; ++e) { int c = (int)__hip_atomic_load(ctl + CW_CNT + 64 * e, RLX_AGENT); if (c > 2 * M) c = 2 * M; const int np = (c + 255) >> 8;
            tab[80 + e] = off; tab[88 + e] = c; for (int i = 0; i < np && p < 80; ++i) tab[p++] = e; off += np * 256; }
        tab[96] = p; }
    __syncthreads();
}
__device__ __forceinline__ void norm_final(const float* Yp, const float* g, float* hio, const int* toke, const int* tokp, const float* tokw, const LAS int* tab, int gw, int NGW, int lane) {
    f32x4 gv[8]; ld_row(g, lane, gv);
#pragma unroll 1
    for (int m = gw; m < M; m += NGW) {
        const int r1 = tab[80 + toke[2 * m]] + tokp[2 * m], r2 = tab[80 + toke[2 * m + 1]] + tokp[2 * m + 1]; const float w1 = tokw[2 * m], w2 = tokw[2 * m + 1];
        f32x4 a[8], b[8], h[8]; ld_row(Yp + (size_t)r1 * DM, lane, a); ld_row(Yp + (size_t)r2 * DM, lane, b); ld_row(hio + (size_t)m * DM, lane, h);
#pragma unroll
        for (int j = 0; j < 8; ++j) a[j] = a[j] * w1 + b[j] * w2;
        const float r = 1.0f / sqrtf(sumsq(a) * (1.0f / DM) + RMS_EPS);
        GAS f32x4* o = (GAS f32x4*)(hio + (size_t)m * DM) + lane;
#pragma unroll
        for (int j = 0; j < 8; ++j) o[64 * j] = h[j] + a[j] * r * gv[j];
    }
}
__device__ __forceinline__ void moe_gather(const bf16* XN, bf16* Xp, const int* toke, const int* tokp, const LAS int* tab, int gw, int NGW, int lane) {
    for (int idx = gw; idx < 2 * M; idx += NGW) { const int row = tab[80 + toke[idx]] + tokp[idx];
        const GAS v4u* s = (const GAS v4u*)(XN + (size_t)(idx >> 1) * DM) + lane; GAS v4u* d = (GAS v4u*)(Xp + (size_t)row * DM) + lane;
#pragma unroll
        for (int j = 0; j < 4; ++j) d[64 * j] = s[64 * j]; }
    for (int pr = gw; pr < NEXP * 256; pr += NGW) { const int e = pr >> 8, i = pr & 255, c = tab[88 + e], np = (c + 255) >> 8;
        if (c + i < np * 256) { GAS v4u* d = (GAS v4u*)(Xp + (size_t)(tab[80 + e] + c + i) * DM) + lane;
#pragma unroll
            for (int j = 0; j < 4; ++j) d[64 * j] = (v4u){0u, 0u, 0u, 0u}; } }
}
__device__ __forceinline__ int t5_bucket(int d) {
    if (d < 16) return d;
    return 16 + (d >= 22) + (d >= 30) + (d >= 40) + (d >= 54) + (d >= 73) + (d >= 99) + (d >= 134) + (d >= 182) + (d >= 246) + (d >= 332) + (d >= 450) + (d >= 609) + (d >= 825) + (d >= 1117) + (d >= 1513);
}
constexpr int VT_PITCH = 520;
constexpr int BT_OFF = 128 * VT_PITCH;
__device__ __forceinline__ void attn_phase(const bf16* Z, const float* relb, bf16* OG, float* LSE, LAS unsigned char* lds, int G, int tid, int wave, int lane) {
    LAS unsigned char* vt = lds + RING_OFF; LAS float* btab = (LAS float*)(lds + RING_OFF + BT_OFF);
    const int qi = lane & 15, qd = lane >> 4;
    constexpr float C2 = 0.08838834764831845f * 1.4426950408889634f;
    for (int ui = blockIdx.x; ui < 768; ui += G) {
        const int hh = ui & 3; const int u2 = ui >> 2; const int b = u2 / 96, s = u2 % 96;
        int g, d, r, n;
        if (s < 32) { g = 0; d = 1; r = 0; n = s; } else if (s < 64) { g = 1; d = 4; r = (s - 32) >> 3; n = (s - 32) & 7; } else { g = 2; d = 16; r = (s - 64) >> 1; n = (s - 64) & 1; }
        const int head = g * 4 + hh;
        __syncthreads();
#pragma unroll
        for (int i = 0; i < 8; ++i) { const int ch = tid + 512 * i, p = ch >> 4, dc = ch & 15, j = 128 * (n - 1) + p;
            v4u v = (v4u){0u, 0u, 0u, 0u};
            if (j >= 0) v = *(const GAS v4u*)(Z + (size_t)(b * SEQ + r + d * j) * INW + ZV + head * 128 + dc * 8);
            LAS unsigned short* w = (LAS unsigned short*)(vt + (dc * 8) * VT_PITCH + p * 2);
            w[0 * (VT_PITCH / 2)] = (unsigned short)(v.x & 0xffffu); w[1 * (VT_PITCH / 2)] = (unsigned short)(v.x >> 16);
            w[2 * (VT_PITCH / 2)] = (unsigned short)(v.y & 0xffffu); w[3 * (VT_PITCH / 2)] = (unsigned short)(v.y >> 16);
            w[4 * (VT_PITCH / 2)] = (unsigned short)(v.z & 0xffffu); w[5 * (VT_PITCH / 2)] = (unsigned short)(v.z >> 16);
            w[6 * (VT_PITCH / 2)] = (unsigned short)(v.w & 0xffffu); w[7 * (VT_PITCH / 2)] = (unsigned short)(v.w >> 16); }
        if (tid < 129) btab[tid] = relb[t5_bucket(tid * d) * 12 + head] * 1.4426950408889634f;
        __syncthreads();
        const int jq = 128 * n + 16 * wave + qi; const size_t rowq = (size_t)(b * SEQ + r + d * jq);
        bf16x8 qf[4];
#pragma unroll
        for (int s4 = 0; s4 < 4; ++s4) qf[s4] = *(const GAS bf16x8*)(Z + rowq * INW + ZQ + head * 128 + 32 * s4 + 8 * qd);
        f32x4 sa[9];
#pragma unroll
        for (int t = 0; t < 9; ++t) { int jk = 128 * (n - 1) + 16 * wave + 16 * t + qi; if (jk < 0) jk = 0;
            const bf16* kp = Z + (size_t)(b * SEQ + r + d * jk) * INW + ZK + head * 128 + 8 * qd;
            f32x4 a = (f32x4){0.f, 0.f, 0.f, 0.f};
#pragma unroll
            for (int s4 = 0; s4 < 4; ++s4) a = __builtin_amdgcn_mfma_f32_16x16x32_bf16(*(const GAS bf16x8*)(kp + 32 * s4), qf[s4], a, 0, 0, 0);
            sa[t] = a; }
        float mx = -__builtin_inff();
#pragma unroll
        for (int t = 0; t < 9; ++t)
#pragma unroll
            for (int rr = 0; rr < 4; ++rr) { const int step = 128 + qi - 16 * t - 4 * qd - rr; const int pk = 16 * wave + 16 * t + 4 * qd + rr;
                const bool valid = (step >= 0) && (step <= 128) && (n > 0 || pk >= 128);
                const int sidx = step < 0 ? 0 : (step > 128 ? 128 : step);
                const float sc = valid ? sa[t][rr] * C2 + btab[sidx] : -__builtin_inff();
                sa[t][rr] = sc; mx = fmaxf(mx, sc); }
        mx = fmaxf(mx, __shfl_xor(mx, 16)); mx = fmaxf(mx, __shfl_xor(mx, 32));
        float sum = 0.f;
#pragma unroll
        for (int t = 0; t < 9; ++t)
#pragma unroll
            for (int rr = 0; rr < 4; ++rr) { const float p = __builtin_amdgcn_exp2f(sa[t][rr] - mx); sa[t][rr] = p; sum += p; }
        sum += __shfl_xor(sum, 16); sum += __shfl_xor(sum, 32);
        f32x4 o[8];
#pragma unroll
        for (int dt = 0; dt < 8; ++dt) o[dt] = (f32x4){0.f, 0.f, 0.f, 0.f};
#pragma unroll
        for (int t = 0; t < 9; ++t) { v2u pw; pw.x = pk2(sa[t][0], sa[t][1]); pw.y = pk2(sa[t][2], sa[t][3]); const bf16x4 pf = __builtin_bit_cast(bf16x4, pw);
#pragma unroll
            for (int dt = 0; dt < 8; ++dt) { const bf16x4 vf = *(const LAS bf16x4*)(vt + (16 * dt + qi) * VT_PITCH + 2 * (16 * wave + 16 * t + 4 * qd));
                o[dt] = __builtin_amdgcn_mfma_f32_16x16x16bf16_1k(vf, pf, o[dt], 0, 0, 0); } }
        const float inv = 1.0f / sum;
        bf16* op = OG + ((size_t)g * M + rowq) * 512 + hh * 128 + 4 * qd;
#pragma unroll
        for (int dt = 0; dt < 8; ++dt) { v2u w; w.x = pk2(o[dt][0] * inv, o[dt][1] * inv); w.y = pk2(o[dt][2] * inv, o[dt][3] * inv); *(GAS v2u*)(op + 16 * dt) = w; }
        if (qd == 0) LSE[((size_t)g * M + rowq) * 4 + hh] = (mx + __builtin_amdgcn_logf(sum)) * 0.6931471805599453f;
    }
}
__device__ __forceinline__ void combine_pool_phase(const bf16* Z, const bf16* OG, const float* LSE, const bf16* WPt, const float* pscale, bf16* OA, bf16* OP, int gw, int NGW, int lane) {
#pragma unroll 1
    for (int m = gw; m < M; m += NGW) { const int hh = lane >> 4;
        const float l0 = LSE[(size_t)m * 4 + hh], l1 = LSE[((size_t)M + m) * 4 + hh], l2 = LSE[((size_t)2 * M + m) * 4 + hh];
        const float mx = fmaxf(l0, fmaxf(l1, l2)); const float e0 = __expf(l0 - mx), e1 = __expf(l1 - mx), e2 = __expf(l2 - mx); const float inv = 1.0f / (e0 + e1 + e2);
        const float w0 = e0 * inv, w1 = e1 * inv, w2 = e2 * inv;
        const v4u a = *(const GAS v4u*)(OG + (size_t)m * 512 + lane * 8), b = *(const GAS v4u*)(OG + ((size_t)M + m) * 512 + lane * 8), c = *(const GAS v4u*)(OG + ((size_t)2 * M + m) * 512 + lane * 8);
        v4u o;
        o.x = pk2(w0 * bflo(a.x) + w1 * bflo(b.x) + w2 * bflo(c.x), w0 * bfhi(a.x) + w1 * bfhi(b.x) + w2 * bfhi(c.x));
        o.y = pk2(w0 * bflo(a.y) + w1 * bflo(b.y) + w2 * bflo(c.y), w0 * bfhi(a.y) + w1 * bfhi(b.y) + w2 * bfhi(c.y));
        o.z = pk2(w0 * bflo(a.z) + w1 * bflo(b.z) + w2 * bflo(c.z), w0 * bfhi(a.z) + w1 * bfhi(b.z) + w2 * bfhi(c.z));
        o.w = pk2(w0 * bflo(a.w) + w1 * bflo(b.w) + w2 * bflo(c.w), w0 * bfhi(a.w) + w1 * bfhi(b.w) + w2 * bfhi(c.w));
        *(GAS v4u*)(OA + (size_t)m * 512 + lane * 8) = o; }
    const int qi = lane & 15, qd = lane >> 4;
    for (int task = gw; task < (M / 16) * 4; task += NGW) { const int g = task & 3, row = (task >> 2) * 16 + qi, tseq = row & (SEQ - 1), size = 2 << g; const int cnt = (tseq + 1 < size) ? tseq + 1 : size;
        const float rc = 1.0f / (float)cnt;
        bf16x8 yf[4];
#pragma unroll
        for (int s4 = 0; s4 < 4; ++s4) { const bf16* zp = Z + (size_t)row * INW + ZP + 128 * g + 32 * s4 + 8 * qd;
            const v4u sv = *(const GAS v4u*)zp;
            float a0 = bflo(sv.x), a1 = bfhi(sv.x), a2 = bflo(sv.y), a3 = bfhi(sv.y), a4 = bflo(sv.z), a5 = bfhi(sv.z), a6 = bflo(sv.w), a7 = bfhi(sv.w);
            for (int j = 1; j < size; ++j) if (j < cnt) { const v4u v = *(const GAS v4u*)(zp - (size_t)j * INW);
                a0 += bflo(v.x); a1 += bfhi(v.x); a2 += bflo(v.y); a3 += bfhi(v.y); a4 += bflo(v.z); a5 += bfhi(v.z); a6 += bflo(v.w); a7 += bfhi(v.w); }
            v4u yw; yw.x = pk2(a0 * rc - bflo(sv.x), a1 * rc - bfhi(sv.x)); yw.y = pk2(a2 * rc - bflo(sv.y), a3 * rc - bfhi(sv.y));
            yw.z = pk2(a4 * rc - bflo(sv.z), a5 * rc - bfhi(sv.z)); yw.w = pk2(a6 * rc - bflo(sv.w), a7 * rc - bfhi(sv.w));
            yf[s4] = __builtin_bit_cast(bf16x8, yw); }
#pragma unroll
        for (int nt = 0; nt < 8; ++nt) { f32x4 acc = (f32x4){0.f, 0.f, 0.f, 0.f};
            const bf16* wp = WPt + ((size_t)g * 128 + 16 * nt + qi) * 128 + 8 * qd;
#pragma unroll
            for (int s4 = 0; s4 < 4; ++s4) acc = __builtin_amdgcn_mfma_f32_16x16x32_bf16(*(const GAS bf16x8*)(wp + 32 * s4), yf[s4], acc, 0, 0, 0);
            const f32x4 ps = *(const GAS f32x4*)(pscale + 128 * g + 16 * nt + 4 * qd);
            v2u w; w.x = pk2(acc[0] * ps[0], acc[1] * ps[1]); w.y = pk2(acc[2] * ps[2], acc[3] * ps[3]);
            *(GAS v2u*)(OP + (size_t)row * 512 + 128 * g + 16 * nt + 4 * qd) = w; }
    }
}
struct Args { const float* in[16]; float* out; unsigned char* ws; int ph_lo, ph_hi; };
__global__ void __launch_bounds__(NWAVES * 64, 2) mk_fwd(Args args) {
    extern __shared__ __attribute__((aligned(16))) unsigned char lds_raw[];
    LAS unsigned char* lds = (LAS unsigned char*)lds_raw;
    volatile LAS unsigned* MISC = (volatile LAS unsigned*)(lds + MISC_OFF);
    LAS int* tab = (LAS int*)(lds + TAB_OFF);
    const int tid = threadIdx.x, lane = tid & 63, wave = __builtin_amdgcn_readfirstlane(tid >> 6);
    const int G = gridDim.x; const int bx = blockIdx.x; const int vcu = (G % 8 == 0) ? (bx % 8) * (G / 8) + bx / 8 : bx;
    const int gw = vcu * NWAVES + wave, NGW = G * NWAVES;
    Ptrs P;
    P.x = args.in[0]; P.w_in = args.in[1]; P.relb = args.in[2]; P.w_pool = args.in[3]; P.pscale = args.in[4]; P.w_ao = args.in[5]; P.w_po = args.in[6]; P.w_out = args.in[7];
    P.gains = args.in[8]; P.dwg = args.in[9]; P.dwu = args.in[10]; P.dwd = args.in[11]; P.wr = args.in[12]; P.mwg = args.in[13]; P.mwu = args.in[14]; P.mwd = args.in[15];
    P.out = args.out; P.ws = args.ws;
    unsigned char* ws = args.ws;
    gu32* ctl = (gu32*)(ws + WS_CTL);
    bf16* XN = (bf16*)(ws + WS_XN); bf16* Z = (bf16*)(ws + WS_Z); bf16* OG = (bf16*)(ws + WS_OG); bf16* OA = (bf16*)(ws + WS_OA); bf16* OP = (bf16*)(ws + WS_OP);
    bf16* TB = (bf16*)(ws + WS_T); bf16* MRG = (bf16*)(ws + WS_MRG); float* MIX = (float*)(ws + WS_MIX); float* LSE = (float*)(ws + WS_LSE);
    int* toke = (int*)(ws + WS_TOKE); int* tokp = (int*)(ws + WS_TOKP); float* tokw = (float*)(ws + WS_TOKW);
    for (int u = tid; u < (LDS_BYTES - LDSCTL_OFF) / 4; u += NWAVES * 64) ((LAS unsigned*)(lds + LDSCTL_OFF))[u] = 0u;
    __syncthreads();
    XcdBarrier bar; bar.bar = (unsigned*)(ctl + CW_BAR); bar.x = 0; bar.st = nullptr;
    if (!MK_SPLIT) bar = xcd_barrier_post((unsigned*)(ctl + CW_BAR), MISC + 8);
    const int lo = args.ph_lo, hi = args.ph_hi;
#define IN(k) (lo <= (k) && (k) < hi)
#define SEAM(k) do { if (IN(k) && IN((k) + 1)) xcd_barrier(bar); } while (0)
#define FRESH() int tid_ = threadIdx.x; asm volatile("" : "+v"(tid_)); const int lane_ = tid_ & 63, wave_ = __builtin_amdgcn_readfirstlane(tid_ >> 6), gw_ = vcu * NWAVES + wave_; (void)lane_; (void)wave_; (void)gw_

    if (IN(0)) { FRESH(); p0_convert(P, lds, gw_, NGW, wave_, lane_); norm_first(P.x, P.gains, XN, gw_, NGW, lane_); }
    SEAM(0);
    for (int layer = 0; layer < 2; ++layer) {
        const int pb = layer == 0 ? 1 : 10;
        const float* gl = P.gains + (size_t)layer * 4 * DM;
        if (IN(pb + 0)) {
            pg8::Gemm g{XN, (const bf16*)(ws + WS_WIN) + (size_t)layer * INW * DM, M, INW, DM}; pg8::StaticOrder S; S.init(M, INW, G, bx);
            pg8::EpiZ E{Z, INW, ZGA / 256};
            pg8::gemm_phase<pg8::EpiZ, pg8::StaticOrder, true, true>(lds + RING_OFF, g, S, E);
        }
        SEAM(pb + 0);
        if (IN(pb + 1)) { FRESH(); attn_phase(Z, P.relb, OG, LSE, lds, G, tid_, wave_, lane_); }
        SEAM(pb + 1);
        if (IN(pb + 2)) { FRESH(); combine_pool_phase(Z, OG, LSE, (const bf16*)(ws + WS_WPOOL) + (size_t)layer * 4 * 128 * 128, P.pscale + (size_t)layer * 512, OA, OP, gw_, NGW, lane_); }
        SEAM(pb + 2);
        if (IN(pb + 3)) {
            { pg8::Gemm g{OA, (const bf16*)(ws + WS_WAO) + (size_t)layer * DM * 512, M, DM, 512}; pg8::StaticOrder S; S.init(M, DM, G, bx);
              pg8::EpiGate<0> E{Z + ZGA, INW, nullptr, TB, DM};
              pg8::gemm_phase<pg8::EpiGate<0>, pg8::StaticOrder, true, true>(lds + RING_OFF, g, S, E); }
            { pg8::Gemm g{OP, (const bf16*)(ws + WS_WPO) + (size_t)layer * DM * 512, M, DM, 512}; pg8::StaticOrder S; S.init(M, DM, G, bx);
              pg8::EpiGate<1> E{Z + ZGB, INW, TB, MRG, DM};
              pg8::gemm_phase<pg8::EpiGate<1>, pg8::StaticOrder, true, true>(lds + RING_OFF, g, S, E); }
        }
        SEAM(pb + 3);
        if (IN(pb + 4)) {
            pg8::Gemm g{MRG, (const bf16*)(ws + WS_WOUT) + (size_t)layer * DM * DM, M, DM, DM}; pg8::StaticOrder S; S.init(M, DM, G, bx);
            pg8::EpiF32 E{MIX, DM};
            pg8::gemm_phase<pg8::EpiF32, pg8::StaticOrder, true, true>(lds + RING_OFF, g, S, E);
        }
        SEAM(pb + 4);
        if (IN(pb + 5)) {
            FRESH();
            if (layer == 0) norm_mid<false>(MIX, P.x, P.out, gl + DM, gl + 2 * DM, XN, nullptr, ctl, toke, tokp, tokw, gw_, NGW, lane_);
            else {
                LAS float* wrl = (LAS float*)(lds + RING_OFF);
                for (int i = tid_; i < DM * NEXP; i += NWAVES * 64) wrl[(i & 7) * DM + (i >> 3)] = P.wr[i];
                __syncthreads();
                norm_mid<true>(MIX, P.out, P.out, gl + DM, gl + 2 * DM, XN, wrl, ctl, toke, tokp, tokw, gw_, NGW, lane_);
            }
        }
        SEAM(pb + 5);
        if (layer == 0) {
            if (IN(7)) {
                pg8::Gemm g{XN, (const bf16*)(ws + WS_DGU), M, 2 * DFF, DM}; pg8::StaticOrder S; S.init(M, 2 * DFF, G, bx);
                pg8::EpiSwiGLU E{(bf16*)(ws + WS_HM), DFF};
                pg8::gemm_phase<pg8::EpiSwiGLU, pg8::StaticOrder, true, true>(lds + RING_OFF, g, S, E);
            }
            SEAM(7);
            if (IN(8)) {
                pg8::Gemm g{(const bf16*)(ws + WS_HM), (const bf16*)(ws + WS_DD), M, DM, DFF}; pg8::StaticOrder S; S.init(M, DM, G, bx);
                pg8::EpiF32 E{MIX, DM};
                pg8::gemm_phase<pg8::EpiF32, pg8::StaticOrder, true, true>(lds + RING_OFF, g, S, E);
            }
            SEAM(8);
            if (IN(9)) { FRESH(); norm_mid<false>(MIX, P.out, P.out, P.gains + 3 * DM, P.gains + 4 * DM, XN, nullptr, ctl, toke, tokp, tokw, gw_, NGW, lane_); }
            SEAM(9);
        } else {
            bf16* Xp = (bf16*)(ws + WS_XP); bf16* HMp = (bf16*)(ws + WS_HMP); float* Yp = (float*)(ws + WS_YP);
            if (IN(16)) { FRESH(); moe_tables(ctl, tab, tid_); moe_gather(XN, Xp, toke, tokp, tab, gw_, NGW, lane_); }
            SEAM(16);
            if (IN(17)) {
                if (MK_SPLIT) moe_tables(ctl, tab, tid);
                pg8::Gemm g{Xp, (const bf16*)(ws + WS_MGU), MPAD, 2 * EFF, DM}; pg8::MoeOrder S{__builtin_amdgcn_readfirstlane(tab[96]), (2 * EFF) / 256, G, bx, tab};
                pg8::EpiSwiGLU E{HMp, EFF};
                pg8::gemm_phase<pg8::EpiSwiGLU, pg8::MoeOrder, true, true>(lds + RING_OFF, g, S, E);
            }
            SEAM(17);
            if (IN(18)) {
                if (MK_SPLIT) moe_tables(ctl, tab, tid);
                pg8::Gemm g{HMp, (const bf16*)(ws + WS_MD), MPAD, DM, EFF}; pg8::MoeOrder S{__builtin_amdgcn_readfirstlane(tab[96]), DM / 256, G, bx, tab};
                pg8::EpiF32 E{Yp, DM};
                pg8::gemm_phase<pg8::EpiF32, pg8::MoeOrder, true, true>(lds + RING_OFF, g, S, E);
            }
            SEAM(18);
            if (IN(19)) {
                FRESH();
                if (MK_SPLIT) moe_tables(ctl, tab, tid_);
                norm_final(Yp, P.gains + (size_t)(4 + 3) * DM, P.out, toke, tokp, tokw, tab, gw_, NGW, lane_);
            }
        }
    }
#undef IN
#undef SEAM
}

extern "C" void kernel_launch(void* const* d_in, const int* in_sizes, int n_in, void* d_out, int out_size, void* d_ws, size_t ws_size, hipStream_t stream) {
    static int grid = 0;
    if (grid == 0) {
        if (n_in != 16 || out_size != M * DM || ws_size < WS_END) { fprintf(stderr, "kernel_launch: unexpected shapes (n_in %d out %d ws %zu, need %zu)\n", n_in, out_size, ws_size, (size_t)WS_END); grid = -1; return; }
        int dev = 0, cus = 0, per_cu = 0;
        if (hipGetDevice(&dev) != hipSuccess || hipDeviceGetAttribute(&cus, hipDeviceAttributeMultiprocessorCount, dev) != hipSuccess) { grid = -1; return; }
        if (hipFuncSetAttribute((const void*)mk_fwd, hipFuncAttributeMaxDynamicSharedMemorySize, LDS_BYTES) != hipSuccess) { fprintf(stderr, "kernel_launch: hipFuncSetAttribute failed\n"); grid = -1; return; }
        if (hipOccupancyMaxActiveBlocksPerMultiprocessor(&per_cu, (const void*)mk_fwd, NWAVES * 64, LDS_BYTES) != hipSuccess || per_cu < 1) { fprintf(stderr, "kernel_launch: occupancy query says %d\n", per_cu); }
        (void)hipGetLastError();
        grid = cus;
    }
    if (grid < 0) return;
    if (hipMemsetAsync((char*)d_ws + WS_CTL, 0, CTL_ZERO_BYTES, stream) != hipSuccess) return;
    Args a{};
    for (int i = 0; i < 16; ++i) a.in[i] = (const float*)d_in[i];
    a.out = (float*)d_out; a.ws = (unsigned char*)d_ws;
#if MK_SPLIT
    for (int ph = 0; ph < NPH; ++ph) { a.ph_lo = ph; a.ph_hi = ph + 1; hipLaunchKernelGGL(mk_fwd, dim3(grid), dim3(NWAVES * 64), LDS_BYTES, stream, a); }
#else
    a.ph_lo = 0; a.ph_hi = NPH;
    hipLaunchKernelGGL(mk_fwd, dim3(grid), dim3(NWAVES * 64), LDS_BYTES, stream, a);
#endif
    const hipError_t le = hipPeekAtLastError();
    if (le != hipSuccess) fprintf(stderr, "kernel_launch: launch failed: %s\n", hipGetErrorName(le));
}
```

```cpp
#include <hip/hip_runtime.h>
#include <cstdio>
#include <cstdint>
#ifndef MK_SPLIT
#define MK_SPLIT 0
#endif
namespace pg8 {
#define PG8_LAS __attribute__((address_space(3)))
typedef unsigned short bf16_t;
typedef short bf16x8 __attribute__((ext_vector_type(8)));
typedef float f32x4 __attribute__((ext_vector_type(4)));
typedef unsigned u32x4 __attribute__((ext_vector_type(4)));
typedef int i32x4 __attribute__((ext_vector_type(4)));
typedef int i32x8 __attribute__((ext_vector_type(8)));
constexpr int BM = 256, BK = 64, HALF = 128, HTB = HALF * BK * 2  , STAGE_BYTES = 8 * HTB, NXCD = 8, WGM = 8;

__host__ __device__ __forceinline__ int lds_byte(int r, int c) { const int st = (r >> 4) * 2 + (c >> 5), rr = r & 15, cc = c & 31, ob = rr * 64 + cc * 2; return st * 1024 + (ob ^ (((ob >> 9) & 1) << 5)); }
__host__ __device__ __forceinline__ void stage_rc(int b, int& R, int& C) { const int st = b / 1024, sb = b % 1024, swz = sb ^ (((sb >> 9) & 1) << 5); R = (st >> 1) * 16 + swz / 64; C = (st & 1) * 32 + (swz % 64) / 2; }
__host__ __device__ __forceinline__ int perm32(int rho) { const int n = rho >> 4, i = rho & 15; return 8 * (i >> 2) + 4 * n + (i & 3); }

struct Unit { int pm, pn, pb, ko, ks, pa; };
struct Gemm { const bf16_t* A; const bf16_t* Bt; int M, N, K, ld; };

struct StaticOrder {
    int nM, nN, nwg, G, c;
    __host__ __device__ void init(int M, int N, int G_, int c_) { nM = M / BM; nN = N / BM; nwg = nM * nN; G = G_; c = c_; }
    __host__ __device__ bool next(int i, Unit& u) const {
        const long L = (long)i * G + c; if (L >= nwg) return false;
        int wgid = (int)L; { const int q = nwg / NXCD, r = nwg % NXCD, xcd = wgid % NXCD, off = wgid / NXCD; wgid = (xcd < r ? xcd * (q + 1) : r * (q + 1) + (xcd - r) * q) + off; }
        const int nig = WGM * nN, gid = wgid / nig, fm = gid * WGM, gsz = (nM - fm) < WGM ? (nM - fm) : WGM;
        u.pm = fm + ((wgid % nig) % gsz); u.pn = (wgid % nig) / gsz; u.pb = u.pn; u.ko = 0; u.ks = 0; u.pa = u.pm; return true;
    }
    __device__ __forceinline__ void a_ready(const Unit&) const {}
    __device__ __forceinline__ void done(const Unit&) const {}
};

typedef __bf16 bf16x2_t __attribute__((ext_vector_type(2)));
__device__ __forceinline__ unsigned cvt_pk_bf16(float lo, float hi) { typedef float f32x2v __attribute__((ext_vector_type(2))); const f32x2v v = {lo, hi}; return __builtin_bit_cast(unsigned, __builtin_convertvector(v, bf16x2_t)); }
typedef float f32x2 __attribute__((ext_vector_type(2)));
__device__ __forceinline__ f32x2 gelu_pk(f32x2 v) {
    const f32x2 av = __builtin_elementwise_abs(v), d = av * 0.2316418882f + 1.0f;
    f32x2 t; t.x = __builtin_amdgcn_rcpf(d.x); t.y = __builtin_amdgcn_rcpf(d.y);
    f32x2 q = t * 0.5307027145f + (-0.7265760135f); q = q * t + 0.7107068705f; q = q * t + (-0.142248368f); q = q * t + 0.127414796f; q = q * t;
    const f32x2 s = (v * v) * (-0.72134752044f);
    f32x2 e; e.x = __builtin_amdgcn_exp2f(s.x); e.y = __builtin_amdgcn_exp2f(s.y);
    const f32x2 m = v * (q * e), r = v - m;
    f32x2 o; o.x = v.x < 0.f ? m.x : r.x; o.y = v.y < 0.f ? m.y : r.y; return o;
}

__device__ __forceinline__ f32x2 sigmoid_pk(f32x2 x, float c1) { const f32x2 t = x * c1; f32x2 e; e.x = __builtin_amdgcn_exp2f(t.x); e.y = __builtin_amdgcn_exp2f(t.y); const f32x2 d = e + 1.0f;
    f32x2 r; r.x = __builtin_amdgcn_rcpf(d.x); r.y = __builtin_amdgcn_rcpf(d.y); return r; }
__device__ __forceinline__ f32x2 swiglu_pk(f32x2 a, f32x2 b, float c1, float k2) { return (a * b) * (sigmoid_pk(a, c1) * k2); }
__device__ __forceinline__ float sigmoid_f(float v) { return __builtin_amdgcn_rcpf(1.0f + __builtin_amdgcn_exp2f(-1.4426950408889634f * v)); }
__device__ __forceinline__ float bf_lo(unsigned w) { return __uint_as_float(w << 16); }
__device__ __forceinline__ float bf_hi(unsigned w) { return __uint_as_float(w & 0xffff0000u); }
struct EpiZ {
    static constexpr bool PERM = true, AFTER_DRAIN = false;
    bf16_t* O; int ldc; int col_off; float sc; int sig_from; int gap;
    __device__ __forceinline__ void operator()(const f32x4 (&acc)[2][2][4][2], const Unit& u, int wr, int wc, int fr, int fq) const {
        const bool sg = u.pn >= sig_from;
        const int row0 = u.pm * BM + wr * 64 + fr, col0 = col_off + u.pn * BM + (sg ? gap : 0) + wc * 32 + 8 * fq;
#pragma unroll
        for (int ai = 0; ai < 2; ++ai)
#pragma unroll
            for (int m = 0; m < 4; ++m) { bf16_t* rowp = O + (size_t)(row0 + ai * HALF + m * 16) * ldc + col0;
#pragma unroll
                for (int bj = 0; bj < 2; ++bj) { f32x4 v0, v1;
                    if (sg) { const float c1 = -1.4426950408889634f * sc; const f32x4 x0 = acc[ai][bj][m][0], x1 = acc[ai][bj][m][1];
                        const f32x2 a = sigmoid_pk((f32x2){x0[0], x0[1]}, c1), b = sigmoid_pk((f32x2){x0[2], x0[3]}, c1), c = sigmoid_pk((f32x2){x1[0], x1[1]}, c1), d = sigmoid_pk((f32x2){x1[2], x1[3]}, c1);
                        v0 = (f32x4){a.x, a.y, b.x, b.y}; v1 = (f32x4){c.x, c.y, d.x, d.y}; }
                    else { v0 = acc[ai][bj][m][0] * sc; v1 = acc[ai][bj][m][1] * sc; }
                    u32x4 w; w.x = cvt_pk_bf16(v0[0], v0[1]); w.y = cvt_pk_bf16(v0[2], v0[3]); w.z = cvt_pk_bf16(v1[0], v1[1]); w.w = cvt_pk_bf16(v1[2], v1[3]);
                    *(u32x4*)(rowp + bj * HALF) = w; } }
    }
};
template <int MODE> struct EpiGate {
    static constexpr bool PERM = true, AFTER_DRAIN = false;
    const bf16_t* G; int ldg; const bf16_t* Tin; bf16_t* O; int ldc;
    __device__ __forceinline__ void operator()(const f32x4 (&acc)[2][2][4][2], const Unit& u, int wr, int wc, int fr, int fq) const {
        const int row0 = u.pm * BM + wr * 64 + fr, col0 = u.pn * BM + wc * 32 + 8 * fq;
#pragma unroll
        for (int ai = 0; ai < 2; ++ai)
#pragma unroll
          for (int mh = 0; mh < 2; ++mh) {
            u32x4 gw[2][2], tw[2][2];
#pragma unroll
            for (int mm = 0; mm < 2; ++mm)
#pragma unroll
                for (int bj = 0; bj < 2; ++bj) { const size_t row = (size_t)(row0 + ai * HALF + (2 * mh + mm) * 16); const int col = col0 + bj * HALF;
                    gw[mm][bj] = *(const u32x4*)(G + row * ldg + col); if (MODE == 1) tw[mm][bj] = *(const u32x4*)(Tin + row * ldc + col); }
            __builtin_amdgcn_sched_barrier(0);
#pragma unroll
            for (int mm = 0; mm < 2; ++mm)
#pragma unroll
                for (int bj = 0; bj < 2; ++bj) { const int m = 2 * mh + mm; const size_t row = (size_t)(row0 + ai * HALF + m * 16); const int col = col0 + bj * HALF; const u32x4 g4 = gw[mm][bj];
                    f32x4 v0 = acc[ai][bj][m][0], v1 = acc[ai][bj][m][1];
                    v0[0] *= bf_lo(g4.x); v0[1] *= bf_hi(g4.x); v0[2] *= bf_lo(g4.y); v0[3] *= bf_hi(g4.y);
                    v1[0] *= bf_lo(g4.z); v1[1] *= bf_hi(g4.z); v1[2] *= bf_lo(g4.w); v1[3] *= bf_hi(g4.w);
                    if (MODE == 1) { const u32x4 t4 = tw[mm][bj];
                        v0[0] += bf_lo(t4.x); v0[1] += bf_hi(t4.x); v0[2] += bf_lo(t4.y); v0[3] += bf_hi(t4.y);
                        v1[0] += bf_lo(t4.z); v1[1] += bf_hi(t4.z); v1[2] += bf_lo(t4.w); v1[3] += bf_hi(t4.w); }
                    u32x4 w; w.x = cvt_pk_bf16(v0[0], v0[1]); w.y = cvt_pk_bf16(v0[2], v0[3]); w.z = cvt_pk_bf16(v1[0], v1[1]); w.w = cvt_pk_bf16(v1[2], v1[3]);
                    *(u32x4*)(O + row * ldc + col) = w; }
            __builtin_amdgcn_sched_barrier(0);
          }
    }
};
struct EpiF32 {
    static constexpr bool PERM = false, AFTER_DRAIN = false;
    float* C; int ldc;
    __device__ __forceinline__ void operator()(const f32x4 (&acc)[2][2][4][2], const Unit& u, int wr, int wc, int fr, int fq) const {
        const int row0 = u.pm * BM + wr * 64 + fr, col0 = u.pn * BM + wc * 32 + 4 * fq;
#pragma unroll
        for (int ai = 0; ai < 2; ++ai)
#pragma unroll
            for (int m = 0; m < 4; ++m) { float* rowp = C + (size_t)(row0 + ai * HALF + m * 16) * ldc + col0;
#pragma unroll
                for (int bj = 0; bj < 2; ++bj)
#pragma unroll
                    for (int n = 0; n < 2; ++n) *(f32x4*)(rowp + bj * HALF + n * 16) = acc[ai][bj][m][n]; }
    }
};
struct EpiSwiGLU {
    static constexpr bool PERM = true, AFTER_DRAIN = false;
    bf16_t* O; int ldo; float sc;
    __device__ __forceinline__ void operator()(const f32x4 (&acc)[2][2][4][2], const Unit& u, int wr, int wc, int fr, int fq) const {
        const int row0 = u.pm * BM + wr * 64 + fr, col0 = u.pn * HALF + wc * 32 + 8 * fq;
#pragma unroll
        for (int ai = 0; ai < 2; ++ai)
#pragma unroll
            for (int m = 0; m < 4; ++m) { bf16_t* rowp = O + (size_t)(row0 + ai * HALF + m * 16) * ldo + col0;
                f32x4 v0, v1;
                { const f32x4 g0 = acc[ai][0][m][0], g1 = acc[ai][0][m][1], u0 = acc[ai][1][m][0], u1 = acc[ai][1][m][1]; const float c1 = -1.4426950408889634f * sc, k2 = sc * sc;
                  const f32x2 a = swiglu_pk((f32x2){g0[0], g0[1]}, (f32x2){u0[0], u0[1]}, c1, k2), b = swiglu_pk((f32x2){g0[2], g0[3]}, (f32x2){u0[2], u0[3]}, c1, k2),
                              c = swiglu_pk((f32x2){g1[0], g1[1]}, (f32x2){u1[0], u1[1]}, c1, k2), d = swiglu_pk((f32x2){g1[2], g1[3]}, (f32x2){u1[2], u1[3]}, c1, k2);
                  v0 = (f32x4){a.x, a.y, b.x, b.y}; v1 = (f32x4){c.x, c.y, d.x, d.y}; }
                u32x4 w; w.x = cvt_pk_bf16(v0[0], v0[1]); w.y = cvt_pk_bf16(v0[2], v0[3]); w.z = cvt_pk_bf16(v1[0], v1[1]); w.w = cvt_pk_bf16(v1[2], v1[3]);
                *(u32x4*)rowp = w; __builtin_amdgcn_sched_barrier(0); }
    }
};
__device__ __forceinline__ float clamp8(float v) { return __builtin_fminf(__builtin_fmaxf(v, -440.f), 440.f); }
__device__ __forceinline__ unsigned pack4_fp8(float a, float b, float c, float d) { int w = __builtin_amdgcn_cvt_pk_fp8_f32(clamp8(a), clamp8(b), 0, false); w = __builtin_amdgcn_cvt_pk_fp8_f32(clamp8(c), clamp8(d), w, true); return (unsigned)w; }
struct EpiSwiGLU8 {
    static constexpr bool PERM = true, AFTER_DRAIN = false;
    unsigned char* O; int ldo; float sc;
    __device__ __forceinline__ void operator()(const f32x4 (&acc)[2][2][4][2], const Unit& u, int wr, int wc, int fr, int fq) const {
        const int row0 = u.pm * BM + wr * 64 + fr, col0 = u.pn * HALF + wc * 32 + 8 * fq;
#pragma unroll
        for (int ai = 0; ai < 2; ++ai)
#pragma unroll
            for (int m = 0; m < 4; ++m) { unsigned char* rowp = O + (size_t)(row0 + ai * HALF + m * 16) * ldo + col0;
                f32x4 v0, v1;
                { const f32x4 g0 = acc[ai][0][m][0], g1 = acc[ai][0][m][1], u0 = acc[ai][1][m][0], u1 = acc[ai][1][m][1]; const float c1 = -1.4426950408889634f * sc, k2 = sc * sc;
                  const f32x2 a = swiglu_pk((f32x2){g0[0], g0[1]}, (f32x2){u0[0], u0[1]}, c1, k2), b = swiglu_pk((f32x2){g0[2], g0[3]}, (f32x2){u0[2], u0[3]}, c1, k2),
                              c = swiglu_pk((f32x2){g1[0], g1[1]}, (f32x2){u1[0], u1[1]}, c1, k2), d = swiglu_pk((f32x2){g1[2], g1[3]}, (f32x2){u1[2], u1[3]}, c1, k2);
                  v0 = (f32x4){a.x, a.y, b.x, b.y}; v1 = (f32x4){c.x, c.y, d.x, d.y}; }
                typedef unsigned u32x2 __attribute__((ext_vector_type(2)));
                u32x2 w; w.x = pack4_fp8(v0[0], v0[1], v0[2], v0[3]); w.y = pack4_fp8(v1[0], v1[1], v1[2], v1[3]);
                *(u32x2*)rowp = w; __builtin_amdgcn_sched_barrier(0); }
    }
};
struct EpiYp {
    static constexpr bool PERM = true, AFTER_DRAIN = false;
    bf16_t* C; int ldc; float sc; bf16_t* Ct; int pm0;
    __device__ __forceinline__ void operator()(const f32x4 (&acc)[2][2][4][2], const Unit& u, int wr, int wc, int fr, int fq) const {
        const int row0 = u.pm * BM + wr * 64 + fr, col0 = u.pn * BM + wc * 32 + 8 * fq;
        bf16_t* base = u.ks == 0 ? C + (size_t)row0 * ldc : Ct + ((size_t)(u.ks - 1) * 2048 + (row0 - pm0 * BM)) * ldc;
#pragma unroll
        for (int ai = 0; ai < 2; ++ai)
#pragma unroll
            for (int m = 0; m < 4; ++m) { bf16_t* rowp = base + (size_t)(ai * HALF + m * 16) * ldc + col0;
#pragma unroll
                for (int bj = 0; bj < 2; ++bj) { const f32x4 v0 = acc[ai][bj][m][0] * sc, v1 = acc[ai][bj][m][1] * sc;
                    u32x4 w; w.x = cvt_pk_bf16(v0[0], v0[1]); w.y = cvt_pk_bf16(v0[2], v0[3]); w.z = cvt_pk_bf16(v1[0], v1[1]); w.w = cvt_pk_bf16(v1[2], v1[3]);
                    *(u32x4*)(rowp + bj * HALF) = w; } }
    }
};
struct MoeOrder {
    int P, NT, G, c; const PG8_LAS int* pexp;
    int acap;
    int pm0, NTC, kbytes;
    __device__ __forceinline__ bool next(int i, Unit& u) const {
        const int U = ((i * 8 + (c & 7)) * 32) + (c >> 3); if (U >= P * NT) return false;
        const int gsz = 4 * NT, g = U / gsz, up = U - g * gsz; int pl = P - 4 * g; pl = pl > 4 ? 4 : pl;
        const int blk = pl * 8, j = up / blk, rr = up - j * blk, v = 8 * j + rr / pl;
        u.pm = pm0 + 4 * g + rr % pl; u.ks = v / NTC; u.pn = v - u.ks * NTC; u.ko = u.ks * kbytes; const int e = __builtin_amdgcn_readfirstlane(pexp[u.pm]); u.pb = e * NTC + u.pn;
        u.pa = acap ? e * acap + u.pm - (__builtin_amdgcn_readfirstlane(pexp[80 + e]) >> 8) : u.pm; return true;
    }
    __device__ __forceinline__ void a_ready(const Unit&) const {}
    __device__ __forceinline__ void done(const Unit&) const {}
};

template <class S> struct SubOrder {
    S s; int lo, hi;
    __device__ __forceinline__ bool next(int i, Unit& u) const { return (lo + i < hi) && s.next(lo + i, u); }
    __device__ __forceinline__ void a_ready(const Unit& u) const { s.a_ready(u); }
    __device__ __forceinline__ void done(const Unit& u) const { s.done(u); }
};

template <bool F8> struct Frag;
template <> struct Frag<false> { bf16x8 v[2]; __device__ __forceinline__ void set(int k, bf16x8 x) { v[k] = x; } };
template <> struct Frag<true> { i32x8 w; __device__ __forceinline__ void set(int k, bf16x8 x) { if (k == 0) w.lo = __builtin_bit_cast(i32x4, x); else w.hi = __builtin_bit_cast(i32x4, x); } };
template <class Epi, class Sched, bool ALIGN_EPI = false, bool SP2 = false, bool FP8 = false>
__device__ __forceinline__ void gemm_phase(PG8_LAS unsigned char* lds, const Gemm g, const Sched& S, const Epi& E) {
    int tid = threadIdx.x; asm volatile("" : "+v"(tid));
    const int wid = __builtin_amdgcn_readfirstlane(tid >> 6), lane = tid & 63, wr = wid >> 2, wc = wid & 3, fr = lane & 15, fq = lane >> 4;
    const int K = g.K, nt = K / BK, LD = g.ld ? g.ld : g.K;
    unsigned voffA[2], voffB[2];
#pragma unroll
    for (int i = 0; i < 2; ++i) { int R, C; stage_rc(tid * 16 + i * 8192, R, C); const int Rb = Epi::PERM ? ((R & ~31) + perm32(R & 31)) : R;
        voffA[i] = (unsigned)(R * LD + C) * 2u; voffB[i] = (unsigned)(Rb * LD + C) * 2u; }
    const size_t kstep = (size_t)(BK * 2);
    const size_t hstep = (size_t)HALF * LD * 2;
    const size_t tstep = 2 * hstep;
    const unsigned ldsw = (unsigned)wid * 1024u;
    const int aoff = lds_byte(wr * 64 + fr, fq * 8), boff = lds_byte(wc * 32 + fr, fq * 8);
#define PG8_SA(b, h) (((b) * 2 + (h)) * HTB)
#define PG8_SB(b, h) ((4 + (b) * 2 + (h)) * HTB)
#define PG8_STAGE(bufoff, gbase, voff) do { _Pragma("unroll") for (int _i = 0; _i < 2; ++_i) \
        __builtin_amdgcn_global_load_lds((const unsigned*)((const char*)(gbase) + (voff)[_i]), (PG8_LAS unsigned*)(lds + (bufoff) + ldsw + _i * 8192), 16, 0, 0); } while (0)
#define PG8_LDA(dst, b, h) do { _Pragma("unroll") for (int m = 0; m < 4; ++m) _Pragma("unroll") for (int k = 0; k < 2; ++k) dst[m].set(k, *(const PG8_LAS bf16x8*)(lds + PG8_SA(b, h) + aoff + m * 2048 + k * 1024)); } while (0)
#define PG8_LDB(dst, b, h) do { _Pragma("unroll") for (int n = 0; n < 2; ++n) _Pragma("unroll") for (int k = 0; k < 2; ++k) dst[n].set(k, *(const PG8_LAS bf16x8*)(lds + PG8_SB(b, h) + boff + n * 2048 + k * 1024)); } while (0)
#define PG8_MMA(ai, bj, At, Bt) do { __builtin_amdgcn_s_setprio(1); _Pragma("unroll") for (int m = 0; m < 4; ++m) _Pragma("unroll") for (int n = 0; n < 2; ++n) { \
        if constexpr (FP8) asm volatile("v_mfma_scale_f32_16x16x128_f8f6f4 %0, %1, %2, %0, %3, %3 op_sel_hi:[0,0,0]" : "+v"(acc[ai][bj][m][n]) : "v"(Bt[n].w), "v"(At[m].w), "v"(sc1));   \
        else { _Pragma("unroll") for (int k = 0; k < 2; ++k) acc[ai][bj][m][n] = __builtin_amdgcn_mfma_f32_16x16x32_bf16(Bt[n].v[k], At[m].v[k], acc[ai][bj][m][n], 0, 0, 0); } } __builtin_amdgcn_s_setprio(0); } while (0)
#define PG8_MMAZ(ai, bj, At, Bt) do { __builtin_amdgcn_s_setprio(1); _Pragma("unroll") for (int m = 0; m < 4; ++m) _Pragma("unroll") for (int n = 0; n < 2; ++n) { \
        if constexpr (FP8) asm volatile("v_mfma_scale_f32_16x16x128_f8f6f4 %0, %1, %2, 0, %3, %3 op_sel_hi:[0,0,0]" : "=&v"(acc[ai][bj][m][n]) : "v"(Bt[n].w), "v"(At[m].w), "v"(sc1)); \
        else { acc[ai][bj][m][n] = __builtin_amdgcn_mfma_f32_16x16x32_bf16(Bt[n].v[0], At[m].v[0], (f32x4){0.f, 0.f, 0.f, 0.f}, 0, 0, 0); \
               acc[ai][bj][m][n] = __builtin_amdgcn_mfma_f32_16x16x32_bf16(Bt[n].v[1], At[m].v[1], acc[ai][bj][m][n], 0, 0, 0); } } __builtin_amdgcn_s_setprio(0); } while (0)
#define PG8_WAIT_V(n) asm volatile("s_waitcnt vmcnt(" #n ")" ::: "memory")
#define PG8_WAIT_L(n) asm volatile("s_waitcnt lgkmcnt(" #n ")" ::: "memory")
#define PG8_BAR __builtin_amdgcn_s_barrier()
#define PG8_SCHED __builtin_amdgcn_sched_barrier(0)
    Unit cur, nxt; int ui = 0;
    if (!S.next(0, cur)) return;
    f32x4 acc[2][2][4][2];
#pragma unroll
    for (int a = 0; a < 2; ++a)
#pragma unroll
        for (int b = 0; b < 2; ++b)
#pragma unroll
            for (int m = 0; m < 4; ++m)
#pragma unroll
                for (int n = 0; n < 2; ++n) { if constexpr (SP2 && FP8) asm volatile("" : "=v"(acc[a][b][m][n])); else acc[a][b][m][n] = (f32x4){0.f, 0.f, 0.f, 0.f}; }
    Frag<FP8> At[4], B0[2], B1[2];
    int sc1 = 0x7f7f7f7f; asm volatile("" : "+v"(sc1));
    (void)sc1;
    const char* cA = (const char*)g.A + (size_t)cur.pa * tstep + cur.ko; const char* cB = (const char*)g.Bt + (size_t)cur.pb * tstep + cur.ko;
    asm volatile("" : "+v"(voffA[0]), "+v"(voffA[1]), "+v"(voffB[0]), "+v"(voffB[1]));
    S.a_ready(cur);
    if constexpr (SP2) {
        PG8_STAGE(PG8_SB(0, 0), cB, voffB); PG8_STAGE(PG8_SB(0, 1), cB + hstep, voffB); PG8_STAGE(PG8_SA(0, 0), cA, voffA); PG8_STAGE(PG8_SA(0, 1), cA + hstep, voffA);
        if (wr == 1) PG8_BAR;
        PG8_WAIT_V(2); PG8_BAR;
        PG8_STAGE(PG8_SB(1, 0), cB + kstep, voffB); PG8_STAGE(PG8_SA(1, 0), cA + kstep, voffA); PG8_STAGE(PG8_SB(1, 1), cB + hstep + kstep, voffB);
        PG8_WAIT_V(6); PG8_BAR;
    } else {
        PG8_STAGE(PG8_SB(0, 0), cB, voffB); PG8_STAGE(PG8_SA(0, 0), cA, voffA); PG8_STAGE(PG8_SB(0, 1), cB + hstep, voffB); PG8_STAGE(PG8_SA(0, 1), cA + hstep, voffA);
        if (wr == 1) PG8_BAR;
        PG8_WAIT_V(4); PG8_BAR;
        PG8_STAGE(PG8_SB(1, 0), cB + kstep, voffB); PG8_STAGE(PG8_SA(1, 0), cA + kstep, voffA); PG8_STAGE(PG8_SB(1, 1), cB + hstep + kstep, voffB);
        PG8_WAIT_V(6); PG8_BAR;
    }
    for (;;) {
        const bool has_next = S.next(ui + 1, nxt);
        const char* nA = has_next ? (const char*)g.A + (size_t)nxt.pa * tstep + nxt.ko : cA; const char* nB = has_next ? (const char*)g.Bt + (size_t)nxt.pb * tstep + nxt.ko : cB;
        for (int t = 0; t < nt; t += 2) {
            const bool last = (t == nt - 2);
            const char* a1 = cA + (size_t)(t + 1) * kstep;
            const char* a2 = last ? nA : cA + (size_t)(t + 2) * kstep; const char* b2 = last ? nB : cB + (size_t)(t + 2) * kstep;
            const char* a3 = a2 + kstep; const char* b3 = b2 + kstep;
            if (last && has_next) S.a_ready(nxt);
            if constexpr (SP2) {
            PG8_LDB(B0, 0, 0); PG8_LDB(B1, 0, 1); PG8_SCHED; PG8_LDA(At, 0, 0); PG8_STAGE(PG8_SA(1, 1), a1 + hstep, voffA);
            PG8_WAIT_V(8); PG8_WAIT_L(0); PG8_BAR; if (FP8 && t == 0) { PG8_MMAZ(0, 0, At, B0); PG8_MMAZ(0, 1, At, B1); } else { PG8_MMA(0, 0, At, B0); PG8_MMA(0, 1, At, B1); } PG8_BAR; PG8_SCHED;
            PG8_LDA(At, 0, 1); PG8_STAGE(PG8_SB(0, 0), b2, voffB); PG8_STAGE(PG8_SB(0, 1), b2 + hstep, voffB); PG8_STAGE(PG8_SA(0, 0), a2, voffA);
            PG8_WAIT_V(8); PG8_WAIT_L(0); PG8_BAR; if (FP8 && t == 0) { PG8_MMAZ(1, 0, At, B0); PG8_MMAZ(1, 1, At, B1); } else { PG8_MMA(1, 0, At, B0); PG8_MMA(1, 1, At, B1); } PG8_BAR; PG8_SCHED;
            PG8_LDB(B0, 1, 0); PG8_LDB(B1, 1, 1); PG8_SCHED; PG8_LDA(At, 1, 0); PG8_STAGE(PG8_SA(0, 1), a2 + hstep, voffA);
            PG8_WAIT_V(8); PG8_WAIT_L(0); PG8_BAR; PG8_MMA(0, 0, At, B0); PG8_MMA(0, 1, At, B1); PG8_BAR; PG8_SCHED;
            PG8_LDA(At, 1, 1); PG8_STAGE(PG8_SB(1, 0), b3, voffB); PG8_STAGE(PG8_SB(1, 1), b3 + hstep, voffB); PG8_STAGE(PG8_SA(1, 0), a3, voffA);
            PG8_WAIT_V(8); PG8_WAIT_L(0); PG8_BAR; PG8_MMA(1, 0, At, B0); PG8_MMA(1, 1, At, B1); PG8_BAR; PG8_SCHED;
            } else {
            PG8_LDB(B0, 0, 0); PG8_SCHED; PG8_LDA(At, 0, 0); PG8_STAGE(PG8_SA(1, 1), a1 + hstep, voffA);
            PG8_WAIT_L(8); PG8_BAR; PG8_WAIT_L(0); PG8_MMA(0, 0, At, B0); PG8_BAR; PG8_SCHED;
            PG8_LDB(B1, 0, 1); PG8_STAGE(PG8_SB(0, 0), b2, voffB);
            PG8_BAR; PG8_WAIT_L(0); PG8_MMA(0, 1, At, B1); PG8_BAR;
            PG8_LDA(At, 0, 1); PG8_STAGE(PG8_SA(0, 0), a2, voffA);
            PG8_BAR; PG8_WAIT_L(0); PG8_MMA(1, 0, At, B0); PG8_BAR; PG8_SCHED;
            PG8_STAGE(PG8_SB(0, 1), b2 + hstep, voffB);
            PG8_WAIT_V(6); PG8_BAR; PG8_MMA(1, 1, At, B1); PG8_BAR;
            PG8_LDB(B0, 1, 0); PG8_SCHED; PG8_LDA(At, 1, 0); PG8_STAGE(PG8_SA(0, 1), a2 + hstep, voffA);
            PG8_WAIT_L(8); PG8_BAR; PG8_WAIT_L(0); PG8_MMA(0, 0, At, B0); PG8_BAR; PG8_SCHED;
            PG8_LDB(B1, 1, 1); PG8_STAGE(PG8_SB(1, 0), b3, voffB);
            PG8_BAR; PG8_WAIT_L(0); PG8_MMA(0, 1, At, B1); PG8_BAR;
            PG8_LDA(At, 1, 1); PG8_STAGE(PG8_SA(1, 0), a3, voffA);
            PG8_BAR; PG8_WAIT_L(0); PG8_MMA(1, 0, At, B0); PG8_BAR; PG8_SCHED;
            PG8_STAGE(PG8_SB(1, 1), b3 + hstep, voffB);
            PG8_WAIT_V(6); PG8_BAR; PG8_MMA(1, 1, At, B1); PG8_BAR;
            }
        }
        if constexpr (FP8) asm volatile("s_nop 7\n\ts_nop 7\n\ts_nop 7" ::: "memory");
        if constexpr (FP8) {
#pragma unroll
            for (int a = 0; a < 2; ++a)
#pragma unroll
                for (int b = 0; b < 2; ++b)
#pragma unroll
                    for (int m = 0; m < 4; ++m)
#pragma unroll
                        for (int n = 0; n < 2; ++n) asm volatile("" : "+v"(acc[a][b][m][n]));
        }
        if constexpr (ALIGN_EPI) { if (wr == 0) PG8_BAR; }
        if constexpr (!Epi::AFTER_DRAIN) { E(acc, cur, wr, wc, fr, fq); S.done(cur); }
        if (!has_next) break;
#pragma unroll
        for (int a = 0; a < 2; ++a)
#pragma unroll
            for (int b = 0; b < 2; ++b)
#pragma unroll
                for (int m = 0; m < 4; ++m)
#pragma unroll
                    for (int n = 0; n < 2; ++n) { if constexpr (!(SP2 && FP8)) acc[a][b][m][n] = (f32x4){0.f, 0.f, 0.f, 0.f}; }
        cur = nxt; cA = nA; cB = nB; ++ui;
        if constexpr (ALIGN_EPI) { if (wr == 1) PG8_BAR; }
    }
    PG8_WAIT_V(0);
    if constexpr (!ALIGN_EPI) { if (wr == 0) PG8_BAR; }
    PG8_BAR;
    if constexpr (Epi::AFTER_DRAIN) { E.fused(acc, cur, wr, wc, fr, fq, lds, wid, lane); S.done(cur); }
#undef PG8_SA
#undef PG8_SB
#undef PG8_STAGE
#undef PG8_LDA
#undef PG8_LDB
#undef PG8_MMA
#undef PG8_MMAZ
#undef PG8_WAIT_V
#undef PG8_WAIT_L
#undef PG8_BAR
#undef PG8_SCHED
}
}
constexpr int NWAVES = 8;
constexpr int BATCH = 2, SEQ = 4096, DM = 2048, M = BATCH * SEQ;
constexpr int INW = 9216, ZQ = 0, ZK = 1536, ZV = 3072, ZP = 4608, ZGA = 5120, ZGB = 7168;
constexpr int DFF = 5632, EFF = 7168, NEXP = 8;
constexpr int XCAP = M;
constexpr int MPAD = 2 * M + NEXP * 256;
constexpr float RMS_EPS = 1e-6f;
constexpr int NPH = 20;
constexpr size_t MiB = 1u << 20;
constexpr size_t WS_CTL = 0, CTL_ZERO_BYTES = 1 * MiB;
constexpr size_t WS_LSE = 1 * MiB, WS_TOKE = WS_LSE + 512 * 1024, WS_TOKP = WS_TOKE + 64 * 1024, WS_TOKW = WS_TOKP + 64 * 1024;
constexpr size_t WS_WIN = 2 * MiB;
constexpr size_t WS_WAO = WS_WIN + 72 * MiB;
constexpr size_t WS_WPO = WS_WAO + 4 * MiB;
constexpr size_t WS_WOUT = WS_WPO + 4 * MiB;
constexpr size_t WS_WPOOL = WS_WOUT + 16 * MiB;
constexpr size_t WS_DGU = WS_WPOOL + 1 * MiB;
constexpr size_t WS_DD = WS_DGU + 44 * MiB;
constexpr size_t WS_MGU = WS_DD + 22 * MiB;
constexpr size_t WS_MD = WS_MGU + 448 * MiB;
constexpr size_t WS_XN = WS_MD + 224 * MiB;
constexpr size_t WS_A = WS_XN + 32 * MiB;
constexpr size_t WS_Z = WS_A, WS_OG = WS_A + 144 * MiB, WS_OA = WS_A + 168 * MiB, WS_OP = WS_A + 176 * MiB, WS_HM = WS_A, WS_HMP = WS_A;
constexpr size_t WS_B = WS_A + 252 * MiB;
constexpr size_t WS_T = WS_B, WS_MRG = WS_B + 32 * MiB, WS_MIX = WS_B + 64 * MiB, WS_YP = WS_B;
constexpr size_t WS_XP = WS_WIN;
static_assert(WS_XP + (size_t)NEXP * XCAP * DM <= WS_MGU, "Xp must end before the MoE weight copies");
constexpr size_t WS_YT = WS_B + 144 * MiB;
constexpr size_t WS_WIN8 = WS_YT + 48 * MiB;
constexpr size_t WS_XN8 = WS_WIN8 + 32 * MiB;
constexpr size_t WS_HB = WS_XN8 + 16 * MiB;
constexpr size_t WS_END = WS_HB + 32 * MiB;
static_assert((size_t)MPAD * EFF * 2 <= 252 * MiB && (size_t)MPAD * DM * 4 <= 144 * MiB && (size_t)M * INW * 2 <= 144 * MiB, "arena sizes");
constexpr int CW_TMO = 0, CW_CODE = 1;
constexpr int CW_BAR = 4096;
constexpr int CW_CNT = 8192;
constexpr int RING_OFF = 0, RING_BYTES = 131072;
constexpr int LDSCTL_OFF = RING_BYTES, MISC_OFF = LDSCTL_OFF + 320, TAB_OFF = LDSCTL_OFF + 512;
constexpr int LDS_BYTES = 147456;

#define GAS __attribute__((address_space(1)))
#define LAS __attribute__((address_space(3)))
typedef unsigned short bf16;
typedef unsigned v4u __attribute__((ext_vector_type(4)));
typedef unsigned v2u __attribute__((ext_vector_type(2)));
typedef float f32x4 __attribute__((ext_vector_type(4)));
typedef short bf16x8 __attribute__((ext_vector_type(8)));
typedef short bf16x4 __attribute__((ext_vector_type(4)));
typedef GAS unsigned gu32;
#define RLX_AGENT __ATOMIC_RELAXED, __HIP_MEMORY_SCOPE_AGENT
#define LDS_WAIT() asm volatile("s_waitcnt lgkmcnt(0)" ::: "memory")
#define VM_WAIT() asm volatile("s_waitcnt vmcnt(0)" ::: "memory")
__device__ __forceinline__ unsigned f2bf(float f) { unsigned u = __builtin_bit_cast(unsigned, f); return (u + 0x7fffu + ((u >> 16) & 1u)) >> 16; }
__device__ __forceinline__ unsigned pk2(float lo, float hi) { return pg8::cvt_pk_bf16(lo, hi); }
__device__ __forceinline__ float bflo(unsigned w) { return __uint_as_float(w << 16); }
__device__ __forceinline__ float bfhi(unsigned w) { return __uint_as_float(w & 0xffff0000u); }
#define XB_TMO      128
#define XB_XCNT(j)  (256  + 64 * (j))
#define XB_XSUB(j)  (1280 + 64 * (j))
#define XB_XGEN(j)  (2304 + 64 * (j))
#define XB_TOP      3328
#define XB_TOPGEN   3392
#define XCD_BAR_WORDS 3456
#define XB_SPIN_CAP (1u << 18)

__device__ __forceinline__ unsigned xb_ld(unsigned* p)              { return __hip_atomic_load(p, __ATOMIC_RELAXED, __HIP_MEMORY_SCOPE_AGENT); }
__device__ __forceinline__ unsigned xb_add(unsigned* p, unsigned v) { return __hip_atomic_fetch_add(p, v, __ATOMIC_RELAXED, __HIP_MEMORY_SCOPE_AGENT); }
__device__ __forceinline__ unsigned xb_xcc_id() { return (unsigned)__builtin_amdgcn_s_getreg((3 << 11) | 20) & 0xFu; }
#define XB_SPIN(cond, bar) do { unsigned _sp = 0; while (cond) { __builtin_amdgcn_s_sleep(1); \
    if ((++_sp & 255u) == 0u) { if (xb_ld(&(bar)[XB_TMO])) break; if (_sp > XB_SPIN_CAP) { atomicAdd(&(bar)[XB_TMO], 1u); break; } } } } while (0)

struct XcdBarrier {
    unsigned* bar; unsigned x;
    volatile LAS unsigned* st;
};

__device__ __forceinline__ XcdBarrier xcd_barrier_post(unsigned* bar, volatile LAS unsigned* st) {
    XcdBarrier b; b.bar = bar; b.x = xb_xcc_id(); b.st = st;
    if (threadIdx.x == 0) (void)xb_add(&bar[XB_XCNT(b.x)], 1u);
    return b;
}
__device__ __forceinline__ void xcd_barrier_complete(unsigned* bar, unsigned x, unsigned& nloc, unsigned& nx) {
    const unsigned G = gridDim.x * gridDim.y * gridDim.z;
    unsigned sum, cnt, mine, sp = 0u;
    for (;;) {
        sum = 0u; cnt = 0u; mine = 0u;
#pragma unroll
        for (unsigned j = 0; j < 16; ++j) { const unsigned c = xb_ld(&bar[XB_XCNT(j)]); sum += c; cnt += (c > 0u) ? 1u : 0u; mine = (j == x) ? c : mine; }
        if (sum == G) break;
        __builtin_amdgcn_s_sleep(1);
        if ((++sp & 255u) == 0u) { if (xb_ld(&bar[XB_TMO])) break; if (sp > XB_SPIN_CAP) { atomicAdd(&bar[XB_TMO], 1u); break; } }
    }
    nloc = mine > 0u ? mine : 1u; nx = cnt > 0u ? cnt : 1u;
}

__device__ __forceinline__ void xcd_barrier(const XcdBarrier& b) {
    asm volatile("s_waitcnt vmcnt(0)" ::: "memory");
    __syncthreads();
    if (threadIdx.x == 0) {
        unsigned* bar = b.bar;
        __builtin_amdgcn_s_waitcnt(0);
        unsigned nloc = b.st[0], nx = b.st[1];
        if (nloc == 0u) { xcd_barrier_complete(bar, b.x, nloc, nx); b.st[0] = nloc; b.st[1] = nx; }
        const unsigned old = xb_add(&bar[XB_XSUB(b.x)], 1u);
        const unsigned gen = old / nloc;
        if (old + 1u == (gen + 1u) * nloc) {
            __builtin_amdgcn_fence(__ATOMIC_RELEASE, "agent");
            asm volatile("s_waitcnt vmcnt(0)" ::: "memory");
            const unsigned og = xb_add(&bar[XB_TOP], 1u);
            const unsigned tg = og / nx;
            if (og + 1u == (tg + 1u) * nx) xb_add(&bar[XB_TOPGEN], 1u);
            else XB_SPIN(xb_ld(&bar[XB_TOPGEN]) == tg, bar);
            __builtin_amdgcn_fence(__ATOMIC_ACQUIRE, "agent");
            xb_add(&bar[XB_XGEN(b.x)], 1u);
            asm volatile("s_waitcnt vmcnt(0)" ::: "memory");
        } else {
            XB_SPIN(xb_ld(&bar[XB_XGEN(b.x)]) == gen, bar);
            __builtin_amdgcn_fence(__ATOMIC_ACQUIRE, "agent");
            asm volatile("s_waitcnt vmcnt(0)" ::: "memory");
        }
    }
    __syncthreads();
}

__device__ __forceinline__ float wave_sum(float v) {
#pragma unroll
    for (int o = 1; o < 64; o <<= 1) v += __shfl_xor(v, o);
    return v;
}
__device__ __forceinline__ void conv64(const float* W, int ldn, int k0, int n0, bf16* dst, int ldk, int drow0, LAS float* scr, int lane) {
    { const int r = lane >> 4, j = lane & 15; f32x4 v[16];
      const GAS f32x4* src = (const GAS f32x4*)(W + (size_t)(k0 + r) * ldn + n0 + 4 * j);
#pragma unroll
      for (int i = 0; i < 16; ++i) v[i] = __builtin_nontemporal_load(src + (size_t)i * ldn);
#pragma unroll
      for (int i = 0; i < 16; ++i) { const int kk = 4 * i + r; *(LAS f32x4*)(scr + kk * 64 + ((4 * j) ^ (4 * ((kk >> 3) & 7)))) = v[i]; } }
    LDS_WAIT(); asm volatile("" ::: "memory");
    const int c = lane & 7, nn = lane >> 3;
#pragma unroll
    for (int t = 0; t < 8; ++t) { const int n = nn + 8 * t; const LAS float* sp = scr + (8 * c) * 64 + (n ^ (4 * c));
        v4u o; o.x = pk2(sp[0 * 64], sp[1 * 64]); o.y = pk2(sp[2 * 64], sp[3 * 64]); o.z = pk2(sp[4 * 64], sp[5 * 64]); o.w = pk2(sp[6 * 64], sp[7 * 64]);
        *(GAS v4u*)(dst + (size_t)(drow0 + n) * ldk + k0 + 8 * c) = o; }
    LDS_WAIT(); asm volatile("" ::: "memory");
}
constexpr float WSCALE = 64.0f;
__device__ __forceinline__ unsigned pk4_fp8(float a, float b, float c, float d) { int w = __builtin_amdgcn_cvt_pk_fp8_f32(a, b, 0, false); w = __builtin_amdgcn_cvt_pk_fp8_f32(c, d, w, true); return (unsigned)w; }
__device__ __forceinline__ void conv8(const float* W, int ldn, int k0, int n0, unsigned char* dst, int ldk, int drow0, LAS float* scr, int lane) {
    { const int r = lane >> 3, j = lane & 7; f32x4 v[16];
      const GAS f32x4* src = (const GAS f32x4*)(W + (size_t)(k0 + r) * ldn + n0 + 4 * j);
#pragma unroll
      for (int i = 0; i < 16; ++i) v[i] = __builtin_nontemporal_load(src + (size_t)i * 2 * ldn);
#pragma unroll
      for (int i = 0; i < 16; ++i) { const int kk = 8 * i + r; *(LAS f32x4*)(scr + kk * 32 + ((4 * j) ^ (4 * (i & 7)))) = v[i] * WSCALE; } }
    LDS_WAIT(); asm volatile("" ::: "memory");
    const int c = lane & 15, nn = lane >> 4;
#pragma unroll
    for (int t = 0; t < 8; ++t) { const int n = nn + 4 * t; const LAS float* sp = scr + (8 * c) * 32 + (n ^ (4 * (c & 7)));
        v2u o; o.x = pk4_fp8(sp[0 * 32], sp[1 * 32], sp[2 * 32], sp[3 * 32]); o.y = pk4_fp8(sp[4 * 32], sp[5 * 32], sp[6 * 32], sp[7 * 32]);
        *(GAS v2u*)(dst + (size_t)(drow0 + n) * ldk + k0 + 8 * c) = o; }
    LDS_WAIT(); asm volatile("" ::: "memory");
}
struct Ptrs {
    const float *x, *w_in, *relb, *w_pool, *pscale, *w_ao, *w_po, *w_out, *gains, *dwg, *dwu, *dwd, *wr, *mwg, *mwu, *mwd;
    float* out; unsigned char* ws;
};
constexpr int I_WIN = 2 * 32 * 32, I_WIN8 = 2 * 16 * 224, I_AO = 2 * 8 * 32, I_PO = I_AO, I_WOUT = 2 * 32 * 32, I_POOL = 8 * 2 * 2, I_DG = 32 * 88, I_DU = I_DG, I_DD = 88 * 32,
              I_MG = 8 * 16 * 224, I_MU = I_MG, I_MD = 8 * 56 * 64;
constexpr int N_ITEMS_A = I_WIN + I_WIN8 + I_AO + I_PO + I_WOUT + I_POOL + I_DG + I_DU + I_DD, N_ITEMS_B = I_MG + I_MU + I_MD;
#ifndef QW_ITEMS
#define QW_ITEMS 14
#endif
constexpr int QW = QW_ITEMS, QWZ = QW_ITEMS / 2;
constexpr int N_DEFER = 128 * NWAVES * (QW + 2 * QWZ);
static_assert(N_DEFER <= N_ITEMS_B, "deferred conversion quota");
__device__ __forceinline__ void conv_a(const Ptrs& P, int it, LAS float* scr, int lane) {
    unsigned char* ws = P.ws; int r = it;
    if (r < I_WIN) { const int l = r / (32 * 32), q = r % (32 * 32), kb = q / 32, nb = q % 32;
        conv64(P.w_in + (size_t)l * DM * INW, INW, 64 * kb, ZV + 64 * nb, (bf16*)(ws + WS_WIN) + (size_t)l * INW * DM, DM, ZV + 64 * nb, scr, lane); return; } r -= I_WIN;
    if (r < I_WIN8) { const int l = r / (16 * 224), q = r % (16 * 224), kb = q / 224, nb = q % 224;
        const int n0 = nb < 96 ? 32 * nb : ZGA + 32 * (nb - 96);
        conv8(P.w_in + (size_t)l * DM * INW, INW, 128 * kb, n0, (unsigned char*)(ws + WS_WIN8) + (size_t)l * 7168 * DM, DM, 32 * nb, scr, lane); return; } r -= I_WIN8;
    if (r < I_AO) { const int l = r / 256, q = r % 256, kb = q / 32, nb = q % 32;
        conv64(P.w_ao + (size_t)l * 512 * DM, DM, 64 * kb, 64 * nb, (bf16*)(ws + WS_WAO) + (size_t)l * DM * 512, 512, 64 * nb, scr, lane); return; } r -= I_AO;
    if (r < I_PO) { const int l = r / 256, q = r % 256, kb = q / 32, nb = q % 32;
        conv64(P.w_po + (size_t)l * 512 * DM, DM, 64 * kb, 64 * nb, (bf16*)(ws + WS_WPO) + (size_t)l * DM * 512, 512, 64 * nb, scr, lane); return; } r -= I_PO;
    if (r < I_WOUT) { const int l = r / 1024, q = r % 1024, kb = q / 32, nb = q % 32;
        conv64(P.w_out + (size_t)l * DM * DM, DM, 64 * kb, 64 * nb, (bf16*)(ws + WS_WOUT) + (size_t)l * DM * DM, DM, 64 * nb, scr, lane); return; } r -= I_WOUT;
    if (r < I_POOL) { const int mtx = r / 4, q = r % 4, kb = q / 2, nb = q % 2;
        conv64(P.w_pool + (size_t)mtx * 128 * 128, 128, 64 * kb, 64 * nb, (bf16*)(ws + WS_WPOOL) + (size_t)mtx * 128 * 128, 128, 64 * nb, scr, lane); return; } r -= I_POOL;
    if (r < I_DG + I_DU) { const int up = r >= I_DG; const int q = up ? r - I_DG : r; const int kb = q / 88, nb = q % 88, n0 = 64 * nb;
        conv64(up ? P.dwu : P.dwg, DFF, 64 * kb, n0, (bf16*)(ws + WS_DGU), DM, (n0 >> 7) * 256 + (n0 & 127) + (up ? 128 : 0), scr, lane); return; } r -= I_DG + I_DU;
    { const int kb = r / 32, nb = r % 32;
        conv64(P.dwd, DM, 64 * kb, 64 * nb, (bf16*)(ws + WS_DD), DFF, 64 * nb, scr, lane); }
}
__device__ __forceinline__ void conv_b(const Ptrs& P, int it, LAS float* scr, int lane) {
    unsigned char* ws = P.ws; int r = it;
    if (r < I_MG + I_MU) { const int up = r >= I_MG; const int q0 = up ? r - I_MG : r; const int e = q0 / (16 * 224), q = q0 % (16 * 224), kb = q / 224, nb = q % 224, n0 = 32 * nb;
        conv8((up ? P.mwu : P.mwg) + (size_t)e * DM * EFF, EFF, 128 * kb, n0, (unsigned char*)(ws + WS_MGU) + (size_t)e * 2 * EFF * DM, DM, (n0 >> 7) * 256 + (n0 & 127) + (up ? 128 : 0), scr, lane); return; } r -= I_MG + I_MU;
    { const int e = r / (56 * 64), q = r % (56 * 64), kb = q / 64, nb = q % 64;
        conv8(P.mwd + (size_t)e * EFF * DM, DM, 128 * kb, 32 * nb, (unsigned char*)(ws + WS_MD) + (size_t)e * DM * EFF, EFF, 32 * nb, scr, lane); }
}
__device__ __forceinline__ void p0_convert(const Ptrs& P, LAS unsigned char* lds, int gw, int NGW, int wave, int lane) {
    LAS float* scr = (LAS float*)(lds + RING_OFF + wave * 16384);
#pragma unroll 1
    for (int j = gw; j < I_WIN / 2 + I_WIN8 / 2; j += NGW) conv_a(P, j < I_WIN / 2 ? j : I_WIN + (j - I_WIN / 2), scr, lane);
}
__device__ __forceinline__ void conv_share_down(const Ptrs& P, LAS unsigned char* lds, int gw, int NGW, int wave, int lane) {
    LAS float* scr = (LAS float*)(lds + RING_OFF + wave * 16384);
    constexpr int PER = I_MD / 256; static_assert(I_MD % 256 == 0 && PER % NWAVES == 0, "conv_share_down: whole steps of eight items per workgroup");
    const int first = I_MG + I_MU + (gw / NWAVES) * PER + wave;
#pragma unroll 1
    for (int j = 0; j < PER; j += NWAVES) conv_b(P, first + j, scr, lane);
}
__device__ __forceinline__ void conv_share_a(const Ptrs& P, LAS unsigned char* lds, int gw, int NGW, int wave, int lane) {
    LAS float* scr = (LAS float*)(lds + RING_OFF + wave * 16384);
    constexpr int NA1 = N_ITEMS_A - I_WIN / 2 - I_WIN8 / 2;
#pragma unroll 1
    for (int j = gw; j < NA1; j += NGW) conv_a(P, j < I_WIN / 2 ? I_WIN / 2 + j : I_WIN + I_WIN8 / 2 + (j - I_WIN / 2), scr, lane);
}
__device__ __forceinline__ void conv_share_gu(const Ptrs& P, LAS unsigned char* lds, int gw, int NGW, int wave, int lane) {
    LAS float* scr = (LAS float*)(lds + RING_OFF + wave * 16384);
    constexpr int PER = (I_MG + I_MU - N_DEFER) / 256; static_assert((I_MG + I_MU - N_DEFER) % 256 == 0, "conv_share_gu: equal runs");
    const int first = N_DEFER + (gw / NWAVES) * PER;
#pragma unroll 1
    for (int j = wave; j < PER; j += NWAVES) conv_b(P, first + j, scr, lane);
}
__device__ __forceinline__ void conv_quota(const Ptrs& P, LAS unsigned char* lds, int site, int bx, int wave, int lane) {
    LAS float* scr = (LAS float*)(lds + RING_OFF + wave * 16384);
    const int w = (bx - 128) * NWAVES + wave, nq = site == 1 ? QW : QWZ, base = 128 * NWAVES * (site == 0 ? 0 : (site == 1 ? QWZ : QWZ + QW));
#pragma unroll 1
    for (int q = 0; q < nq; ++q) conv_b(P, base + q * (128 * NWAVES) + w, scr, lane);
}
__device__ __forceinline__ void ld_row(const float* p, int lane, f32x4 (&v)[8]) { const GAS f32x4* r = (const GAS f32x4*)p + lane;
#pragma unroll
    for (int j = 0; j < 8; ++j) v[j] = r[64 * j]; }
__device__ __forceinline__ void ld_row_bfraw(const bf16* p, int lane, v2u (&w)[8]) { const GAS v2u* r = (const GAS v2u*)p + lane;
#pragma unroll
    for (int j = 0; j < 8; ++j) w[j] = r[64 * j]; }
__device__ __forceinline__ void unpack_bf(const v2u (&w)[8], f32x4 (&v)[8]) {
#pragma unroll
    for (int j = 0; j < 8; ++j) v[j] = (f32x4){bflo(w[j].x), bfhi(w[j].x), bflo(w[j].y), bfhi(w[j].y)}; }
__device__ __forceinline__ void ld_row_bf(const bf16* p, int lane, f32x4 (&v)[8]) { v2u w[8]; ld_row_bfraw(p, lane, w); __builtin_amdgcn_sched_barrier(0); unpack_bf(w, v); }
__device__ __forceinline__ float sumsq(const f32x4 (&v)[8]) { float s = 0.f;
#pragma unroll
    for (int j = 0; j < 8; ++j) s += (v[j].x * v[j].x + v[j].y * v[j].y) + (v[j].z * v[j].z + v[j].w * v[j].w);
    return wave_sum(s); }
__device__ __forceinline__ void st_row_bf16(bf16* p, int lane, const f32x4 (&v)[8]) { GAS v2u* o = (GAS v2u*)p + lane;
#pragma unroll
    for (int j = 0; j < 8; ++j) { v2u w; w.x = pk2(v[j].x, v[j].y); w.y = pk2(v[j].z, v[j].w); o[64 * j] = w; } }
__device__ __forceinline__ void st_row_fp8(unsigned char* p, int lane, const f32x4 (&v)[8]) { GAS unsigned* o = (GAS unsigned*)p + lane;
#pragma unroll
    for (int j = 0; j < 8; ++j) o[64 * j] = pk4_fp8(v[j].x, v[j].y, v[j].z, v[j].w); }
__device__ __forceinline__ void norm_first(const float* x, const float* g, bf16* XN, unsigned char* XN8, int gw, int NGW, int lane) {
    f32x4 gv[8]; ld_row(g, lane, gv);
#pragma unroll 1
    for (int m = gw; m < M; m += NGW) { f32x4 v[8]; ld_row(x + (size_t)m * DM, lane, v);
        const float r = 1.0f / sqrtf(sumsq(v) * (1.0f / DM) + RMS_EPS);
#pragma unroll
        for (int j = 0; j < 8; ++j) v[j] = v[j] * r * gv[j];
        st_row_bf16(XN + (size_t)m * DM, lane, v); st_row_fp8(XN8 + (size_t)m * DM, lane, v); }
}
template <bool ROUTER, bool RES_BF>
__device__ __forceinline__ void norm_mid(const bf16* src, const void* res, bf16* hout, const float* gpost, const float* gpre, bf16* XN, unsigned char* XN8,
                                         const LAS float* wrl, gu32* ctl, int* toke, int* tokp, float* tokw, unsigned char* Xp, int gw, int NGW, int lane) {
    f32x4 v[8], h[8], hn[8]; v2u vr[8], hr[8];
    unsigned pend[8]; int pe1 = 0, pe2 = 0; unsigned pp1 = 0u, pp2 = 0u; bool have = false;
    if (gw < M) { ld_row_bfraw(src + (size_t)gw * DM, lane, vr);
        if constexpr (RES_BF) ld_row_bfraw((const bf16*)res + (size_t)gw * DM, lane, hr); else ld_row((const float*)res + (size_t)gw * DM, lane, hn); }
#pragma unroll 1
    for (int m = gw; m < M; m += NGW) {
        const int mn = m + NGW;
        unpack_bf(vr, v);
        if constexpr (RES_BF) unpack_bf(hr, h); else {
#pragma unroll
            for (int j = 0; j < 8; ++j) h[j] = hn[j]; }
        __builtin_amdgcn_sched_barrier(0);
        if (mn < M) { ld_row_bfraw(src + (size_t)mn * DM, lane, vr);
            if constexpr (RES_BF) ld_row_bfraw((const bf16*)res + (size_t)mn * DM, lane, hr); else ld_row((const float*)res + (size_t)mn * DM, lane, hn); }
        __builtin_amdgcn_sched_barrier(0);
        f32x4 gv[8]; ld_row(gpost, lane, gv);
        const float r = 1.0f / sqrtf(sumsq(v) * (1.0f / DM) + RMS_EPS);
#pragma unroll
        for (int j = 0; j < 8; ++j) h[j] = h[j] + v[j] * r * gv[j];
        st_row_bf16(hout + (size_t)m * DM, lane, h);
        const float r2 = 1.0f / sqrtf(sumsq(h) * (1.0f / DM) + RMS_EPS);
        ld_row(gpre, lane, gv);
#pragma unroll
        for (int j = 0; j < 8; ++j) h[j] = h[j] * r2 * gv[j];
        if (!ROUTER && XN) st_row_bf16(XN + (size_t)m * DM, lane, h);
        if (XN8) st_row_fp8(XN8 + (size_t)m * DM, lane, h);
        if (ROUTER) {
            int e1 = 0, e2 = 0; float v1 = -3.0e38f, v2 = -3.0e38f;
#pragma unroll 1
            for (int e = 0; e < NEXP; ++e) { float s = 0.f; const LAS f32x4* wp = (const LAS f32x4*)(wrl + e * DM) + lane;
#pragma unroll
                for (int j = 0; j < 8; ++j) { const f32x4 w = wp[64 * j]; s += (h[j].x * w.x + h[j].y * w.y) + (h[j].z * w.z + h[j].w * w.w); }
                s = wave_sum(s);
                if (s > v1) { v2 = v1; e2 = e1; v1 = s; e1 = e; } else if (s > v2) { v2 = s; e2 = e; } }
            if (have) {
                const unsigned q1 = __builtin_amdgcn_readfirstlane(pp1), q2 = __builtin_amdgcn_readfirstlane(pp2);
                GAS unsigned* o1 = (GAS unsigned*)(Xp + ((size_t)pe1 * XCAP + q1) * DM) + lane; GAS unsigned* o2 = (GAS unsigned*)(Xp + ((size_t)pe2 * XCAP + q2) * DM) + lane;
#pragma unroll
                for (int j = 0; j < 8; ++j) { o1[64 * j] = pend[j]; o2[64 * j] = pend[j]; } }
#pragma unroll
            for (int j = 0; j < 8; ++j) pend[j] = pk4_fp8(h[j].x, h[j].y, h[j].z, h[j].w);
            pe1 = e1; pe2 = e2; have = true;
            if (lane == 0) {
                const float w1 = 1.0f / (1.0f + __expf(v2 - v1)), w2 = 1.0f - w1;
                pp1 = __hip_atomic_fetch_add(ctl + CW_CNT + 64 * e1, 1u, RLX_AGENT);
                pp2 = __hip_atomic_fetch_add(ctl + CW_CNT + 64 * e2, 1u, RLX_AGENT);
                toke[2 * m] = e1; toke[2 * m + 1] = e2; tokp[2 * m] = (int)pp1; tokp[2 * m + 1] = (int)pp2; tokw[2 * m] = w1; tokw[2 * m + 1] = w2;
            }
        }
    }
    if (ROUTER && have) {
        const unsigned q1 = __builtin_amdgcn_readfirstlane(pp1), q2 = __builtin_amdgcn_readfirstlane(pp2);
        GAS unsigned* o1 = (GAS unsigned*)(Xp + ((size_t)pe1 * XCAP + q1) * DM) + lane; GAS unsigned* o2 = (GAS unsigned*)(Xp + ((size_t)pe2 * XCAP + q2) * DM) + lane;
#pragma unroll
        for (int j = 0; j < 8; ++j) { o1[64 * j] = pend[j]; o2[64 * j] = pend[j]; } }
}
__device__ __forceinline__ void moe_tables(gu32* ctl, LAS int* tab, int tid) {
    if (tid < NEXP) { int c = (int)__hip_atomic_load(ctl + CW_CNT + 64 * tid, RLX_AGENT); if (c > XCAP) c = XCAP; tab[88 + tid] = c; }
    __syncthreads();
    if (tid == 0) { int off = 0, p = 0;
        for (int e = 0; e < NEXP; ++e) { const int c = tab[88 + e], np = (c + 255) >> 8;
            tab[80 + e] = off; for (int i = 0; i < np && p < 80; ++i) tab[p++] = e; off += np * 256; }
        tab[96] = p; }
    __syncthreads();
}
__device__ __forceinline__ void add_ytail(const bf16* Yt, int r, int rt0, int lane, f32x4 (&a)[8]) {
    if (r >= rt0) {
#pragma unroll 1
        for (int k = 0; k < 3; ++k) { f32x4 t[8]; ld_row_bf(Yt + ((size_t)k * 2048 + (r - rt0)) * DM, lane, t);
#pragma unroll
            for (int j = 0; j < 8; ++j) a[j] = a[j] + t[j]; } }
}
__device__ __forceinline__ void norm_final(const bf16* Yp, const bf16* Yt, const float* g, const bf16* hb, float* out, const int* toke, const int* tokp, const float* tokw, const LAS int* tab, int gw, int NGW, int lane) {
    const int rt0 = (tab[96] & ~31) * 256;
    v2u ar[8], br[8]; int r1 = 0, r2 = 0, r1n = 0, r2n = 0; float w1 = 0.f, w2 = 0.f, w1n = 0.f, w2n = 0.f;
    if (gw < M) { const int m = gw; r1 = tab[80 + toke[2 * m]] + tokp[2 * m]; r2 = tab[80 + toke[2 * m + 1]] + tokp[2 * m + 1]; w1 = tokw[2 * m]; w2 = tokw[2 * m + 1];
        ld_row_bfraw(Yp + (size_t)r1 * DM, lane, ar); ld_row_bfraw(Yp + (size_t)r2 * DM, lane, br); }
#pragma unroll 1
    for (int m = gw; m < M; m += NGW) {
        const int mn = m + NGW;
        f32x4 a[8], b[8]; unpack_bf(ar, a); unpack_bf(br, b);
        __builtin_amdgcn_sched_barrier(0);
        if (mn < M) { r1n = tab[80 + toke[2 * mn]] + tokp[2 * mn]; r2n = tab[80 + toke[2 * mn + 1]] + tokp[2 * mn + 1]; w1n = tokw[2 * mn]; w2n = tokw[2 * mn + 1];
            ld_row_bfraw(Yp + (size_t)r1n * DM, lane, ar); ld_row_bfraw(Yp + (size_t)r2n * DM, lane, br); }
        __builtin_amdgcn_sched_barrier(0);
        add_ytail(Yt, r1, rt0, lane, a); add_ytail(Yt, r2, rt0, lane, b);
#pragma unroll
        for (int j = 0; j < 8; ++j) a[j] = a[j] * w1 + b[j] * w2;
        ld_row_bf(hb + (size_t)m * DM, lane, b);
        const float r = 1.0f / sqrtf(sumsq(a) * (1.0f / DM) + RMS_EPS);
        GAS f32x4* o = (GAS f32x4*)(out + (size_t)m * DM) + lane; const GAS f32x4* gp = (const GAS f32x4*)g + lane;
#pragma unroll
        for (int j = 0; j < 8; ++j) o[64 * j] = b[j] + a[j] * r * gp[64 * j];
        r1 = r1n; r2 = r2n; w1 = w1n; w2 = w2n;
    }
}
__device__ __forceinline__ int t5_bucket(int d) {
    if (d < 16) return d;
    return 16 + (d >= 22) + (d >= 30) + (d >= 40) + (d >= 54) + (d >= 73) + (d >= 99) + (d >= 134) + (d >= 182) + (d >= 246) + (d >= 332) + (d >= 450) + (d >= 609) + (d >= 825) + (d >= 1117) + (d >= 1513);
}
struct AttnU { int b, g, d, r, n, hh, head; };
__device__ __forceinline__ AttnU attn_decode(int ui) { AttnU u; u.hh = ui & 3; const int u2 = ui >> 2; u.b = u2 / 96; const int s = u2 % 96;
    if (s < 32) { u.g = 0; u.d = 1; u.r = 0; u.n = s; } else if (s < 64) { u.g = 1; u.d = 4; u.r = (s - 32) >> 3; u.n = (s - 32) & 7; } else { u.g = 2; u.d = 16; u.r = (s - 64) >> 1; u.n = (s - 64) & 1; }
    u.head = u.g * 4 + u.hh; return u; }
__device__ __forceinline__ void att_dma16(const void* g, LAS unsigned char* piece) {
    unsigned sv; const unsigned base = (unsigned)(size_t)piece;
    asm volatile("s_mov_b32 %0, m0\n\ts_mov_b32 m0, %2\n\ts_nop 0\n\tglobal_load_lds_dwordx4 %1, off\n\ts_mov_b32 m0, %0" : "=&s"(sv) : "v"(g), "s"(__builtin_amdgcn_readfirstlane(base)) : "memory");
}
__device__ __forceinline__ int v_swz(int row) { return ((row & 3) << 2) | ((row >> 2) & 3); }
__device__ __forceinline__ void attn_dma_v(const bf16* Z, const AttnU& u, LAS unsigned char* buf, int wave, int lane) {
#pragma unroll
    for (int i = 0; i < 8; ++i) { const int piece = wave * 8 + i, p = 4 * piece + (lane >> 4), j = 128 * (u.n - 1) + p;
        const bf16* src = Z + (size_t)(u.b * SEQ + u.r + u.d * (j < 0 ? 0 : j)) * INW + ZV + u.head * 128 + 8 * ((lane & 15) ^ v_swz(p));
        att_dma16(src, buf + piece * 1024); }
}
constexpr int ATT_BT_OFF = LDSCTL_OFF + 1024;
__device__ __forceinline__ void attn_dma_k(const bf16* Z, const AttnU& u, LAS unsigned char* buf, int wave, int lane) {
#pragma unroll
    for (int i = 0; i < 8; ++i) { const int piece = wave * 8 + i, p = 4 * piece + (lane >> 4), j = 128 * (u.n - 1) + p;
        const bf16* src = Z + (size_t)(u.b * SEQ + u.r + u.d * (j < 0 ? 0 : j)) * INW + ZK + u.head * 128 + 8 * ((lane & 15) ^ (p & 15));
        att_dma16(src, buf + piece * 1024); }
}
__device__ __forceinline__ void attn_ld_q(const bf16* Z, const AttnU& u, int wave, int qi, int qd, bf16x8 (&qf)[4]) {
    const int jq = 128 * u.n + 16 * wave + qi; const size_t rowq = (size_t)(u.b * SEQ + u.r + u.d * jq);
#pragma unroll
    for (int s4 = 0; s4 < 4; ++s4) qf[s4] = *(const GAS bf16x8*)(Z + rowq * INW + ZQ + u.head * 128 + 32 * s4 + 8 * qd);
}
#define ATT_BAR() do { asm volatile("s_waitcnt lgkmcnt(0)" ::: "memory"); __builtin_amdgcn_s_barrier(); asm volatile("" ::: "memory"); } while (0)
__device__ __forceinline__ void attn_phase(const bf16* Z, const float* relb, bf16* OG, float* LSE, LAS unsigned char* lds, int G, int tid, int wave, int lane) {
    const int qi = lane & 15, qd = lane >> 4;
    constexpr float C2 = 0.08838834764831845f * 1.4426950408889634f;
    const int trq = (lane & 15) >> 2, trp = lane & 3, trrow = 4 * qd + trq, trswz = (trq << 2) | qd;
    LAS unsigned char* kbuf = lds + RING_OFF; LAS unsigned char* vbuf = lds + RING_OFF + 65536;
    const int tb = tid < 128 ? tid : 128;
    int it = 0;
    int bxl = blockIdx.x; asm volatile("" : "+s"(bxl));
    bf16x8 qf[4];
    if (bxl < 768) { const AttnU u0 = attn_decode(bxl);
        const float bv = relb[t5_bucket(tb * u0.d) * 12 + u0.head]; attn_ld_q(Z, u0, wave, qi, qd, qf);
        __builtin_amdgcn_sched_barrier(0);
        attn_dma_k(Z, u0, kbuf, wave, lane); attn_dma_v(Z, u0, vbuf, wave, lane);
        __builtin_amdgcn_sched_barrier(0);
        if (tid < 129) ((LAS float*)(lds + ATT_BT_OFF))[tid] = bv * 1.4426950408889634f; }
#pragma unroll 1
    for (int ui = bxl; ui < 768; ui += G, ++it) {
        const AttnU U = attn_decode(ui); const int b = U.b, g = U.g, d = U.d, r = U.r, n = U.n, hh = U.hh, head = U.head;
        const bool has_next = ui + G < 768;
        LAS float* btab = (LAS float*)(lds + ATT_BT_OFF) + (it & 1) * 132; LAS float* btabn = (LAS float*)(lds + ATT_BT_OFF) + ((it + 1) & 1) * 132;
        const int jq = 128 * n + 16 * wave + qi; const size_t rowq = (size_t)(b * SEQ + r + d * jq);
        __builtin_amdgcn_sched_barrier(0);
        asm volatile("s_waitcnt vmcnt(8)" ::: "memory");
        ATT_BAR();
        __builtin_amdgcn_sched_barrier(0);
        f32x4 sa[9];
        const LAS unsigned char* krow = kbuf + (16 * wave + qi) * 256;
        bf16x8 kfA[3][4], kfB[3][4];
#define ATT_LDK(dst, t0) do { _Pragma("unroll") for (int tt = 0; tt < 3; ++tt) _Pragma("unroll") for (int s4 = 0; s4 < 4; ++s4) dst[tt][s4] = *(const LAS bf16x8*)(krow + ((t0) + tt) * 4096 + 16 * ((4 * s4 + qd) ^ qi)); } while (0)
#define ATT_QK(src, t0) do { _Pragma("unroll") for (int tt = 0; tt < 3; ++tt) { f32x4 a_ = (f32x4){0.f, 0.f, 0.f, 0.f}; \
            _Pragma("unroll") for (int s4 = 0; s4 < 4; ++s4) a_ = __builtin_amdgcn_mfma_f32_16x16x32_bf16(src[tt][s4], qf[s4], a_, 0, 0, 0); sa[(t0) + tt] = a_; } } while (0)
        ATT_LDK(kfA, 0); ATT_LDK(kfB, 3); __builtin_amdgcn_sched_barrier(0);
        ATT_QK(kfA, 0); __builtin_amdgcn_sched_barrier(0);
        ATT_LDK(kfA, 6); __builtin_amdgcn_sched_barrier(0);
        ATT_QK(kfB, 3); __builtin_amdgcn_sched_barrier(0);
        ATT_QK(kfA, 6);
#undef ATT_LDK
#undef ATT_QK
        __builtin_amdgcn_sched_barrier(0);
        ATT_BAR();
        __builtin_amdgcn_sched_barrier(0);
        float bvn = 0.f;
        if (has_next) { const AttnU un = attn_decode(ui + G);
            bvn = relb[t5_bucket(tb * un.d) * 12 + un.head]; __builtin_amdgcn_sched_barrier(0);
            attn_ld_q(Z, un, wave, qi, qd, qf); __builtin_amdgcn_sched_barrier(0);
            attn_dma_k(Z, un, kbuf, wave, lane); }
        __builtin_amdgcn_sched_barrier(0);
        float bs[9][4];
#pragma unroll
        for (int t = 0; t < 9; ++t)
#pragma unroll
            for (int rr = 0; rr < 4; ++rr) { const int e = qi - 4 * qd - rr;
                bs[t][rr] = btab[t == 0 ? (e > 0 ? 128 : 128 + e) : (t == 8 ? (e < 0 ? 0 : e) : 128 - 16 * t + e)]; }
        __builtin_amdgcn_sched_barrier(0);
        float mx = -__builtin_inff();
#pragma unroll
        for (int t = 0; t < 9; ++t)
#pragma unroll
            for (int rr = 0; rr < 4; ++rr) { const int e = qi - 4 * qd - rr;
                const bool valid = (t == 0 ? e <= 0 : (t == 8 ? e >= 0 : true)) && (n > 0 || wave + t >= 8);
                const float sc = valid ? sa[t][rr] * C2 + bs[t][rr] : -__builtin_inff();
                sa[t][rr] = sc; mx = fmaxf(mx, sc); }
        mx = fmaxf(mx, __shfl_xor(mx, 16)); mx = fmaxf(mx, __shfl_xor(mx, 32));
        float sum = 0.f;
#pragma unroll
        for (int t = 0; t < 9; ++t)
#pragma unroll
            for (int rr = 0; rr < 4; ++rr) { const float p = __builtin_amdgcn_exp2f(sa[t][rr] - mx); sa[t][rr] = p; sum += p; }
        sum += __shfl_xor(sum, 16); sum += __shfl_xor(sum, 32);
        __builtin_amdgcn_sched_barrier(0);
        if (has_next) asm volatile("s_waitcnt vmcnt(13)" ::: "memory");
        else asm volatile("s_waitcnt vmcnt(0)" ::: "memory");
        ATT_BAR();
        __builtin_amdgcn_sched_barrier(0);
        f32x4 o[8];
#pragma unroll
        for (int dt = 0; dt < 8; ++dt) o[dt] = (f32x4){0.f, 0.f, 0.f, 0.f};
        const LAS unsigned char* vrow = vbuf + (16 * wave + trrow) * 256 + 8 * (trp & 1);
#pragma unroll
        for (int t = 0; t < 9; ++t) { v2u pw; pw.x = pk2(sa[t][0], sa[t][1]); pw.y = pk2(sa[t][2], sa[t][3]); const bf16x4 pf = __builtin_bit_cast(bf16x4, pw);
            bf16x4 vf[8];
#pragma unroll
            for (int dt = 0; dt < 8; ++dt) vf[dt] = __builtin_amdgcn_ds_read_tr16_b64_v4i16((LAS bf16x4*)(vrow + t * 4096 + 16 * ((2 * dt + (trp >> 1)) ^ trswz)));
            __builtin_amdgcn_sched_barrier(0);
#pragma unroll
            for (int dt = 0; dt < 8; ++dt) o[dt] = __builtin_amdgcn_mfma_f32_16x16x16bf16_1k(vf[dt], pf, o[dt], 0, 0, 0); }
        __builtin_amdgcn_sched_barrier(0);
        ATT_BAR();
        __builtin_amdgcn_sched_barrier(0);
        asm volatile("" : "+v"(bvn));
        if (has_next && tid < 129) btabn[tid] = bvn * 1.4426950408889634f;
        __builtin_amdgcn_sched_barrier(0);
        const float inv = 1.0f / sum;
        bf16* op = OG + ((size_t)g * M + rowq) * 512 + hh * 128 + 4 * qd;
#pragma unroll
        for (int dt = 0; dt < 8; ++dt) { v2u w; w.x = pk2(o[dt][0] * inv, o[dt][1] * inv); w.y = pk2(o[dt][2] * inv, o[dt][3] * inv); *(GAS v2u*)(op + 16 * dt) = w; }
        if (qd == 0) LSE[((size_t)g * M + rowq) * 4 + hh] = (mx + __builtin_amdgcn_logf(sum)) * 0.6931471805599453f;
        __builtin_amdgcn_sched_barrier(0);
        if (has_next) { const AttnU un = attn_decode(ui + G); attn_dma_v(Z, un, vbuf, wave, lane); }
        __builtin_amdgcn_sched_barrier(0);
    }
    asm volatile("s_waitcnt vmcnt(0)" ::: "memory"); __syncthreads();
}
template <int K> __device__ __forceinline__ float row_shr(float x) { return __int_as_float(__builtin_amdgcn_update_dpp(0, __float_as_int(x), 0x110 + K, 0xF, 0xF, true)); }
template <int K> __device__ __forceinline__ float row_shl(float x) { return __int_as_float(__builtin_amdgcn_update_dpp(0, __float_as_int(x), 0x100 + K, 0xF, 0xF, true)); }
template <int SZ>
__device__ __forceinline__ void pool_window(const bf16* Z, int g, int tile, int lane, bf16x8 (&yf)[4]) {
    static_assert(SZ == 2 || SZ == 4 || SZ == 8 || SZ == 16, "window");
    const int qi = lane & 15, qd = lane >> 4, row = tile * 16 + qi, tseq = row & (SEQ - 1); const int cnt = (tseq + 1 < SZ) ? tseq + 1 : SZ;
    const float rc = 1.0f / (float)cnt; const bool hasprev = ((tile * 16) & (SEQ - 1)) != 0;
    v4u cw[4], pw[4];
#pragma unroll
    for (int s4 = 0; s4 < 4; ++s4) { const bf16* zp = Z + (size_t)row * INW + ZP + 128 * g + 32 * s4 + 8 * qd;
        cw[s4] = *(const GAS v4u*)zp; pw[s4] = *(const GAS v4u*)(zp - (hasprev ? (size_t)16 * INW : (size_t)0)); }
    __builtin_amdgcn_sched_barrier(0);
#pragma unroll
    for (int s4 = 0; s4 < 4; ++s4) {
        const float c[8] = {bflo(cw[s4].x), bfhi(cw[s4].x), bflo(cw[s4].y), bfhi(cw[s4].y), bflo(cw[s4].z), bfhi(cw[s4].z), bflo(cw[s4].w), bfhi(cw[s4].w)};
        const float p[8] = {bflo(pw[s4].x), bfhi(pw[s4].x), bflo(pw[s4].y), bfhi(pw[s4].y), bflo(pw[s4].z), bfhi(pw[s4].z), bflo(pw[s4].w), bfhi(pw[s4].w)};
        float y[8];
#pragma unroll
        for (int e = 0; e < 8; ++e) {
            float Pc = c[e]; Pc += row_shr<1>(Pc); Pc += row_shr<2>(Pc); Pc += row_shr<4>(Pc); Pc += row_shr<8>(Pc);
            float Sp = hasprev ? p[e] : 0.f; Sp += row_shl<1>(Sp); Sp += row_shl<2>(Sp); Sp += row_shl<4>(Sp); Sp += row_shl<8>(Sp);
            float w = Pc + row_shl<17 - SZ>(Sp);
            if (SZ < 16) w -= row_shr<(SZ < 16 ? SZ : 1)>(Pc);
            y[e] = w * rc - c[e]; }
        v4u yw; yw.x = pk2(y[0], y[1]); yw.y = pk2(y[2], y[3]); yw.z = pk2(y[4], y[5]); yw.w = pk2(y[6], y[7]);
        yf[s4] = __builtin_bit_cast(bf16x8, yw); }
}
__device__ __forceinline__ void pool_mma(const bf16* WPt, const float* pscale, bf16* OP, int g, int tile, int lane, const bf16x8 (&yf)[4]) {
    const int qi = lane & 15, qd = lane >> 4, row = tile * 16 + qi;
#pragma unroll
    for (int h = 0; h < 2; ++h) {
        bf16x8 wf[4][4]; f32x4 ps[4];
#pragma unroll
        for (int k = 0; k < 4; ++k) { const int nt = 4 * h + k; const bf16* wp = WPt + ((size_t)g * 128 + 16 * nt + qi) * 128 + 8 * qd;
#pragma unroll
            for (int s4 = 0; s4 < 4; ++s4) wf[k][s4] = *(const GAS bf16x8*)(wp + 32 * s4);
            ps[k] = *(const GAS f32x4*)(pscale + 128 * g + 16 * nt + 4 * qd); }
        __builtin_amdgcn_sched_barrier(0);
#pragma unroll
        for (int k = 0; k < 4; ++k) { const int nt = 4 * h + k; f32x4 acc = (f32x4){0.f, 0.f, 0.f, 0.f};
#pragma unroll
            for (int s4 = 0; s4 < 4; ++s4) acc = __builtin_amdgcn_mfma_f32_16x16x32_bf16(wf[k][s4], yf[s4], acc, 0, 0, 0);
            v2u w; w.x = pk2(acc[0] * ps[k][0], acc[1] * ps[k][1]); w.y = pk2(acc[2] * ps[k][2], acc[3] * ps[k][3]);
            *(GAS v2u*)(OP + (size_t)row * 512 + 128 * g + 16 * nt + 4 * qd) = w; }
        __builtin_amdgcn_sched_barrier(0);
    }
}
__device__ __forceinline__ void combine_pool_phase(const bf16* Z, const bf16* OG, const float* LSE, const bf16* WPt, const float* pscale, bf16* OA, bf16* OP, int gw, int NGW, int lane) {
#pragma unroll 1
    for (int task = gw; task < (M / 16) * 4; task += NGW) { const int g = 3 - (task & 3), tile = task >> 2;
        bf16x8 yf[4];
        if (g == 3) pool_window<16>(Z, 3, tile, lane, yf); else if (g == 2) pool_window<8>(Z, 2, tile, lane, yf);
        else if (g == 1) pool_window<4>(Z, 1, tile, lane, yf); else pool_window<2>(Z, 0, tile, lane, yf);
        pool_mma(WPt, pscale, OP, g, tile, lane, yf); }
    const int hh = lane >> 4;
#pragma unroll 1
    for (int m0 = gw; m0 < M; m0 += 4 * NGW) {
        v4u a[4], b[4], c[4]; float l0[4], l1[4], l2[4];
#pragma unroll
        for (int k = 0; k < 4; ++k) { const int m = m0 + k * NGW; if (m < M) {
            l0[k] = LSE[(size_t)m * 4 + hh]; l1[k] = LSE[((size_t)M + m) * 4 + hh]; l2[k] = LSE[((size_t)2 * M + m) * 4 + hh];
            a[k] = *(const GAS v4u*)(OG + (size_t)m * 512 + lane * 8); b[k] = *(const GAS v4u*)(OG + ((size_t)M + m) * 512 + lane * 8); c[k] = *(const GAS v4u*)(OG + ((size_t)2 * M + m) * 512 + lane * 8); } }
#pragma unroll
        for (int k = 0; k < 4; ++k) { const int m = m0 + k * NGW; if (m < M) {
            const float mx = fmaxf(l0[k], fmaxf(l1[k], l2[k])); const float e0 = __expf(l0[k] - mx), e1 = __expf(l1[k] - mx), e2 = __expf(l2[k] - mx); const float inv = 1.0f / (e0 + e1 + e2);
            const float w0 = e0 * inv, w1 = e1 * inv, w2 = e2 * inv; const v4u A = a[k], B = b[k], C = c[k];
            v4u o;
            o.x = pk2(w0 * bflo(A.x) + w1 * bflo(B.x) + w2 * bflo(C.x), w0 * bfhi(A.x) + w1 * bfhi(B.x) + w2 * bfhi(C.x));
            o.y = pk2(w0 * bflo(A.y) + w1 * bflo(B.y) + w2 * bflo(C.y), w0 * bfhi(A.y) + w1 * bfhi(B.y) + w2 * bfhi(C.y));
            o.z = pk2(w0 * bflo(A.z) + w1 * bflo(B.z) + w2 * bflo(C.z), w0 * bfhi(A.z) + w1 * bfhi(B.z) + w2 * bfhi(C.z));
            o.w = pk2(w0 * bflo(A.w) + w1 * bflo(B.w) + w2 * bflo(C.w), w0 * bfhi(A.w) + w1 * bfhi(B.w) + w2 * bfhi(C.w));
            *(GAS v4u*)(OA + (size_t)m * 512 + lane * 8) = o; } }
    }
}
struct Args { const float* in[16]; float* out; unsigned char* ws; int ph_lo, ph_hi; };
__global__ void __launch_bounds__(NWAVES * 64, 2) mk_fwd(Args args) {
    extern __shared__ __attribute__((aligned(16))) unsigned char lds_raw[];
    LAS unsigned char* lds = (LAS unsigned char*)lds_raw;
    volatile LAS unsigned* MISC = (volatile LAS unsigned*)(lds + MISC_OFF);
    LAS int* tab = (LAS int*)(lds + TAB_OFF);
    const int tid = threadIdx.x, lane = tid & 63, wave = __builtin_amdgcn_readfirstlane(tid >> 6);
    const int G = gridDim.x; const int bx = blockIdx.x; const int vcu = (G % 8 == 0) ? (bx % 8) * (G / 8) + bx / 8 : bx;
    const int gw = vcu * NWAVES + wave, NGW = G * NWAVES;
    Ptrs P;
    P.x = args.in[0]; P.w_in = args.in[1]; P.relb = args.in[2]; P.w_pool = args.in[3]; P.pscale = args.in[4]; P.w_ao = args.in[5]; P.w_po = args.in[6]; P.w_out = args.in[7];
    P.gains = args.in[8]; P.dwg = args.in[9]; P.dwu = args.in[10]; P.dwd = args.in[11]; P.wr = args.in[12]; P.mwg = args.in[13]; P.mwu = args.in[14]; P.mwd = args.in[15];
    P.out = args.out; P.ws = args.ws;
    unsigned char* ws = args.ws;
    gu32* ctl = (gu32*)(ws + WS_CTL);
    bf16* XN = (bf16*)(ws + WS_XN); bf16* Z = (bf16*)(ws + WS_Z); bf16* OG = (bf16*)(ws + WS_OG); bf16* OA = (bf16*)(ws + WS_OA); bf16* OP = (bf16*)(ws + WS_OP);
    bf16* TB = (bf16*)(ws + WS_T); bf16* MRG = (bf16*)(ws + WS_MRG); bf16* MIXb = (bf16*)(ws + WS_MIX); float* LSE = (float*)(ws + WS_LSE);
    bf16* HB = (bf16*)(ws + WS_HB);
    int* toke = (int*)(ws + WS_TOKE); int* tokp = (int*)(ws + WS_TOKP); float* tokw = (float*)(ws + WS_TOKW);
    for (int u = tid; u < (LDS_BYTES - LDSCTL_OFF) / 4; u += NWAVES * 64) ((LAS unsigned*)(lds + LDSCTL_OFF))[u] = 0u;
    __syncthreads();
    XcdBarrier bar; bar.bar = (unsigned*)(ctl + CW_BAR); bar.x = 0; bar.st = nullptr;
    if (!MK_SPLIT) bar = xcd_barrier_post((unsigned*)(ctl + CW_BAR), MISC + 8);
    const int lo = args.ph_lo, hi = args.ph_hi;
#define IN(k) (lo <= (k) && (k) < hi)
#define SEAM(k) do { if (IN(k) && IN((k) + 1)) xcd_barrier(bar); } while (0)
#define FRESH() int tid_ = threadIdx.x; asm volatile("" : "+v"(tid_)); const int lane_ = tid_ & 63, wave_ = __builtin_amdgcn_readfirstlane(tid_ >> 6), gw_ = vcu * NWAVES + wave_; (void)lane_; (void)wave_; (void)gw_

    if (IN(0)) { FRESH(); p0_convert(P, lds, gw_, NGW, wave_, lane_); norm_first(P.x, P.gains, XN, ws + WS_XN8, gw_, NGW, lane_); }
    SEAM(0);
    for (int layer = 0; layer < 2; ++layer) {
        const int pb = layer == 0 ? 1 : 10;
        const float* gl = P.gains + (size_t)layer * 4 * DM;
        if (IN(pb + 0)) {
            const bool conv_first = layer == 0 && ((bx >> 3) & 1) != 0, conv_last = layer == 0 && ((bx >> 3) & 1) == 0;
            if (conv_first) { FRESH(); conv_share_a(P, lds, gw_, NGW, wave_, lane_); __syncthreads(); }
            { pg8::Gemm g{XN, (const bf16*)(ws + WS_WIN) + (size_t)layer * INW * DM + (size_t)ZV * DM, M, ZGA - ZV, DM, 0}; pg8::StaticOrder S; S.init(M, ZGA - ZV, G, bx);
              pg8::EpiZ E{Z, INW, ZV, 1.0f, 1000, 0};
              pg8::gemm_phase<pg8::EpiZ, pg8::StaticOrder, true, true>(lds + RING_OFF, g, S, E); }
            { pg8::Gemm g{(const bf16*)(ws + WS_XN8), (const bf16*)(ws + WS_WIN8) + (size_t)layer * 3584 * DM, M, 7168, DM / 2, 0}; pg8::StaticOrder S; S.init(M, 7168, G, bx);
              pg8::EpiZ E{Z, INW, 0, 1.0f / WSCALE, 12, ZGA - 3072};
              pg8::gemm_phase<pg8::EpiZ, pg8::StaticOrder, true, true, true>(lds + RING_OFF, g, S, E); }
            if (QW > 0 && bx >= 128) { FRESH(); conv_quota(P, lds, layer ? 2 : 0, bx, wave_, lane_); }
            if (conv_last) { FRESH(); conv_share_a(P, lds, gw_, NGW, wave_, lane_); }
        }
        SEAM(pb + 0);
        if (IN(pb + 1)) { FRESH(); attn_phase(Z, P.relb, OG, LSE, lds, G, tid_, wave_, lane_); }
        SEAM(pb + 1);
        if (IN(pb + 2)) { FRESH(); combine_pool_phase(Z, OG, LSE, (const bf16*)(ws + WS_WPOOL) + (size_t)layer * 4 * 128 * 128, P.pscale + (size_t)layer * 512, OA, OP, gw_, NGW, lane_); }
        SEAM(pb + 2);
        if (IN(pb + 3)) {
            { pg8::Gemm g{OA, (const bf16*)(ws + WS_WAO) + (size_t)layer * DM * 512, M, DM, 512}; pg8::StaticOrder S; S.init(M, DM, G, bx);
              pg8::EpiGate<0> E{Z + ZGA, INW, nullptr, TB, DM};
              pg8::gemm_phase<pg8::EpiGate<0>, pg8::StaticOrder, true, true>(lds + RING_OFF, g, S, E); }
            { pg8::Gemm g{OP, (const bf16*)(ws + WS_WPO) + (size_t)layer * DM * 512, M, DM, 512}; pg8::StaticOrder S; S.init(M, DM, G, bx);
              pg8::EpiGate<1> E{Z + ZGB, INW, TB, MRG, DM};
              pg8::gemm_phase<pg8::EpiGate<1>, pg8::StaticOrder, true, true>(lds + RING_OFF, g, S, E); }
        }
        SEAM(pb + 3);
        if (IN(pb + 4)) {
            pg8::Gemm g{MRG, (const bf16*)(ws + WS_WOUT) + (size_t)layer * DM * DM, M, DM, DM}; pg8::StaticOrder S; S.init(M, DM, G, bx);
            pg8::EpiZ E{MIXb, DM, 0, 1.0f, 1000, 0};
            pg8::gemm_phase<pg8::EpiZ, pg8::StaticOrder, true, true>(lds + RING_OFF, g, S, E);
        }
        SEAM(pb + 4);
        if (IN(pb + 5)) {
            FRESH();
            if (layer == 0) norm_mid<false, false>(MIXb, P.x, HB, gl + DM, gl + 2 * DM, XN, nullptr, nullptr, ctl, toke, tokp, tokw, nullptr, gw_, NGW, lane_);
            else {
                LAS float* wrl = (LAS float*)(lds + RING_OFF);
                { float tmp[32];
#pragma unroll
                  for (int k = 0; k < 32; ++k) tmp[k] = P.wr[tid_ + 512 * k];
                  __builtin_amdgcn_sched_barrier(0);
#pragma unroll
                  for (int k = 0; k < 32; ++k) { const int i = tid_ + 512 * k; wrl[(i & 7) * DM + (i >> 3)] = tmp[k]; } }
                __syncthreads();
                norm_mid<true, true>(MIXb, HB, HB, gl + DM, gl + 2 * DM, XN, nullptr, wrl, ctl, toke, tokp, tokw, ws + WS_XP, gw_, NGW, lane_);
            }
        }
        SEAM(pb + 5);
        if (layer == 0) {
            if (IN(7)) {
                pg8::Gemm g{XN, (const bf16*)(ws + WS_DGU), M, 2 * DFF, DM}; pg8::StaticOrder S; S.init(M, 2 * DFF, G, bx);
                pg8::EpiSwiGLU E{(bf16*)(ws + WS_HM), DFF, 1.0f};
                pg8::gemm_phase<pg8::EpiSwiGLU, pg8::StaticOrder, true, true>(lds + RING_OFF, g, S, E);
                if (QW > 0 && bx >= 128) { FRESH(); conv_quota(P, lds, 1, bx, wave_, lane_); }
            }
            SEAM(7);
            if (IN(8)) {
                pg8::Gemm g{(const bf16*)(ws + WS_HM), (const bf16*)(ws + WS_DD), M, DM, DFF}; pg8::StaticOrder S; S.init(M, DM, G, bx);
                pg8::EpiZ E{MIXb, DM, 0, 1.0f, 1000, 0};
                const bool conv_first = ((bx >> 3) & 1) != 0;
                if (conv_first) { FRESH(); conv_share_gu(P, lds, gw_, NGW, wave_, lane_); __syncthreads(); }
                pg8::gemm_phase<pg8::EpiZ, pg8::StaticOrder, true, true>(lds + RING_OFF, g, S, E);
                if (!conv_first) { FRESH(); conv_share_gu(P, lds, gw_, NGW, wave_, lane_); }
            }
            SEAM(8);
            if (IN(9)) { FRESH(); norm_mid<false, true>(MIXb, HB, HB, P.gains + 3 * DM, P.gains + 4 * DM, XN, ws + WS_XN8, nullptr, ctl, toke, tokp, tokw, nullptr, gw_, NGW, lane_); }
            SEAM(9);
        } else {
            unsigned char* Xp = ws + WS_XP; unsigned char* HMp = ws + WS_HMP; bf16* Yp = (bf16*)(ws + WS_YP);
            if (IN(16)) { FRESH(); moe_tables(ctl, tab, tid_); }
            if (IN(17)) {
                if (MK_SPLIT) moe_tables(ctl, tab, tid);
                pg8::Gemm g{(const bf16*)Xp, (const bf16*)(ws + WS_MGU), MPAD, 2 * EFF, DM / 2}; pg8::MoeOrder S{__builtin_amdgcn_readfirstlane(tab[96]), (2 * EFF) / 256, G, bx, tab, XCAP / 256, 0, (2 * EFF) / 256, 0};
                pg8::EpiSwiGLU8 E{HMp, EFF, 1.0f / WSCALE};
                const int cut = 2 * ((bx >> 3) & 7);
#pragma unroll 1
                for (int part = 0; part < 2; ++part) {
                    pg8::SubOrder<pg8::MoeOrder> S2{S, part ? cut : 0, part ? (1 << 30) : cut};
                    pg8::gemm_phase<pg8::EpiSwiGLU8, pg8::SubOrder<pg8::MoeOrder>, true, true, true>(lds + RING_OFF, g, S2, E);
                    if (part == 0) { FRESH(); __syncthreads(); conv_share_down(P, lds, gw_, NGW, wave_, lane_); __syncthreads(); }
                }
            }
            SEAM(17);
            if (IN(18)) {
                if (MK_SPLIT) moe_tables(ctl, tab, tid);
                const int Pall = __builtin_amdgcn_readfirstlane(tab[96]), Pmain = Pall & ~31;
                pg8::EpiYp E{Yp, DM, 1.0f / WSCALE, (bf16*)(ws + WS_YT), Pmain};
                { pg8::Gemm g{(const bf16*)HMp, (const bf16*)(ws + WS_MD), MPAD, DM, EFF / 2, 0}; pg8::MoeOrder S{Pmain, DM / 256, G, bx, tab, 0, 0, DM / 256, 0};
                  pg8::gemm_phase<pg8::EpiYp, pg8::MoeOrder, true, true, true>(lds + RING_OFF, g, S, E); }
                if (Pall > Pmain) {
                  pg8::Gemm g{(const bf16*)HMp, (const bf16*)(ws + WS_MD), MPAD, DM, EFF / 8, EFF / 2}; pg8::MoeOrder S{Pall - Pmain, 4 * (DM / 256), G, bx, tab, 0, Pmain, DM / 256, EFF / 4};
                  pg8::gemm_phase<pg8::EpiYp, pg8::MoeOrder, true, true, true>(lds + RING_OFF, g, S, E); }
            }
            SEAM(18);
            if (IN(19)) {
                FRESH();
                if (MK_SPLIT) moe_tables(ctl, tab, tid_);
                norm_final(Yp, (const bf16*)(ws + WS_YT), P.gains + (size_t)(4 + 3) * DM, HB, P.out, toke, tokp, tokw, tab, gw_, NGW, lane_);
            }
        }
    }
#undef IN
#undef SEAM
}

extern "C" void kernel_launch(void* const* d_in, const int* in_sizes, int n_in, void* d_out, int out_size, void* d_ws, size_t ws_size, hipStream_t stream) {
    static int grid = 0;
    if (grid == 0) {
        if (n_in != 16 || out_size != M * DM || ws_size < WS_END) { fprintf(stderr, "kernel_launch: unexpected shapes (n_in %d out %d ws %zu, need %zu)\n", n_in, out_size, ws_size, (size_t)WS_END); grid = -1; return; }
        int dev = 0, cus = 0, per_cu = 0;
        if (hipGetDevice(&dev) != hipSuccess || hipDeviceGetAttribute(&cus, hipDeviceAttributeMultiprocessorCount, dev) != hipSuccess) { grid = -1; return; }
        if (hipFuncSetAttribute((const void*)mk_fwd, hipFuncAttributeMaxDynamicSharedMemorySize, LDS_BYTES) != hipSuccess) { fprintf(stderr, "kernel_launch: hipFuncSetAttribute failed\n"); grid = -1; return; }
        if (hipOccupancyMaxActiveBlocksPerMultiprocessor(&per_cu, (const void*)mk_fwd, NWAVES * 64, LDS_BYTES) != hipSuccess || per_cu < 1) { fprintf(stderr, "kernel_launch: occupancy query says %d\n", per_cu); }
        (void)hipGetLastError();
        if (cus < 256) { fprintf(stderr, "kernel_launch: built for a 256-CU device (got %d CUs)\n", cus); grid = -1; return; }
        grid = 256;
    }
    if (grid < 0) return;
    if (hipMemsetAsync((char*)d_ws + WS_CTL, 0, CTL_ZERO_BYTES, stream) != hipSuccess) return;
    Args a{};
    for (int i = 0; i < 16; ++i) a.in[i] = (const float*)d_in[i];
    a.out = (float*)d_out; a.ws = (unsigned char*)d_ws;
#if MK_SPLIT
    for (int ph = 0; ph < NPH; ++ph) { a.ph_lo = ph; a.ph_hi = ph + 1; hipLaunchKernelGGL(mk_fwd, dim3(grid), dim3(NWAVES * 64), LDS_BYTES, stream, a); }
#else
    a.ph_lo = 0; a.ph_hi = NPH;
    hipLaunchKernelGGL(mk_fwd, dim3(grid), dim3(NWAVES * 64), LDS_BYTES, stream, a);
#endif
    const hipError_t le = hipPeekAtLastError();
    if (le != hipSuccess) fprintf(stderr, "kernel_launch: launch failed: %s\n", hipGetErrorName(le));
}
```

```cpp
#include <hip/hip_runtime.h>
#include <cstdio>
#include <cstdint>
#ifndef MK_SPLIT
#define MK_SPLIT 0
#endif
namespace pg8 {
#define PG8_LAS __attribute__((address_space(3)))
typedef unsigned short bf16_t;
typedef short bf16x8 __attribute__((ext_vector_type(8)));
typedef float f32x4 __attribute__((ext_vector_type(4)));
typedef unsigned u32x4 __attribute__((ext_vector_type(4)));
typedef int i32x4 __attribute__((ext_vector_type(4)));
typedef int i32x8 __attribute__((ext_vector_type(8)));
constexpr int BM = 256, BK = 64, HALF = 128, HTB = HALF * BK * 2  , STAGE_BYTES = 8 * HTB, NXCD = 8, WGM = 8;

__host__ __device__ __forceinline__ int lds_byte(int r, int c) { const int st = (r >> 4) * 2 + (c >> 5), rr = r & 15, cc = c & 31, ob = rr * 64 + cc * 2; return st * 1024 + (ob ^ (((ob >> 9) & 1) << 5)); }
__host__ __device__ __forceinline__ void stage_rc(int b, int& R, int& C) { const int st = b / 1024, sb = b % 1024, swz = sb ^ (((sb >> 9) & 1) << 5); R = (st >> 1) * 16 + swz / 64; C = (st & 1) * 32 + (swz % 64) / 2; }
__host__ __device__ __forceinline__ int perm32(int rho) { const int n = rho >> 4, i = rho & 15; return 8 * (i >> 2) + 4 * n + (i & 3); }

struct Unit { int pm, pn, pb, ko, ks, pa; };
struct Gemm { const bf16_t* A; const bf16_t* Bt; int M, N, K, ld; };

struct StaticOrder {
    int nM, nN, nwg, G, c;
    __host__ __device__ void init(int M, int N, int G_, int c_) { nM = M / BM; nN = N / BM; nwg = nM * nN; G = G_; c = c_; }
    __host__ __device__ bool next(int i, Unit& u) const {
        const long L = (long)i * G + c; if (L >= nwg) return false;
        int wgid = (int)L; { const int q = nwg / NXCD, r = nwg % NXCD, xcd = wgid % NXCD, off = wgid / NXCD; wgid = (xcd < r ? xcd * (q + 1) : r * (q + 1) + (xcd - r) * q) + off; }
        const int nig = WGM * nN, gid = wgid / nig, fm = gid * WGM, gsz = (nM - fm) < WGM ? (nM - fm) : WGM;
        u.pm = fm + ((wgid % nig) % gsz); u.pn = (wgid % nig) / gsz; u.pb = u.pn; u.ko = 0; u.ks = 0; u.pa = u.pm; return true;
    }
    __device__ __forceinline__ void a_ready(const Unit&) const {}
    __device__ __forceinline__ void done(const Unit&) const {}
};

typedef __bf16 bf16x2_t __attribute__((ext_vector_type(2)));
__device__ __forceinline__ unsigned cvt_pk_bf16(float lo, float hi) { typedef float f32x2v __attribute__((ext_vector_type(2))); const f32x2v v = {lo, hi}; return __builtin_bit_cast(unsigned, __builtin_convertvector(v, bf16x2_t)); }
typedef float f32x2 __attribute__((ext_vector_type(2)));
__device__ __forceinline__ f32x2 gelu_pk(f32x2 v) {
    const f32x2 av = __builtin_elementwise_abs(v), d = av * 0.2316418882f + 1.0f;
    f32x2 t; t.x = __builtin_amdgcn_rcpf(d.x); t.y = __builtin_amdgcn_rcpf(d.y);
    f32x2 q = t * 0.5307027145f + (-0.7265760135f); q = q * t + 0.7107068705f; q = q * t + (-0.142248368f); q = q * t + 0.127414796f; q = q * t;
    const f32x2 s = (v * v) * (-0.72134752044f);
    f32x2 e; e.x = __builtin_amdgcn_exp2f(s.x); e.y = __builtin_amdgcn_exp2f(s.y);
    const f32x2 m = v * (q * e), r = v - m;
    f32x2 o; o.x = v.x < 0.f ? m.x : r.x; o.y = v.y < 0.f ? m.y : r.y; return o;
}

__device__ __forceinline__ f32x2 sigmoid_pk(f32x2 x, float c1) { const f32x2 t = x * c1; f32x2 e; e.x = __builtin_amdgcn_exp2f(t.x); e.y = __builtin_amdgcn_exp2f(t.y); const f32x2 d = e + 1.0f;
    f32x2 r; r.x = __builtin_amdgcn_rcpf(d.x); r.y = __builtin_amdgcn_rcpf(d.y); return r; }
__device__ __forceinline__ f32x2 swiglu_pk(f32x2 a, f32x2 b, float c1, float k2) { return (a * b) * (sigmoid_pk(a, c1) * k2); }
__device__ __forceinline__ float sigmoid_f(float v) { return __builtin_amdgcn_rcpf(1.0f + __builtin_amdgcn_exp2f(-1.4426950408889634f * v)); }
__device__ __forceinline__ float bf_lo(unsigned w) { return __uint_as_float(w << 16); }
__device__ __forceinline__ float bf_hi(unsigned w) { return __uint_as_float(w & 0xffff0000u); }
struct EpiZ {
    static constexpr bool PERM = true, AFTER_DRAIN = false; static constexpr int NST = 16;
    bf16_t* O; int ldc; int col_off; float sc; int sig_from; int gap;
    __device__ __forceinline__ void operator()(const f32x4 (&acc)[2][2][4][2], const Unit& u, int wr, int wc, int fr, int fq) const {
        const bool sg = u.pn >= sig_from;
        const int row0 = u.pm * BM + wr * 64 + fr, col0 = col_off + u.pn * BM + (sg ? gap : 0) + wc * 32 + 8 * fq;
#pragma unroll
        for (int ai = 0; ai < 2; ++ai)
#pragma unroll
            for (int m = 0; m < 4; ++m) { bf16_t* rowp = O + (size_t)(row0 + ai * HALF + m * 16) * ldc + col0;
#pragma unroll
                for (int bj = 0; bj < 2; ++bj) { f32x4 v0, v1;
                    if (sg) { const float c1 = -1.4426950408889634f * sc; const f32x4 x0 = acc[ai][bj][m][0], x1 = acc[ai][bj][m][1];
                        const f32x2 a = sigmoid_pk((f32x2){x0[0], x0[1]}, c1), b = sigmoid_pk((f32x2){x0[2], x0[3]}, c1), c = sigmoid_pk((f32x2){x1[0], x1[1]}, c1), d = sigmoid_pk((f32x2){x1[2], x1[3]}, c1);
                        v0 = (f32x4){a.x, a.y, b.x, b.y}; v1 = (f32x4){c.x, c.y, d.x, d.y}; }
                    else { v0 = acc[ai][bj][m][0] * sc; v1 = acc[ai][bj][m][1] * sc; }
                    u32x4 w; w.x = cvt_pk_bf16(v0[0], v0[1]); w.y = cvt_pk_bf16(v0[2], v0[3]); w.z = cvt_pk_bf16(v1[0], v1[1]); w.w = cvt_pk_bf16(v1[2], v1[3]);
                    *(u32x4*)(rowp + bj * HALF) = w; } }
    }
};
template <int MODE> struct EpiGate {
    static constexpr bool PERM = true, AFTER_DRAIN = false; static constexpr int NST = 0;
    const bf16_t* G; int ldg; const bf16_t* Tin; bf16_t* O; int ldc;
    __device__ __forceinline__ void operator()(const f32x4 (&acc)[2][2][4][2], const Unit& u, int wr, int wc, int fr, int fq) const {
        const int row0 = u.pm * BM + wr * 64 + fr, col0 = u.pn * BM + wc * 32 + 8 * fq;
#pragma unroll
        for (int ai = 0; ai < 2; ++ai)
#pragma unroll
          for (int mh = 0; mh < 2; ++mh) {
            u32x4 gw[2][2], tw[2][2];
#pragma unroll
            for (int mm = 0; mm < 2; ++mm)
#pragma unroll
                for (int bj = 0; bj < 2; ++bj) { const size_t row = (size_t)(row0 + ai * HALF + (2 * mh + mm) * 16); const int col = col0 + bj * HALF;
                    gw[mm][bj] = *(const u32x4*)(G + row * ldg + col); if (MODE == 1) tw[mm][bj] = *(const u32x4*)(Tin + row * ldc + col); }
            __builtin_amdgcn_sched_barrier(0);
#pragma unroll
            for (int mm = 0; mm < 2; ++mm)
#pragma unroll
                for (int bj = 0; bj < 2; ++bj) { const int m = 2 * mh + mm; const size_t row = (size_t)(row0 + ai * HALF + m * 16); const int col = col0 + bj * HALF; const u32x4 g4 = gw[mm][bj];
                    f32x4 v0 = acc[ai][bj][m][0], v1 = acc[ai][bj][m][1];
                    v0[0] *= bf_lo(g4.x); v0[1] *= bf_hi(g4.x); v0[2] *= bf_lo(g4.y); v0[3] *= bf_hi(g4.y);
                    v1[0] *= bf_lo(g4.z); v1[1] *= bf_hi(g4.z); v1[2] *= bf_lo(g4.w); v1[3] *= bf_hi(g4.w);
                    if (MODE == 1) { const u32x4 t4 = tw[mm][bj];
                        v0[0] += bf_lo(t4.x); v0[1] += bf_hi(t4.x); v0[2] += bf_lo(t4.y); v0[3] += bf_hi(t4.y);
                        v1[0] += bf_lo(t4.z); v1[1] += bf_hi(t4.z); v1[2] += bf_lo(t4.w); v1[3] += bf_hi(t4.w); }
                    u32x4 w; w.x = cvt_pk_bf16(v0[0], v0[1]); w.y = cvt_pk_bf16(v0[2], v0[3]); w.z = cvt_pk_bf16(v1[0], v1[1]); w.w = cvt_pk_bf16(v1[2], v1[3]);
                    *(u32x4*)(O + row * ldc + col) = w; }
            __builtin_amdgcn_sched_barrier(0);
          }
    }
};
struct EpiF32 {
    static constexpr bool PERM = false, AFTER_DRAIN = false; static constexpr int NST = 0;
    float* C; int ldc;
    __device__ __forceinline__ void operator()(const f32x4 (&acc)[2][2][4][2], const Unit& u, int wr, int wc, int fr, int fq) const {
        const int row0 = u.pm * BM + wr * 64 + fr, col0 = u.pn * BM + wc * 32 + 4 * fq;
#pragma unroll
        for (int ai = 0; ai < 2; ++ai)
#pragma unroll
            for (int m = 0; m < 4; ++m) { float* rowp = C + (size_t)(row0 + ai * HALF + m * 16) * ldc + col0;
#pragma unroll
                for (int bj = 0; bj < 2; ++bj)
#pragma unroll
                    for (int n = 0; n < 2; ++n) *(f32x4*)(rowp + bj * HALF + n * 16) = acc[ai][bj][m][n]; }
    }
};
struct EpiSwiGLU {
    static constexpr bool PERM = true, AFTER_DRAIN = false; static constexpr int NST = 8;
    bf16_t* O; int ldo; float sc;
    __device__ __forceinline__ void operator()(const f32x4 (&acc)[2][2][4][2], const Unit& u, int wr, int wc, int fr, int fq) const {
        const int row0 = u.pm * BM + wr * 64 + fr, col0 = u.pn * HALF + wc * 32 + 8 * fq;
#pragma unroll
        for (int ai = 0; ai < 2; ++ai)
#pragma unroll
            for (int m = 0; m < 4; ++m) { bf16_t* rowp = O + (size_t)(row0 + ai * HALF + m * 16) * ldo + col0;
                f32x4 v0, v1;
                { const f32x4 g0 = acc[ai][0][m][0], g1 = acc[ai][0][m][1], u0 = acc[ai][1][m][0], u1 = acc[ai][1][m][1]; const float c1 = -1.4426950408889634f * sc, k2 = sc * sc;
                  const f32x2 a = swiglu_pk((f32x2){g0[0], g0[1]}, (f32x2){u0[0], u0[1]}, c1, k2), b = swiglu_pk((f32x2){g0[2], g0[3]}, (f32x2){u0[2], u0[3]}, c1, k2),
                              c = swiglu_pk((f32x2){g1[0], g1[1]}, (f32x2){u1[0], u1[1]}, c1, k2), d = swiglu_pk((f32x2){g1[2], g1[3]}, (f32x2){u1[2], u1[3]}, c1, k2);
                  v0 = (f32x4){a.x, a.y, b.x, b.y}; v1 = (f32x4){c.x, c.y, d.x, d.y}; }
                u32x4 w; w.x = cvt_pk_bf16(v0[0], v0[1]); w.y = cvt_pk_bf16(v0[2], v0[3]); w.z = cvt_pk_bf16(v1[0], v1[1]); w.w = cvt_pk_bf16(v1[2], v1[3]);
                *(u32x4*)rowp = w; __builtin_amdgcn_sched_barrier(0); }
    }
};
__device__ __forceinline__ float clamp8(float v) { return __builtin_fminf(__builtin_fmaxf(v, -440.f), 440.f); }
__device__ __forceinline__ unsigned pack4_fp8(float a, float b, float c, float d) { int w = __builtin_amdgcn_cvt_pk_fp8_f32(clamp8(a), clamp8(b), 0, false); w = __builtin_amdgcn_cvt_pk_fp8_f32(clamp8(c), clamp8(d), w, true); return (unsigned)w; }
struct EpiSwiGLU8 {
    static constexpr bool PERM = true, AFTER_DRAIN = false; static constexpr int NST = 8;
    unsigned char* O; int ldo; float sc;
    __device__ __forceinline__ void operator()(const f32x4 (&acc)[2][2][4][2], const Unit& u, int wr, int wc, int fr, int fq) const {
        const int row0 = u.pm * BM + wr * 64 + fr, col0 = u.pn * HALF + wc * 32 + 8 * fq;
#pragma unroll
        for (int ai = 0; ai < 2; ++ai)
#pragma unroll
            for (int m = 0; m < 4; ++m) { unsigned char* rowp = O + (size_t)(row0 + ai * HALF + m * 16) * ldo + col0;
                f32x4 v0, v1;
                { const f32x4 g0 = acc[ai][0][m][0], g1 = acc[ai][0][m][1], u0 = acc[ai][1][m][0], u1 = acc[ai][1][m][1]; const float c1 = -1.4426950408889634f * sc, k2 = sc * sc;
                  const f32x2 a = swiglu_pk((f32x2){g0[0], g0[1]}, (f32x2){u0[0], u0[1]}, c1, k2), b = swiglu_pk((f32x2){g0[2], g0[3]}, (f32x2){u0[2], u0[3]}, c1, k2),
                              c = swiglu_pk((f32x2){g1[0], g1[1]}, (f32x2){u1[0], u1[1]}, c1, k2), d = swiglu_pk((f32x2){g1[2], g1[3]}, (f32x2){u1[2], u1[3]}, c1, k2);
                  v0 = (f32x4){a.x, a.y, b.x, b.y}; v1 = (f32x4){c.x, c.y, d.x, d.y}; }
                typedef unsigned u32x2 __attribute__((ext_vector_type(2)));
                u32x2 w; w.x = pack4_fp8(v0[0], v0[1], v0[2], v0[3]); w.y = pack4_fp8(v1[0], v1[1], v1[2], v1[3]);
                *(u32x2*)rowp = w; __builtin_amdgcn_sched_barrier(0); }
    }
};
struct EpiYp {
    static constexpr bool PERM = true, AFTER_DRAIN = false; static constexpr int NST = 16;
    bf16_t* C; int ldc; float sc; bf16_t* Ct; int pm0;
    __device__ __forceinline__ void operator()(const f32x4 (&acc)[2][2][4][2], const Unit& u, int wr, int wc, int fr, int fq) const {
        const int row0 = u.pm * BM + wr * 64 + fr, col0 = u.pn * BM + wc * 32 + 8 * fq;
        bf16_t* base = u.ks == 0 ? C + (size_t)row0 * ldc : Ct + ((size_t)(u.ks - 1) * 2048 + (row0 - pm0 * BM)) * ldc;
#pragma unroll
        for (int ai = 0; ai < 2; ++ai)
#pragma unroll
            for (int m = 0; m < 4; ++m) { bf16_t* rowp = base + (size_t)(ai * HALF + m * 16) * ldc + col0;
#pragma unroll
                for (int bj = 0; bj < 2; ++bj) { const f32x4 v0 = acc[ai][bj][m][0] * sc, v1 = acc[ai][bj][m][1] * sc;
                    u32x4 w; w.x = cvt_pk_bf16(v0[0], v0[1]); w.y = cvt_pk_bf16(v0[2], v0[3]); w.z = cvt_pk_bf16(v1[0], v1[1]); w.w = cvt_pk_bf16(v1[2], v1[3]);
                    *(u32x4*)(rowp + bj * HALF) = w; } }
    }
};
struct MoeOrder {
    int P, NT, G, c; const PG8_LAS int* pexp;
    int acap;
    int pm0, NTC, kbytes;
    __device__ __forceinline__ bool next(int i, Unit& u) const {
        const int U = ((i * 8 + (c & 7)) * 32) + (c >> 3); if (U >= P * NT) return false;
        const int gsz = 4 * NT, g = U / gsz, up = U - g * gsz; int pl = P - 4 * g; pl = pl > 4 ? 4 : pl;
        const int blk = pl * 8, j = up / blk, rr = up - j * blk, v = 8 * j + rr / pl;
        u.pm = pm0 + 4 * g + rr % pl; u.ks = v / NTC; u.pn = v - u.ks * NTC; u.ko = u.ks * kbytes; const int e = __builtin_amdgcn_readfirstlane(pexp[u.pm]); u.pb = e * NTC + u.pn;
        u.pa = acap ? e * acap + u.pm - (__builtin_amdgcn_readfirstlane(pexp[80 + e]) >> 8) : u.pm; return true;
    }
    __device__ __forceinline__ void a_ready(const Unit&) const {}
    __device__ __forceinline__ void done(const Unit&) const {}
};

template <class S> struct SubOrder {
    S s; int lo, hi;
    __device__ __forceinline__ bool next(int i, Unit& u) const { return (lo + i < hi) && s.next(lo + i, u); }
    __device__ __forceinline__ void a_ready(const Unit& u) const { s.a_ready(u); }
    __device__ __forceinline__ void done(const Unit& u) const { s.done(u); }
};

template <bool F8> struct Frag;
template <> struct Frag<false> { bf16x8 v[2]; __device__ __forceinline__ void set(int k, bf16x8 x) { v[k] = x; } };
template <> struct Frag<true> { i32x8 w; __device__ __forceinline__ void set(int k, bf16x8 x) { if (k == 0) w.lo = __builtin_bit_cast(i32x4, x); else w.hi = __builtin_bit_cast(i32x4, x); } };
template <class Epi, class Sched, bool ALIGN_EPI = false, bool SP2 = false, bool FP8 = false>
__device__ __forceinline__ void gemm_phase(PG8_LAS unsigned char* lds, const Gemm g, const Sched& S, const Epi& E) {
    int tid = threadIdx.x; asm volatile("" : "+v"(tid));
    const int wid = __builtin_amdgcn_readfirstlane(tid >> 6), lane = tid & 63, wr = wid >> 2, wc = wid & 3, fr = lane & 15, fq = lane >> 4;
    const int K = g.K, nt = K / BK, LD = g.ld ? g.ld : g.K;
    unsigned voffA[2], voffB[2];
#pragma unroll
    for (int i = 0; i < 2; ++i) { int R, C; stage_rc(tid * 16 + i * 8192, R, C); const int Rb = Epi::PERM ? ((R & ~31) + perm32(R & 31)) : R;
        voffA[i] = (unsigned)(R * LD + C) * 2u; voffB[i] = (unsigned)(Rb * LD + C) * 2u; }
    const size_t kstep = (size_t)(BK * 2);
    const size_t hstep = (size_t)HALF * LD * 2;
    const size_t tstep = 2 * hstep;
    const unsigned ldsw = (unsigned)wid * 1024u;
    const int aoff = lds_byte(wr * 64 + fr, fq * 8), boff = lds_byte(wc * 32 + fr, fq * 8);
#define PG8_SA(b, h) (((b) * 2 + (h)) * HTB)
#define PG8_SB(b, h) ((4 + (b) * 2 + (h)) * HTB)
#define PG8_STAGE(bufoff, gbase, voff) do { _Pragma("unroll") for (int _i = 0; _i < 2; ++_i) \
        __builtin_amdgcn_global_load_lds((const unsigned*)((const char*)(gbase) + (voff)[_i]), (PG8_LAS unsigned*)(lds + (bufoff) + ldsw + _i * 8192), 16, 0, 0); } while (0)
#define PG8_LDA(dst, b, h) do { _Pragma("unroll") for (int m = 0; m < 4; ++m) _Pragma("unroll") for (int k = 0; k < 2; ++k) dst[m].set(k, *(const PG8_LAS bf16x8*)(lds + PG8_SA(b, h) + aoff + m * 2048 + k * 1024)); } while (0)
#define PG8_LDB(dst, b, h) do { _Pragma("unroll") for (int n = 0; n < 2; ++n) _Pragma("unroll") for (int k = 0; k < 2; ++k) dst[n].set(k, *(const PG8_LAS bf16x8*)(lds + PG8_SB(b, h) + boff + n * 2048 + k * 1024)); } while (0)
#define PG8_MMA(ai, bj, At, Bt) do { __builtin_amdgcn_s_setprio(1); _Pragma("unroll") for (int m = 0; m < 4; ++m) _Pragma("unroll") for (int n = 0; n < 2; ++n) { \
        if constexpr (FP8) asm volatile("v_mfma_scale_f32_16x16x128_f8f6f4 %0, %1, %2, %0, %3, %3 op_sel_hi:[0,0,0]" : "+v"(acc[ai][bj][m][n]) : "v"(Bt[n].w), "v"(At[m].w), "v"(sc1));   \
        else { _Pragma("unroll") for (int k = 0; k < 2; ++k) acc[ai][bj][m][n] = __builtin_amdgcn_mfma_f32_16x16x32_bf16(Bt[n].v[k], At[m].v[k], acc[ai][bj][m][n], 0, 0, 0); } } __builtin_amdgcn_s_setprio(0); } while (0)
#define PG8_MMAZ(ai, bj, At, Bt) do { __builtin_amdgcn_s_setprio(1); _Pragma("unroll") for (int m = 0; m < 4; ++m) _Pragma("unroll") for (int n = 0; n < 2; ++n) { \
        if constexpr (FP8) asm volatile("v_mfma_scale_f32_16x16x128_f8f6f4 %0, %1, %2, 0, %3, %3 op_sel_hi:[0,0,0]" : "=&v"(acc[ai][bj][m][n]) : "v"(Bt[n].w), "v"(At[m].w), "v"(sc1)); \
        else { acc[ai][bj][m][n] = __builtin_amdgcn_mfma_f32_16x16x32_bf16(Bt[n].v[0], At[m].v[0], (f32x4){0.f, 0.f, 0.f, 0.f}, 0, 0, 0); \
               acc[ai][bj][m][n] = __builtin_amdgcn_mfma_f32_16x16x32_bf16(Bt[n].v[1], At[m].v[1], acc[ai][bj][m][n], 0, 0, 0); } } __builtin_amdgcn_s_setprio(0); } while (0)
#define PG8_WAIT_V(n) asm volatile("s_waitcnt vmcnt(" #n ")" ::: "memory")
#define PG8_WAIT_V8E do { if constexpr (Epi::NST == 16) { if (relax) PG8_WAIT_V(24); else PG8_WAIT_V(8); } else if constexpr (Epi::NST == 8) { if (relax) PG8_WAIT_V(16); else PG8_WAIT_V(8); } else PG8_WAIT_V(8); } while (0)
#define PG8_WAIT_L(n) asm volatile("s_waitcnt lgkmcnt(" #n ")" ::: "memory")
#define PG8_BAR __builtin_amdgcn_s_barrier()
#define PG8_SCHED __builtin_amdgcn_sched_barrier(0)
    Unit cur, nxt; int ui = 0;
    if (!S.next(0, cur)) return;
    f32x4 acc[2][2][4][2];
#pragma unroll
    for (int a = 0; a < 2; ++a)
#pragma unroll
        for (int b = 0; b < 2; ++b)
#pragma unroll
            for (int m = 0; m < 4; ++m)
#pragma unroll
                for (int n = 0; n < 2; ++n) { if constexpr (SP2 && FP8) asm volatile("" : "=v"(acc[a][b][m][n])); else acc[a][b][m][n] = (f32x4){0.f, 0.f, 0.f, 0.f}; }
    Frag<FP8> At[4], B0[2], B1[2];
    int sc1 = 0x7f7f7f7f; asm volatile("" : "+v"(sc1));
    (void)sc1;
    const char* cA = (const char*)g.A + (size_t)cur.pa * tstep + cur.ko; const char* cB = (const char*)g.Bt + (size_t)cur.pb * tstep + cur.ko;
    asm volatile("" : "+v"(voffA[0]), "+v"(voffA[1]), "+v"(voffB[0]), "+v"(voffB[1]));
    S.a_ready(cur);
    if constexpr (SP2) {
        PG8_STAGE(PG8_SB(0, 0), cB, voffB); PG8_STAGE(PG8_SB(0, 1), cB + hstep, voffB); PG8_STAGE(PG8_SA(0, 0), cA, voffA); PG8_STAGE(PG8_SA(0, 1), cA + hstep, voffA);
        if (wr == 1) PG8_BAR;
        PG8_WAIT_V(2); PG8_BAR;
        PG8_STAGE(PG8_SB(1, 0), cB + kstep, voffB); PG8_STAGE(PG8_SA(1, 0), cA + kstep, voffA); PG8_STAGE(PG8_SB(1, 1), cB + hstep + kstep, voffB);
        PG8_WAIT_V(6); PG8_BAR;
    } else {
        PG8_STAGE(PG8_SB(0, 0), cB, voffB); PG8_STAGE(PG8_SA(0, 0), cA, voffA); PG8_STAGE(PG8_SB(0, 1), cB + hstep, voffB); PG8_STAGE(PG8_SA(0, 1), cA + hstep, voffA);
        if (wr == 1) PG8_BAR;
        PG8_WAIT_V(4); PG8_BAR;
        PG8_STAGE(PG8_SB(1, 0), cB + kstep, voffB); PG8_STAGE(PG8_SA(1, 0), cA + kstep, voffA); PG8_STAGE(PG8_SB(1, 1), cB + hstep + kstep, voffB);
        PG8_WAIT_V(6); PG8_BAR;
    }
    for (;;) {
        const bool has_next = S.next(ui + 1, nxt);
        const char* nA = has_next ? (const char*)g.A + (size_t)nxt.pa * tstep + nxt.ko : cA; const char* nB = has_next ? (const char*)g.Bt + (size_t)nxt.pb * tstep + nxt.ko : cB;
        for (int t = 0; t < nt; t += 2) {
            const bool last = (t == nt - 2);
            int relax = __builtin_amdgcn_readfirstlane((t == 0 && ui > 0) ? 1 : 0); asm volatile("" : "+s"(relax));
            const char* a1 = cA + (size_t)(t + 1) * kstep;
            const char* a2 = last ? nA : cA + (size_t)(t + 2) * kstep; const char* b2 = last ? nB : cB + (size_t)(t + 2) * kstep;
            const char* a3 = a2 + kstep; const char* b3 = b2 + kstep;
            if (last && has_next) S.a_ready(nxt);
            if constexpr (SP2) {
            PG8_LDB(B0, 0, 0); PG8_LDB(B1, 0, 1); PG8_SCHED; PG8_LDA(At, 0, 0); PG8_STAGE(PG8_SA(1, 1), a1 + hstep, voffA);
            PG8_WAIT_V8E; PG8_WAIT_L(0); PG8_BAR; if (FP8 && t == 0) { PG8_MMAZ(0, 0, At, B0); PG8_MMAZ(0, 1, At, B1); } else { PG8_MMA(0, 0, At, B0); PG8_MMA(0, 1, At, B1); } PG8_BAR; PG8_SCHED;
            PG8_LDA(At, 0, 1); PG8_STAGE(PG8_SB(0, 0), b2, voffB); PG8_STAGE(PG8_SB(0, 1), b2 + hstep, voffB); PG8_STAGE(PG8_SA(0, 0), a2, voffA);
            PG8_WAIT_V8E; PG8_WAIT_L(0); PG8_BAR; if (FP8 && t == 0) { PG8_MMAZ(1, 0, At, B0); PG8_MMAZ(1, 1, At, B1); } else { PG8_MMA(1, 0, At, B0); PG8_MMA(1, 1, At, B1); } PG8_BAR; PG8_SCHED;
            PG8_LDB(B0, 1, 0); PG8_LDB(B1, 1, 1); PG8_SCHED; PG8_LDA(At, 1, 0); PG8_STAGE(PG8_SA(0, 1), a2 + hstep, voffA);
            PG8_WAIT_V(8); PG8_WAIT_L(0); PG8_BAR; PG8_MMA(0, 0, At, B0); PG8_MMA(0, 1, At, B1); PG8_BAR; PG8_SCHED;
            PG8_LDA(At, 1, 1); PG8_STAGE(PG8_SB(1, 0), b3, voffB); PG8_STAGE(PG8_SB(1, 1), b3 + hstep, voffB); PG8_STAGE(PG8_SA(1, 0), a3, voffA);
            PG8_WAIT_V(8); PG8_WAIT_L(0); PG8_BAR; PG8_MMA(1, 0, At, B0); PG8_MMA(1, 1, At, B1); PG8_BAR; PG8_SCHED;
            } else {
            PG8_LDB(B0, 0, 0); PG8_SCHED; PG8_LDA(At, 0, 0); PG8_STAGE(PG8_SA(1, 1), a1 + hstep, voffA);
            PG8_WAIT_L(8); PG8_BAR; PG8_WAIT_L(0); PG8_MMA(0, 0, At, B0); PG8_BAR; PG8_SCHED;
            PG8_LDB(B1, 0, 1); PG8_STAGE(PG8_SB(0, 0), b2, voffB);
            PG8_BAR; PG8_WAIT_L(0); PG8_MMA(0, 1, At, B1); PG8_BAR;
            PG8_LDA(At, 0, 1); PG8_STAGE(PG8_SA(0, 0), a2, voffA);
            PG8_BAR; PG8_WAIT_L(0); PG8_MMA(1, 0, At, B0); PG8_BAR; PG8_SCHED;
            PG8_STAGE(PG8_SB(0, 1), b2 + hstep, voffB);
            PG8_WAIT_V(6); PG8_BAR; PG8_MMA(1, 1, At, B1); PG8_BAR;
            PG8_LDB(B0, 1, 0); PG8_SCHED; PG8_LDA(At, 1, 0); PG8_STAGE(PG8_SA(0, 1), a2 + hstep, voffA);
            PG8_WAIT_L(8); PG8_BAR; PG8_WAIT_L(0); PG8_MMA(0, 0, At, B0); PG8_BAR; PG8_SCHED;
            PG8_LDB(B1, 1, 1); PG8_STAGE(PG8_SB(1, 0), b3, voffB);
            PG8_BAR; PG8_WAIT_L(0); PG8_MMA(0, 1, At, B1); PG8_BAR;
            PG8_LDA(At, 1, 1); PG8_STAGE(PG8_SA(1, 0), a3, voffA);
            PG8_BAR; PG8_WAIT_L(0); PG8_MMA(1, 0, At, B0); PG8_BAR; PG8_SCHED;
            PG8_STAGE(PG8_SB(1, 1), b3 + hstep, voffB);
            PG8_WAIT_V(6); PG8_BAR; PG8_MMA(1, 1, At, B1); PG8_BAR;
            }
        }
        if constexpr (FP8) asm volatile("s_nop 7\n\ts_nop 7\n\ts_nop 7" ::: "memory");
        if constexpr (FP8) {
#pragma unroll
            for (int a = 0; a < 2; ++a)
#pragma unroll
                for (int b = 0; b < 2; ++b)
#pragma unroll
                    for (int m = 0; m < 4; ++m)
#pragma unroll
                        for (int n = 0; n < 2; ++n) asm volatile("" : "+v"(acc[a][b][m][n]));
        }
        if constexpr (ALIGN_EPI) { if (wr == 0) PG8_BAR; }
        if constexpr (!Epi::AFTER_DRAIN) { E(acc, cur, wr, wc, fr, fq); S.done(cur); }
        if (!has_next) break;
#pragma unroll
        for (int a = 0; a < 2; ++a)
#pragma unroll
            for (int b = 0; b < 2; ++b)
#pragma unroll
                for (int m = 0; m < 4; ++m)
#pragma unroll
                    for (int n = 0; n < 2; ++n) { if constexpr (!(SP2 && FP8)) acc[a][b][m][n] = (f32x4){0.f, 0.f, 0.f, 0.f}; }
        cur = nxt; cA = nA; cB = nB; ++ui;
        if constexpr (ALIGN_EPI) { if (wr == 1) PG8_BAR; }
    }
    PG8_WAIT_V(0);
    if constexpr (!ALIGN_EPI) { if (wr == 0) PG8_BAR; }
    PG8_BAR;
    if constexpr (Epi::AFTER_DRAIN) { E.fused(acc, cur, wr, wc, fr, fq, lds, wid, lane); S.done(cur); }
#undef PG8_SA
#undef PG8_SB
#undef PG8_STAGE
#undef PG8_LDA
#undef PG8_LDB
#undef PG8_MMA
#undef PG8_MMAZ
#undef PG8_WAIT_V
#undef PG8_WAIT_V8E
#undef PG8_WAIT_L
#undef PG8_BAR
#undef PG8_SCHED
}
}
constexpr int NWAVES = 8;
constexpr int BATCH = 2, SEQ = 4096, DM = 2048, M = BATCH * SEQ;
constexpr int INW = 9216, ZQ = 0, ZK = 1536, ZV = 3072, ZP = 4608, ZGA = 5120, ZGB = 7168;
constexpr int DFF = 5632, EFF = 7168, NEXP = 8;
constexpr int XCAP = M;
constexpr int MPAD = 2 * M + NEXP * 256;
constexpr float RMS_EPS = 1e-6f;
constexpr int NPH = 20;
constexpr size_t MiB = 1u << 20;
constexpr size_t WS_CTL = 0, CTL_ZERO_BYTES = 1 * MiB;
constexpr size_t WS_LSE = 1 * MiB, WS_TOKE = WS_LSE + 512 * 1024, WS_TOKP = WS_TOKE + 64 * 1024, WS_TOKW = WS_TOKP + 64 * 1024;
constexpr size_t WS_WIN = 2 * MiB;
constexpr size_t WS_WAO = WS_WIN + 72 * MiB;
constexpr size_t WS_WPO = WS_WAO + 4 * MiB;
constexpr size_t WS_WOUT = WS_WPO + 4 * MiB;
constexpr size_t WS_WPOOL = WS_WOUT + 16 * MiB;
constexpr size_t WS_DGU = WS_WPOOL + 1 * MiB;
constexpr size_t WS_DD = WS_DGU + 44 * MiB;
constexpr size_t WS_MGU = WS_DD + 22 * MiB;
constexpr size_t WS_MD = WS_MGU + 448 * MiB;
constexpr size_t WS_XN = WS_MD + 224 * MiB;
constexpr size_t WS_A = WS_XN + 32 * MiB;
constexpr size_t WS_Z = WS_A, WS_OG = WS_A + 144 * MiB, WS_OA = WS_A + 168 * MiB, WS_OP = WS_A + 176 * MiB, WS_HM = WS_A, WS_HMP = WS_A;
constexpr size_t WS_B = WS_A + 252 * MiB;
constexpr size_t WS_T = WS_B, WS_MRG = WS_B + 32 * MiB, WS_MIX = WS_B + 64 * MiB, WS_YP = WS_B;
constexpr size_t WS_XP = WS_WIN;
static_assert(WS_XP + (size_t)NEXP * XCAP * DM <= WS_MGU, "Xp must end before the MoE weight copies");
constexpr size_t WS_YT = WS_B + 144 * MiB;
constexpr size_t WS_WIN8 = WS_YT + 48 * MiB;
constexpr size_t WS_XN8 = WS_WIN8 + 32 * MiB;
constexpr size_t WS_HB = WS_XN8 + 16 * MiB;
constexpr size_t WS_END = WS_HB + 32 * MiB;
static_assert((size_t)MPAD * EFF * 2 <= 252 * MiB && (size_t)MPAD * DM * 4 <= 144 * MiB && (size_t)M * INW * 2 <= 144 * MiB, "arena sizes");
constexpr int CW_TMO = 0, CW_CODE = 1;
constexpr int CW_BAR = 4096;
constexpr int CW_CNT = 8192;
constexpr int RING_OFF = 0, RING_BYTES = 131072;
constexpr int LDSCTL_OFF = RING_BYTES, MISC_OFF = LDSCTL_OFF + 320, TAB_OFF = LDSCTL_OFF + 512;
constexpr int LDS_BYTES = 147456;

#define GAS __attribute__((address_space(1)))
#define LAS __attribute__((address_space(3)))
typedef unsigned short bf16;
typedef unsigned v4u __attribute__((ext_vector_type(4)));
typedef unsigned v2u __attribute__((ext_vector_type(2)));
typedef float f32x4 __attribute__((ext_vector_type(4)));
typedef short bf16x8 __attribute__((ext_vector_type(8)));
typedef short bf16x4 __attribute__((ext_vector_type(4)));
typedef GAS unsigned gu32;
#define RLX_AGENT __ATOMIC_RELAXED, __HIP_MEMORY_SCOPE_AGENT
#define LDS_WAIT() asm volatile("s_waitcnt lgkmcnt(0)" ::: "memory")
#define VM_WAIT() asm volatile("s_waitcnt vmcnt(0)" ::: "memory")
__device__ __forceinline__ unsigned f2bf(float f) { unsigned u = __builtin_bit_cast(unsigned, f); return (u + 0x7fffu + ((u >> 16) & 1u)) >> 16; }
__device__ __forceinline__ unsigned pk2(float lo, float hi) { return pg8::cvt_pk_bf16(lo, hi); }
__device__ __forceinline__ float bflo(unsigned w) { return __uint_as_float(w << 16); }
__device__ __forceinline__ float bfhi(unsigned w) { return __uint_as_float(w & 0xffff0000u); }
#define XB_TMO      128
#define XB_XCNT(j)  (256  + 64 * (j))
#define XB_XSUB(j)  (1280 + 64 * (j))
#define XB_XGEN(j)  (2304 + 64 * (j))
#define XB_TOP      3328
#define XB_TOPGEN   3392
#define XCD_BAR_WORDS 3456
#define XB_SPIN_CAP (1u << 18)

__device__ __forceinline__ unsigned xb_ld(unsigned* p)              { return __hip_atomic_load(p, __ATOMIC_RELAXED, __HIP_MEMORY_SCOPE_AGENT); }
__device__ __forceinline__ unsigned xb_add(unsigned* p, unsigned v) { return __hip_atomic_fetch_add(p, v, __ATOMIC_RELAXED, __HIP_MEMORY_SCOPE_AGENT); }
__device__ __forceinline__ unsigned xb_xcc_id() { return (unsigned)__builtin_amdgcn_s_getreg((3 << 11) | 20) & 0xFu; }
#define XB_SPIN(cond, bar) do { unsigned _sp = 0; while (cond) { __builtin_amdgcn_s_sleep(1); \
    if ((++_sp & 255u) == 0u) { if (xb_ld(&(bar)[XB_TMO])) break; if (_sp > XB_SPIN_CAP) { atomicAdd(&(bar)[XB_TMO], 1u); break; } } } } while (0)

struct XcdBarrier {
    unsigned* bar; unsigned x;
    volatile LAS unsigned* st;
};

__device__ __forceinline__ XcdBarrier xcd_barrier_post(unsigned* bar, volatile LAS unsigned* st) {
    XcdBarrier b; b.bar = bar; b.x = xb_xcc_id(); b.st = st;
    if (threadIdx.x == 0) (void)xb_add(&bar[XB_XCNT(b.x)], 1u);
    return b;
}
__device__ __forceinline__ void xcd_barrier_complete(unsigned* bar, unsigned x, unsigned& nloc, unsigned& nx) {
    const unsigned G = gridDim.x * gridDim.y * gridDim.z;
    unsigned sum, cnt, mine, sp = 0u;
    for (;;) {
        sum = 0u; cnt = 0u; mine = 0u;
#pragma unroll
        for (unsigned j = 0; j < 16; ++j) { const unsigned c = xb_ld(&bar[XB_XCNT(j)]); sum += c; cnt += (c > 0u) ? 1u : 0u; mine = (j == x) ? c : mine; }
        if (sum == G) break;
        __builtin_amdgcn_s_sleep(1);
        if ((++sp & 255u) == 0u) { if (xb_ld(&bar[XB_TMO])) break; if (sp > XB_SPIN_CAP) { atomicAdd(&bar[XB_TMO], 1u); break; } }
    }
    nloc = mine > 0u ? mine : 1u; nx = cnt > 0u ? cnt : 1u;
}

__device__ __forceinline__ void xcd_barrier(const XcdBarrier& b) {
    asm volatile("s_waitcnt vmcnt(0)" ::: "memory");
    __syncthreads();
    if (threadIdx.x == 0) {
        unsigned* bar = b.bar;
        __builtin_amdgcn_s_waitcnt(0);
        unsigned nloc = b.st[0], nx = b.st[1];
        if (nloc == 0u) { xcd_barrier_complete(bar, b.x, nloc, nx); b.st[0] = nloc; b.st[1] = nx; }
        const unsigned old = xb_add(&bar[XB_XSUB(b.x)], 1u);
        const unsigned gen = old / nloc;
        if (old + 1u == (gen + 1u) * nloc) {
            __builtin_amdgcn_fence(__ATOMIC_RELEASE, "agent");
            asm volatile("s_waitcnt vmcnt(0)" ::: "memory");
            const unsigned og = xb_add(&bar[XB_TOP], 1u);
            const unsigned tg = og / nx;
            if (og + 1u == (tg + 1u) * nx) xb_add(&bar[XB_TOPGEN], 1u);
            else XB_SPIN(xb_ld(&bar[XB_TOPGEN]) == tg, bar);
            __builtin_amdgcn_fence(__ATOMIC_ACQUIRE, "agent");
            xb_add(&bar[XB_XGEN(b.x)], 1u);
            asm volatile("s_waitcnt vmcnt(0)" ::: "memory");
        } else {
            XB_SPIN(xb_ld(&bar[XB_XGEN(b.x)]) == gen, bar);
            __builtin_amdgcn_fence(__ATOMIC_ACQUIRE, "agent");
            asm volatile("s_waitcnt vmcnt(0)" ::: "memory");
        }
    }
    __syncthreads();
}

__device__ __forceinline__ float wave_sum(float v) {
#pragma unroll
    for (int o = 1; o < 64; o <<= 1) v += __shfl_xor(v, o);
    return v;
}
__device__ __forceinline__ void conv64(const float* W, int ldn, int k0, int n0, bf16* dst, int ldk, int drow0, LAS float* scr, int lane) {
    { const int r = lane >> 4, j = lane & 15; f32x4 v[16];
      const GAS f32x4* src = (const GAS f32x4*)(W + (size_t)(k0 + r) * ldn + n0 + 4 * j);
#pragma unroll
      for (int i = 0; i < 16; ++i) v[i] = __builtin_nontemporal_load(src + (size_t)i * ldn);
#pragma unroll
      for (int i = 0; i < 16; ++i) { const int kk = 4 * i + r; *(LAS f32x4*)(scr + kk * 64 + ((4 * j) ^ (4 * ((kk >> 3) & 7)))) = v[i]; } }
    LDS_WAIT(); asm volatile("" ::: "memory");
    const int c = lane & 7, nn = lane >> 3;
#pragma unroll
    for (int t = 0; t < 8; ++t) { const int n = nn + 8 * t; const LAS float* sp = scr + (8 * c) * 64 + (n ^ (4 * c));
        v4u o; o.x = pk2(sp[0 * 64], sp[1 * 64]); o.y = pk2(sp[2 * 64], sp[3 * 64]); o.z = pk2(sp[4 * 64], sp[5 * 64]); o.w = pk2(sp[6 * 64], sp[7 * 64]);
        *(GAS v4u*)(dst + (size_t)(drow0 + n) * ldk + k0 + 8 * c) = o; }
    LDS_WAIT(); asm volatile("" ::: "memory");
}
constexpr float WSCALE = 64.0f;
__device__ __forceinline__ unsigned pk4_fp8(float a, float b, float c, float d) { int w = __builtin_amdgcn_cvt_pk_fp8_f32(a, b, 0, false); w = __builtin_amdgcn_cvt_pk_fp8_f32(c, d, w, true); return (unsigned)w; }
__device__ __forceinline__ void conv8(const float* W, int ldn, int k0, int n0, unsigned char* dst, int ldk, int drow0, LAS float* scr, int lane) {
    { const int r = lane >> 3, j = lane & 7; f32x4 v[16];
      const GAS f32x4* src = (const GAS f32x4*)(W + (size_t)(k0 + r) * ldn + n0 + 4 * j);
#pragma unroll
      for (int i = 0; i < 16; ++i) v[i] = __builtin_nontemporal_load(src + (size_t)i * 2 * ldn);
#pragma unroll
      for (int i = 0; i < 16; ++i) { const int kk = 8 * i + r; *(LAS f32x4*)(scr + kk * 32 + ((4 * j) ^ (4 * (i & 7)))) = v[i] * WSCALE; } }
    LDS_WAIT(); asm volatile("" ::: "memory");
    const int c = lane & 15, nn = lane >> 4;
#pragma unroll
    for (int t = 0; t < 8; ++t) { const int n = nn + 4 * t; const LAS float* sp = scr + (8 * c) * 32 + (n ^ (4 * (c & 7)));
        v2u o; o.x = pk4_fp8(sp[0 * 32], sp[1 * 32], sp[2 * 32], sp[3 * 32]); o.y = pk4_fp8(sp[4 * 32], sp[5 * 32], sp[6 * 32], sp[7 * 32]);
        *(GAS v2u*)(dst + (size_t)(drow0 + n) * ldk + k0 + 8 * c) = o; }
    LDS_WAIT(); asm volatile("" ::: "memory");
}
struct Ptrs {
    const float *x, *w_in, *relb, *w_pool, *pscale, *w_ao, *w_po, *w_out, *gains, *dwg, *dwu, *dwd, *wr, *mwg, *mwu, *mwd;
    float* out; unsigned char* ws;
};
constexpr int I_WIN = 2 * 32 * 32, I_WIN8 = 2 * 16 * 224, I_AO = 2 * 8 * 32, I_PO = I_AO, I_WOUT = 2 * 32 * 32, I_POOL = 8 * 2 * 2, I_DG = 16 * 176, I_DU = I_DG, I_DD = 88 * 32,
              I_MG = 8 * 16 * 224, I_MU = I_MG, I_MD = 8 * 56 * 64;
constexpr int N_ITEMS_A = I_WIN + I_WIN8 + I_AO + I_PO + I_WOUT + I_POOL + I_DG + I_DU + I_DD, N_ITEMS_B = I_MG + I_MU + I_MD;
#ifndef QW_ITEMS
#define QW_ITEMS 14
#endif
constexpr int QW = QW_ITEMS / 2, QWZ = QW_ITEMS / 2;
constexpr int N_DEFER = 128 * NWAVES * (QW + 2 * QWZ);
static_assert(N_DEFER <= N_ITEMS_B, "deferred conversion quota");
__device__ __forceinline__ void conv_a(const Ptrs& P, int it, LAS float* scr, int lane) {
    unsigned char* ws = P.ws; int r = it;
    if (r < I_WIN) { const int l = r / (32 * 32), q = r % (32 * 32), kb = q / 32, nb = q % 32;
        conv64(P.w_in + (size_t)l * DM * INW, INW, 64 * kb, ZV + 64 * nb, (bf16*)(ws + WS_WIN) + (size_t)l * INW * DM, DM, ZV + 64 * nb, scr, lane); return; } r -= I_WIN;
    if (r < I_WIN8) { const int l = r / (16 * 224), q = r % (16 * 224), kb = q / 224, nb = q % 224;
        const int n0 = nb < 96 ? 32 * nb : ZGA + 32 * (nb - 96);
        conv8(P.w_in + (size_t)l * DM * INW, INW, 128 * kb, n0, (unsigned char*)(ws + WS_WIN8) + (size_t)l * 7168 * DM, DM, 32 * nb, scr, lane); return; } r -= I_WIN8;
    if (r < I_AO) { const int l = r / 256, q = r % 256, kb = q / 32, nb = q % 32;
        conv64(P.w_ao + (size_t)l * 512 * DM, DM, 64 * kb, 64 * nb, (bf16*)(ws + WS_WAO) + (size_t)l * DM * 512, 512, 64 * nb, scr, lane); return; } r -= I_AO;
    if (r < I_PO) { const int l = r / 256, q = r % 256, kb = q / 32, nb = q % 32;
        conv64(P.w_po + (size_t)l * 512 * DM, DM, 64 * kb, 64 * nb, (bf16*)(ws + WS_WPO) + (size_t)l * DM * 512, 512, 64 * nb, scr, lane); return; } r -= I_PO;
    if (r < I_WOUT) { const int l = r / 1024, q = r % 1024, kb = q / 32, nb = q % 32;
        conv64(P.w_out + (size_t)l * DM * DM, DM, 64 * kb, 64 * nb, (bf16*)(ws + WS_WOUT) + (size_t)l * DM * DM, DM, 64 * nb, scr, lane); return; } r -= I_WOUT;
    if (r < I_POOL) { const int mtx = r / 4, q = r % 4, kb = q / 2, nb = q % 2;
        conv64(P.w_pool + (size_t)mtx * 128 * 128, 128, 64 * kb, 64 * nb, (bf16*)(ws + WS_WPOOL) + (size_t)mtx * 128 * 128, 128, 64 * nb, scr, lane); return; } r -= I_POOL;
    if (r < I_DG + I_DU) { const int up = r >= I_DG; const int q = up ? r - I_DG : r; const int kb = q / 176, nb = q % 176, n0 = 32 * nb;
        conv8(up ? P.dwu : P.dwg, DFF, 128 * kb, n0, (unsigned char*)(ws + WS_DGU), DM, (n0 >> 7) * 256 + (n0 & 127) + (up ? 128 : 0), scr, lane); return; } r -= I_DG + I_DU;
    { const int kb = r / 32, nb = r % 32;
        conv64(P.dwd, DM, 64 * kb, 64 * nb, (bf16*)(ws + WS_DD), DFF, 64 * nb, scr, lane); }
}
__device__ __forceinline__ void conv_b(const Ptrs& P, int it, LAS float* scr, int lane) {
    unsigned char* ws = P.ws; int r = it;
    if (r < I_MG + I_MU) { const int up = r >= I_MG; const int q0 = up ? r - I_MG : r; const int e = q0 / (16 * 224), q = q0 % (16 * 224), kb = q / 224, nb = q % 224, n0 = 32 * nb;
        conv8((up ? P.mwu : P.mwg) + (size_t)e * DM * EFF, EFF, 128 * kb, n0, (unsigned char*)(ws + WS_MGU) + (size_t)e * 2 * EFF * DM, DM, (n0 >> 7) * 256 + (n0 & 127) + (up ? 128 : 0), scr, lane); return; } r -= I_MG + I_MU;
    { const int e = r / (56 * 64), q = r % (56 * 64), kb = q / 64, nb = q % 64;
        conv8(P.mwd + (size_t)e * EFF * DM, DM, 128 * kb, 32 * nb, (unsigned char*)(ws + WS_MD) + (size_t)e * DM * EFF, EFF, 32 * nb, scr, lane); }
}
__device__ __forceinline__ void p0_convert(const Ptrs& P, LAS unsigned char* lds, int gw, int NGW, int wave, int lane) {
    LAS float* scr = (LAS float*)(lds + RING_OFF + wave * 16384);
#pragma unroll 1
    for (int j = gw; j < I_WIN / 2 + I_WIN8 / 2; j += NGW) conv_a(P, j < I_WIN / 2 ? j : I_WIN + (j - I_WIN / 2), scr, lane);
}
__device__ __forceinline__ void conv_share_down(const Ptrs& P, LAS unsigned char* lds, int gw, int NGW, int wave, int lane) {
    LAS float* scr = (LAS float*)(lds + RING_OFF + wave * 16384);
    constexpr int PER = I_MD / 256; static_assert(I_MD % 256 == 0 && PER % NWAVES == 0, "conv_share_down: whole steps of eight items per workgroup");
    const int first = I_MG + I_MU + (gw / NWAVES) * PER + wave;
#pragma unroll 1
    for (int j = 0; j < PER; j += NWAVES) conv_b(P, first + j, scr, lane);
}
__device__ __forceinline__ void conv_share_a(const Ptrs& P, LAS unsigned char* lds, int gw, int NGW, int wave, int lane) {
    LAS float* scr = (LAS float*)(lds + RING_OFF + wave * 16384);
    constexpr int NA1 = N_ITEMS_A - I_WIN / 2 - I_WIN8 / 2;
#pragma unroll 1
    for (int j = gw; j < NA1; j += NGW) conv_a(P, j < I_WIN / 2 ? I_WIN / 2 + j : I_WIN + I_WIN8 / 2 + (j - I_WIN / 2), scr, lane);
}
__device__ __forceinline__ void conv_share_gu(const Ptrs& P, LAS unsigned char* lds, int gw, int NGW, int wave, int lane) {
    LAS float* scr = (LAS float*)(lds + RING_OFF + wave * 16384);
    constexpr int PER = (I_MG + I_MU - N_DEFER) / 256; static_assert((I_MG + I_MU - N_DEFER) % 256 == 0, "conv_share_gu: equal runs");
    const int first = N_DEFER + (gw / NWAVES) * PER;
#pragma unroll 1
    for (int j = wave; j < PER; j += NWAVES) conv_b(P, first + j, scr, lane);
}
__device__ __forceinline__ void conv_quota(const Ptrs& P, LAS unsigned char* lds, int site, int bx, int wave, int lane) {
    LAS float* scr = (LAS float*)(lds + RING_OFF + wave * 16384);
    const int w = (bx - 128) * NWAVES + wave, nq = site == 1 ? QW : QWZ, base = 128 * NWAVES * (site == 0 ? 0 : (site == 1 ? QWZ : QWZ + QW));
#pragma unroll 1
    for (int q = 0; q < nq; ++q) conv_b(P, base + q * (128 * NWAVES) + w, scr, lane);
}
__device__ __forceinline__ void ld_row(const float* p, int lane, f32x4 (&v)[8]) { const GAS f32x4* r = (const GAS f32x4*)p + lane;
#pragma unroll
    for (int j = 0; j < 8; ++j) v[j] = r[64 * j]; }
__device__ __forceinline__ void ld_row_bfraw(const bf16* p, int lane, v2u (&w)[8]) { const GAS v2u* r = (const GAS v2u*)p + lane;
#pragma unroll
    for (int j = 0; j < 8; ++j) w[j] = r[64 * j]; }
__device__ __forceinline__ void unpack_bf(const v2u (&w)[8], f32x4 (&v)[8]) {
#pragma unroll
    for (int j = 0; j < 8; ++j) v[j] = (f32x4){bflo(w[j].x), bfhi(w[j].x), bflo(w[j].y), bfhi(w[j].y)}; }
__device__ __forceinline__ void ld_row_bf(const bf16* p, int lane, f32x4 (&v)[8]) { v2u w[8]; ld_row_bfraw(p, lane, w); __builtin_amdgcn_sched_barrier(0); unpack_bf(w, v); }
__device__ __forceinline__ float sumsq(const f32x4 (&v)[8]) { float s = 0.f;
#pragma unroll
    for (int j = 0; j < 8; ++j) s += (v[j].x * v[j].x + v[j].y * v[j].y) + (v[j].z * v[j].z + v[j].w * v[j].w);
    return wave_sum(s); }
__device__ __forceinline__ void st_row_bf16(bf16* p, int lane, const f32x4 (&v)[8]) { GAS v2u* o = (GAS v2u*)p + lane;
#pragma unroll
    for (int j = 0; j < 8; ++j) { v2u w; w.x = pk2(v[j].x, v[j].y); w.y = pk2(v[j].z, v[j].w); o[64 * j] = w; } }
__device__ __forceinline__ void st_row_fp8(unsigned char* p, int lane, const f32x4 (&v)[8]) { GAS unsigned* o = (GAS unsigned*)p + lane;
#pragma unroll
    for (int j = 0; j < 8; ++j) o[64 * j] = pk4_fp8(v[j].x, v[j].y, v[j].z, v[j].w); }
__device__ __forceinline__ void norm_first(const float* x, const float* g, bf16* XN, unsigned char* XN8, int gw, int NGW, int lane) {
    f32x4 gv[8]; ld_row(g, lane, gv);
#pragma unroll 1
    for (int m = gw; m < M; m += NGW) { f32x4 v[8]; ld_row(x + (size_t)m * DM, lane, v);
        const float r = 1.0f / sqrtf(sumsq(v) * (1.0f / DM) + RMS_EPS);
#pragma unroll
        for (int j = 0; j < 8; ++j) v[j] = v[j] * r * gv[j];
        st_row_bf16(XN + (size_t)m * DM, lane, v); st_row_fp8(XN8 + (size_t)m * DM, lane, v); }
}
template <bool ROUTER, bool RES_BF>
__device__ __forceinline__ void norm_mid(const bf16* src, const void* res, bf16* hout, const float* gpost, const float* gpre, bf16* XN, unsigned char* XN8,
                                         const LAS float* wrl, gu32* ctl, int* toke, int* tokp, float* tokw, unsigned char* Xp, int gw, int NGW, int lane) {
    f32x4 v[8], h[8], hn[8]; v2u vr[8], hr[8];
    unsigned pend[8]; int pe1 = 0, pe2 = 0; unsigned pp1 = 0u, pp2 = 0u; bool have = false;
    if (gw < M) { ld_row_bfraw(src + (size_t)gw * DM, lane, vr);
        if constexpr (RES_BF) ld_row_bfraw((const bf16*)res + (size_t)gw * DM, lane, hr); else ld_row((const float*)res + (size_t)gw * DM, lane, hn); }
#pragma unroll 1
    for (int m = gw; m < M; m += NGW) {
        const int mn = m + NGW;
        unpack_bf(vr, v);
        if constexpr (RES_BF) unpack_bf(hr, h); else {
#pragma unroll
            for (int j = 0; j < 8; ++j) h[j] = hn[j]; }
        __builtin_amdgcn_sched_barrier(0);
        if (mn < M) { ld_row_bfraw(src + (size_t)mn * DM, lane, vr);
            if constexpr (RES_BF) ld_row_bfraw((const bf16*)res + (size_t)mn * DM, lane, hr); else ld_row((const float*)res + (size_t)mn * DM, lane, hn); }
        __builtin_amdgcn_sched_barrier(0);
        f32x4 gv[8]; ld_row(gpost, lane, gv);
        const float r = 1.0f / sqrtf(sumsq(v) * (1.0f / DM) + RMS_EPS);
#pragma unroll
        for (int j = 0; j < 8; ++j) h[j] = h[j] + v[j] * r * gv[j];
        st_row_bf16(hout + (size_t)m * DM, lane, h);
        const float r2 = 1.0f / sqrtf(sumsq(h) * (1.0f / DM) + RMS_EPS);
        ld_row(gpre, lane, gv);
#pragma unroll
        for (int j = 0; j < 8; ++j) h[j] = h[j] * r2 * gv[j];
        if (!ROUTER && XN) st_row_bf16(XN + (size_t)m * DM, lane, h);
        if (XN8) st_row_fp8(XN8 + (size_t)m * DM, lane, h);
        if (ROUTER) {
            int e1 = 0, e2 = 0; float v1 = -3.0e38f, v2 = -3.0e38f;
#pragma unroll 1
            for (int e = 0; e < NEXP; ++e) { float s = 0.f; const LAS f32x4* wp = (const LAS f32x4*)(wrl + e * DM) + lane;
#pragma unroll
                for (int j = 0; j < 8; ++j) { const f32x4 w = wp[64 * j]; s += (h[j].x * w.x + h[j].y * w.y) + (h[j].z * w.z + h[j].w * w.w); }
                s = wave_sum(s);
                if (s > v1) { v2 = v1; e2 = e1; v1 = s; e1 = e; } else if (s > v2) { v2 = s; e2 = e; } }
            if (have) {
                const unsigned q1 = __builtin_amdgcn_readfirstlane(pp1), q2 = __builtin_amdgcn_readfirstlane(pp2);
                GAS unsigned* o1 = (GAS unsigned*)(Xp + ((size_t)pe1 * XCAP + q1) * DM) + lane; GAS unsigned* o2 = (GAS unsigned*)(Xp + ((size_t)pe2 * XCAP + q2) * DM) + lane;
#pragma unroll
                for (int j = 0; j < 8; ++j) { o1[64 * j] = pend[j]; o2[64 * j] = pend[j]; } }
#pragma unroll
            for (int j = 0; j < 8; ++j) pend[j] = pk4_fp8(h[j].x, h[j].y, h[j].z, h[j].w);
            pe1 = e1; pe2 = e2; have = true;
            if (lane == 0) {
                const float w1 = 1.0f / (1.0f + __expf(v2 - v1)), w2 = 1.0f - w1;
                pp1 = __hip_atomic_fetch_add(ctl + CW_CNT + 64 * e1, 1u, RLX_AGENT);
                pp2 = __hip_atomic_fetch_add(ctl + CW_CNT + 64 * e2, 1u, RLX_AGENT);
                toke[2 * m] = e1; toke[2 * m + 1] = e2; tokp[2 * m] = (int)pp1; tokp[2 * m + 1] = (int)pp2; tokw[2 * m] = w1; tokw[2 * m + 1] = w2;
            }
        }
    }
    if (ROUTER && have) {
        const unsigned q1 = __builtin_amdgcn_readfirstlane(pp1), q2 = __builtin_amdgcn_readfirstlane(pp2);
        GAS unsigned* o1 = (GAS unsigned*)(Xp + ((size_t)pe1 * XCAP + q1) * DM) + lane; GAS unsigned* o2 = (GAS unsigned*)(Xp + ((size_t)pe2 * XCAP + q2) * DM) + lane;
#pragma unroll
        for (int j = 0; j < 8; ++j) { o1[64 * j] = pend[j]; o2[64 * j] = pend[j]; } }
}
__device__ __forceinline__ void moe_tables(gu32* ctl, LAS int* tab, int tid) {
    if (tid < NEXP) { int c = (int)__hip_atomic_load(ctl + CW_CNT + 64 * tid, RLX_AGENT); if (c > XCAP) c = XCAP; tab[88 + tid] = c; }
    __syncthreads();
    if (tid == 0) { int off = 0, p = 0;
        for (int e = 0; e < NEXP; ++e) { const int c = tab[88 + e], np = (c + 255) >> 8;
            tab[80 + e] = off; for (int i = 0; i < np && p < 80; ++i) tab[p++] = e; off += np * 256; }
        tab[96] = p; }
    __syncthreads();
}
__device__ __forceinline__ void add_ytail(const bf16* Yt, int r, int rt0, int lane, f32x4 (&a)[8]) {
    if (r >= rt0) {
#pragma unroll 1
        for (int k = 0; k < 3; ++k) { f32x4 t[8]; ld_row_bf(Yt + ((size_t)k * 2048 + (r - rt0)) * DM, lane, t);
#pragma unroll
            for (int j = 0; j < 8; ++j) a[j] = a[j] + t[j]; } }
}
__device__ __forceinline__ void norm_final(const bf16* Yp, const bf16* Yt, const float* g, const bf16* hb, float* out, const int* toke, const int* tokp, const float* tokw, const LAS int* tab, int gw, int NGW, int lane) {
    const int rt0 = (tab[96] & ~31) * 256;
    v2u ar[8], br[8]; int r1 = 0, r2 = 0, r1n = 0, r2n = 0; float w1 = 0.f, w2 = 0.f, w1n = 0.f, w2n = 0.f;
    if (gw < M) { const int m = gw; r1 = tab[80 + toke[2 * m]] + tokp[2 * m]; r2 = tab[80 + toke[2 * m + 1]] + tokp[2 * m + 1]; w1 = tokw[2 * m]; w2 = tokw[2 * m + 1];
        ld_row_bfraw(Yp + (size_t)r1 * DM, lane, ar); ld_row_bfraw(Yp + (size_t)r2 * DM, lane, br); }
#pragma unroll 1
    for (int m = gw; m < M; m += NGW) {
        const int mn = m + NGW;
        f32x4 a[8], b[8]; unpack_bf(ar, a); unpack_bf(br, b);
        __builtin_amdgcn_sched_barrier(0);
        if (mn < M) { r1n = tab[80 + toke[2 * mn]] + tokp[2 * mn]; r2n = tab[80 + toke[2 * mn + 1]] + tokp[2 * mn + 1]; w1n = tokw[2 * mn]; w2n = tokw[2 * mn + 1];
            ld_row_bfraw(Yp + (size_t)r1n * DM, lane, ar); ld_row_bfraw(Yp + (size_t)r2n * DM, lane, br); }
        __builtin_amdgcn_sched_barrier(0);
        add_ytail(Yt, r1, rt0, lane, a); add_ytail(Yt, r2, rt0, lane, b);
#pragma unroll
        for (int j = 0; j < 8; ++j) a[j] = a[j] * w1 + b[j] * w2;
        ld_row_bf(hb + (size_t)m * DM, lane, b);
        const float r = 1.0f / sqrtf(sumsq(a) * (1.0f / DM) + RMS_EPS);
        GAS f32x4* o = (GAS f32x4*)(out + (size_t)m * DM) + lane; const GAS f32x4* gp = (const GAS f32x4*)g + lane;
#pragma unroll
        for (int j = 0; j < 8; ++j) o[64 * j] = b[j] + a[j] * r * gp[64 * j];
        r1 = r1n; r2 = r2n; w1 = w1n; w2 = w2n;
    }
}
__device__ __forceinline__ int t5_bucket(int d) {
    if (d < 16) return d;
    return 16 + (d >= 22) + (d >= 30) + (d >= 40) + (d >= 54) + (d >= 73) + (d >= 99) + (d >= 134) + (d >= 182) + (d >= 246) + (d >= 332) + (d >= 450) + (d >= 609) + (d >= 825) + (d >= 1117) + (d >= 1513);
}
struct AttnU { int b, g, d, r, n, hh, head; };
__device__ __forceinline__ AttnU attn_decode(int ui) { AttnU u; u.hh = ui & 3; const int u2 = ui >> 2; u.b = u2 / 96; const int s = u2 % 96;
    if (s < 32) { u.g = 0; u.d = 1; u.r = 0; u.n = s; } else if (s < 64) { u.g = 1; u.d = 4; u.r = (s - 32) >> 3; u.n = (s - 32) & 7; } else { u.g = 2; u.d = 16; u.r = (s - 64) >> 1; u.n = (s - 64) & 1; }
    u.head = u.g * 4 + u.hh; return u; }
__device__ __forceinline__ void att_dma16(const void* g, LAS unsigned char* piece) {
    unsigned sv; const unsigned base = (unsigned)(size_t)piece;
    asm volatile("s_mov_b32 %0, m0\n\ts_mov_b32 m0, %2\n\ts_nop 0\n\tglobal_load_lds_dwordx4 %1, off\n\ts_mov_b32 m0, %0" : "=&s"(sv) : "v"(g), "s"(__builtin_amdgcn_readfirstlane(base)) : "memory");
}
__device__ __forceinline__ int v_swz(int row) { return ((row & 3) << 2) | ((row >> 2) & 3); }
__device__ __forceinline__ void attn_dma_v(const bf16* Z, const AttnU& u, LAS unsigned char* buf, int wave, int lane) {
#pragma unroll
    for (int i = 0; i < 8; ++i) { const int piece = wave * 8 + i, p = 4 * piece + (lane >> 4), j = 128 * (u.n - 1) + p;
        const bf16* src = Z + (size_t)(u.b * SEQ + u.r + u.d * (j < 0 ? 0 : j)) * INW + ZV + u.head * 128 + 8 * ((lane & 15) ^ v_swz(p));
        att_dma16(src, buf + piece * 1024); }
}
constexpr int ATT_BT_OFF = LDSCTL_OFF + 1024;
__device__ __forceinline__ void attn_dma_k(const bf16* Z, const AttnU& u, LAS unsigned char* buf, int wave, int lane) {
#pragma unroll
    for (int i = 0; i < 8; ++i) { const int piece = wave * 8 + i, p = 4 * piece + (lane >> 4), j = 128 * (u.n - 1) + p;
        const bf16* src = Z + (size_t)(u.b * SEQ + u.r + u.d * (j < 0 ? 0 : j)) * INW + ZK + u.head * 128 + 8 * ((lane & 15) ^ (p & 15));
        att_dma16(src, buf + piece * 1024); }
}
__device__ __forceinline__ void attn_ld_q(const bf16* Z, const AttnU& u, int wave, int qi, int qd, bf16x8 (&qf)[4]) {
    const int jq = 128 * u.n + 16 * wave + qi; const size_t rowq = (size_t)(u.b * SEQ + u.r + u.d * jq);
#pragma unroll
    for (int s4 = 0; s4 < 4; ++s4) qf[s4] = *(const GAS bf16x8*)(Z + rowq * INW + ZQ + u.head * 128 + 32 * s4 + 8 * qd);
}
#define ATT_BAR() do { asm volatile("s_waitcnt lgkmcnt(0)" ::: "memory"); __builtin_amdgcn_s_barrier(); asm volatile("" ::: "memory"); } while (0)
__device__ __forceinline__ void attn_phase(const bf16* Z, const float* relb, bf16* OG, float* LSE, LAS unsigned char* lds, int G, int tid, int wave, int lane) {
    const int qi = lane & 15, qd = lane >> 4;
    constexpr float C2 = 0.08838834764831845f * 1.4426950408889634f;
    const int trq = (lane & 15) >> 2, trp = lane & 3, trrow = 4 * qd + trq, trswz = (trq << 2) | qd;
    LAS unsigned char* kbuf = lds + RING_OFF; LAS unsigned char* vbuf = lds + RING_OFF + 65536;
    const int tb = tid < 128 ? tid : 128;
    int it = 0;
    int bxl = blockIdx.x; asm volatile("" : "+s"(bxl));
    bf16x8 qf[4];
    if (bxl < 768) { const AttnU u0 = attn_decode(bxl);
        const float bv = relb[t5_bucket(tb * u0.d) * 12 + u0.head]; attn_ld_q(Z, u0, wave, qi, qd, qf);
        __builtin_amdgcn_sched_barrier(0);
        attn_dma_k(Z, u0, kbuf, wave, lane); attn_dma_v(Z, u0, vbuf, wave, lane);
        __builtin_amdgcn_sched_barrier(0);
        if (tid < 129) ((LAS float*)(lds + ATT_BT_OFF))[tid] = bv * 1.4426950408889634f; }
#pragma unroll 1
    for (int ui = bxl; ui < 768; ui += G, ++it) {
        const AttnU U = attn_decode(ui); const int b = U.b, g = U.g, d = U.d, r = U.r, n = U.n, hh = U.hh, head = U.head;
        const bool has_next = ui + G < 768;
        LAS float* btab = (LAS float*)(lds + ATT_BT_OFF) + (it & 1) * 132; LAS float* btabn = (LAS float*)(lds + ATT_BT_OFF) + ((it + 1) & 1) * 132;
        const int jq = 128 * n + 16 * wave + qi; const size_t rowq = (size_t)(b * SEQ + r + d * jq);
        __builtin_amdgcn_sched_barrier(0);
        asm volatile("s_waitcnt vmcnt(8)" ::: "memory");
        ATT_BAR();
        __builtin_amdgcn_sched_barrier(0);
        f32x4 sa[9];
        const LAS unsigned char* krow = kbuf + (16 * wave + qi) * 256;
        bf16x8 kfA[3][4], kfB[3][4];
#define ATT_LDK(dst, t0) do { _Pragma("unroll") for (int tt = 0; tt < 3; ++tt) _Pragma("unroll") for (int s4 = 0; s4 < 4; ++s4) dst[tt][s4] = *(const LAS bf16x8*)(krow + ((t0) + tt) * 4096 + 16 * ((4 * s4 + qd) ^ qi)); } while (0)
#define ATT_QK(src, t0) do { _Pragma("unroll") for (int tt = 0; tt < 3; ++tt) { f32x4 a_ = (f32x4){0.f, 0.f, 0.f, 0.f}; \
            _Pragma("unroll") for (int s4 = 0; s4 < 4; ++s4) a_ = __builtin_amdgcn_mfma_f32_16x16x32_bf16(src[tt][s4], qf[s4], a_, 0, 0, 0); sa[(t0) + tt] = a_; } } while (0)
        ATT_LDK(kfA, 0); ATT_LDK(kfB, 3); __builtin_amdgcn_sched_barrier(0);
        ATT_QK(kfA, 0); __builtin_amdgcn_sched_barrier(0);
        ATT_LDK(kfA, 6); __builtin_amdgcn_sched_barrier(0);
        ATT_QK(kfB, 3); __builtin_amdgcn_sched_barrier(0);
        ATT_QK(kfA, 6);
#undef ATT_LDK
#undef ATT_QK
        __builtin_amdgcn_sched_barrier(0);
        ATT_BAR();
        __builtin_amdgcn_sched_barrier(0);
        float bvn = 0.f;
        if (has_next) { const AttnU un = attn_decode(ui + G);
            bvn = relb[t5_bucket(tb * un.d) * 12 + un.head]; __builtin_amdgcn_sched_barrier(0);
            attn_ld_q(Z, un, wave, qi, qd, qf); __builtin_amdgcn_sched_barrier(0);
            attn_dma_k(Z, un, kbuf, wave, lane); }
        __builtin_amdgcn_sched_barrier(0);
        float bs[9][4];
#pragma unroll
        for (int t = 0; t < 9; ++t)
#pragma unroll
            for (int rr = 0; rr < 4; ++rr) { const int e = qi - 4 * qd - rr;
                bs[t][rr] = btab[t == 0 ? (e > 0 ? 128 : 128 + e) : (t == 8 ? (e < 0 ? 0 : e) : 128 - 16 * t + e)]; }
        __builtin_amdgcn_sched_barrier(0);
        float mx = -__builtin_inff();
#pragma unroll
        for (int t = 0; t < 9; ++t)
#pragma unroll
            for (int rr = 0; rr < 4; ++rr) { const int e = qi - 4 * qd - rr;
                const bool valid = (t == 0 ? e <= 0 : (t == 8 ? e >= 0 : true)) && (n > 0 || wave + t >= 8);
                const float sc = valid ? sa[t][rr] * C2 + bs[t][rr] : -__builtin_inff();
                sa[t][rr] = sc; mx = fmaxf(mx, sc); }
        mx = fmaxf(mx, __shfl_xor(mx, 16)); mx = fmaxf(mx, __shfl_xor(mx, 32));
        float sum = 0.f;
#pragma unroll
        for (int t = 0; t < 9; ++t)
#pragma unroll
            for (int rr = 0; rr < 4; ++rr) { const float p = __builtin_amdgcn_exp2f(sa[t][rr] - mx); sa[t][rr] = p; sum += p; }
        sum += __shfl_xor(sum, 16); sum += __shfl_xor(sum, 32);
        __builtin_amdgcn_sched_barrier(0);
        if (has_next) asm volatile("s_waitcnt vmcnt(13)" ::: "memory");
        else asm volatile("s_waitcnt vmcnt(0)" ::: "memory");
        ATT_BAR();
        __builtin_amdgcn_sched_barrier(0);
        f32x4 o[8];
#pragma unroll
        for (int dt = 0; dt < 8; ++dt) o[dt] = (f32x4){0.f, 0.f, 0.f, 0.f};
        const LAS unsigned char* vrow = vbuf + (16 * wave + trrow) * 256 + 8 * (trp & 1);
#pragma unroll
        for (int t = 0; t < 9; ++t) { v2u pw; pw.x = pk2(sa[t][0], sa[t][1]); pw.y = pk2(sa[t][2], sa[t][3]); const bf16x4 pf = __builtin_bit_cast(bf16x4, pw);
            bf16x4 vf[8];
#pragma unroll
            for (int dt = 0; dt < 8; ++dt) vf[dt] = __builtin_amdgcn_ds_read_tr16_b64_v4i16((LAS bf16x4*)(vrow + t * 4096 + 16 * ((2 * dt + (trp >> 1)) ^ trswz)));
            __builtin_amdgcn_sched_barrier(0);
#pragma unroll
            for (int dt = 0; dt < 8; ++dt) o[dt] = __builtin_amdgcn_mfma_f32_16x16x16bf16_1k(vf[dt], pf, o[dt], 0, 0, 0); }
        __builtin_amdgcn_sched_barrier(0);
        ATT_BAR();
        __builtin_amdgcn_sched_barrier(0);
        asm volatile("" : "+v"(bvn));
        if (has_next && tid < 129) btabn[tid] = bvn * 1.4426950408889634f;
        __builtin_amdgcn_sched_barrier(0);
        const float inv = 1.0f / sum;
        bf16* op = OG + ((size_t)g * M + rowq) * 512 + hh * 128 + 4 * qd;
#pragma unroll
        for (int dt = 0; dt < 8; ++dt) { v2u w; w.x = pk2(o[dt][0] * inv, o[dt][1] * inv); w.y = pk2(o[dt][2] * inv, o[dt][3] * inv); *(GAS v2u*)(op + 16 * dt) = w; }
        if (qd == 0) LSE[((size_t)g * M + rowq) * 4 + hh] = (mx + __builtin_amdgcn_logf(sum)) * 0.6931471805599453f;
        __builtin_amdgcn_sched_barrier(0);
        if (has_next) { const AttnU un = attn_decode(ui + G); attn_dma_v(Z, un, vbuf, wave, lane); }
        __builtin_amdgcn_sched_barrier(0);
    }
    asm volatile("s_waitcnt vmcnt(0)" ::: "memory"); __syncthreads();
}
template <int K> __device__ __forceinline__ float row_shr(float x) { return __int_as_float(__builtin_amdgcn_update_dpp(0, __float_as_int(x), 0x110 + K, 0xF, 0xF, true)); }
template <int K> __device__ __forceinline__ float row_shl(float x) { return __int_as_float(__builtin_amdgcn_update_dpp(0, __float_as_int(x), 0x100 + K, 0xF, 0xF, true)); }
template <int SZ>
__device__ __forceinline__ void pool_window(const bf16* Z, int g, int tile, int lane, bf16x8 (&yf)[4]) {
    static_assert(SZ == 2 || SZ == 4 || SZ == 8 || SZ == 16, "window");
    const int qi = lane & 15, qd = lane >> 4, row = tile * 16 + qi, tseq = row & (SEQ - 1); const int cnt = (tseq + 1 < SZ) ? tseq + 1 : SZ;
    const float rc = 1.0f / (float)cnt; const bool hasprev = ((tile * 16) & (SEQ - 1)) != 0;
    v4u cw[4], pw[4];
#pragma unroll
    for (int s4 = 0; s4 < 4; ++s4) { const bf16* zp = Z + (size_t)row * INW + ZP + 128 * g + 32 * s4 + 8 * qd;
        cw[s4] = *(const GAS v4u*)zp; pw[s4] = *(const GAS v4u*)(zp - (hasprev ? (size_t)16 * INW : (size_t)0)); }
    __builtin_amdgcn_sched_barrier(0);
#pragma unroll
    for (int s4 = 0; s4 < 4; ++s4) {
        const float c[8] = {bflo(cw[s4].x), bfhi(cw[s4].x), bflo(cw[s4].y), bfhi(cw[s4].y), bflo(cw[s4].z), bfhi(cw[s4].z), bflo(cw[s4].w), bfhi(cw[s4].w)};
        const float p[8] = {bflo(pw[s4].x), bfhi(pw[s4].x), bflo(pw[s4].y), bfhi(pw[s4].y), bflo(pw[s4].z), bfhi(pw[s4].z), bflo(pw[s4].w), bfhi(pw[s4].w)};
        float y[8];
#pragma unroll
        for (int e = 0; e < 8; ++e) {
            float Pc = c[e]; Pc += row_shr<1>(Pc); Pc += row_shr<2>(Pc); Pc += row_shr<4>(Pc); Pc += row_shr<8>(Pc);
            float Sp = hasprev ? p[e] : 0.f; Sp += row_shl<1>(Sp); Sp += row_shl<2>(Sp); Sp += row_shl<4>(Sp); Sp += row_shl<8>(Sp);
            float w = Pc + row_shl<17 - SZ>(Sp);
            if (SZ < 16) w -= row_shr<(SZ < 16 ? SZ : 1)>(Pc);
            y[e] = w * rc - c[e]; }
        v4u yw; yw.x = pk2(y[0], y[1]); yw.y = pk2(y[2], y[3]); yw.z = pk2(y[4], y[5]); yw.w = pk2(y[6], y[7]);
        yf[s4] = __builtin_bit_cast(bf16x8, yw); }
}
__device__ __forceinline__ void pool_mma(const bf16* WPt, const float* pscale, bf16* OP, int g, int tile, int lane, const bf16x8 (&yf)[4]) {
    const int qi = lane & 15, qd = lane >> 4, row = tile * 16 + qi;
#pragma unroll
    for (int h = 0; h < 2; ++h) {
        bf16x8 wf[4][4]; f32x4 ps[4];
#pragma unroll
        for (int k = 0; k < 4; ++k) { const int nt = 4 * h + k; const bf16* wp = WPt + ((size_t)g * 128 + 16 * nt + qi) * 128 + 8 * qd;
#pragma unroll
            for (int s4 = 0; s4 < 4; ++s4) wf[k][s4] = *(const GAS bf16x8*)(wp + 32 * s4);
            ps[k] = *(const GAS f32x4*)(pscale + 128 * g + 16 * nt + 4 * qd); }
        __builtin_amdgcn_sched_barrier(0);
#pragma unroll
        for (int k = 0; k < 4; ++k) { const int nt = 4 * h + k; f32x4 acc = (f32x4){0.f, 0.f, 0.f, 0.f};
#pragma unroll
            for (int s4 = 0; s4 < 4; ++s4) acc = __builtin_amdgcn_mfma_f32_16x16x32_bf16(wf[k][s4], yf[s4], acc, 0, 0, 0);
            v2u w; w.x = pk2(acc[0] * ps[k][0], acc[1] * ps[k][1]); w.y = pk2(acc[2] * ps[k][2], acc[3] * ps[k][3]);
            *(GAS v2u*)(OP + (size_t)row * 512 + 128 * g + 16 * nt + 4 * qd) = w; }
        __builtin_amdgcn_sched_barrier(0);
    }
}
__device__ __forceinline__ void combine_pool_phase(const bf16* Z, const bf16* OG, const float* LSE, const bf16* WPt, const float* pscale, bf16* OA, bf16* OP, int gw, int NGW, int lane) {
#pragma unroll 1
    for (int task = gw; task < (M / 16) * 4; task += NGW) { const int g = 3 - (task & 3), tile = task >> 2;
        bf16x8 yf[4];
        if (g == 3) pool_window<16>(Z, 3, tile, lane, yf); else if (g == 2) pool_window<8>(Z, 2, tile, lane, yf);
        else if (g == 1) pool_window<4>(Z, 1, tile, lane, yf); else pool_window<2>(Z, 0, tile, lane, yf);
        pool_mma(WPt, pscale, OP, g, tile, lane, yf); }
    const int hh = lane >> 4;
#pragma unroll 1
    for (int m0 = gw; m0 < M; m0 += 4 * NGW) {
        v4u a[4], b[4], c[4]; float l0[4], l1[4], l2[4];
#pragma unroll
        for (int k = 0; k < 4; ++k) { const int m = m0 + k * NGW; if (m < M) {
            l0[k] = LSE[(size_t)m * 4 + hh]; l1[k] = LSE[((size_t)M + m) * 4 + hh]; l2[k] = LSE[((size_t)2 * M + m) * 4 + hh];
            a[k] = *(const GAS v4u*)(OG + (size_t)m * 512 + lane * 8); b[k] = *(const GAS v4u*)(OG + ((size_t)M + m) * 512 + lane * 8); c[k] = *(const GAS v4u*)(OG + ((size_t)2 * M + m) * 512 + lane * 8); } }
#pragma unroll
        for (int k = 0; k < 4; ++k) { const int m = m0 + k * NGW; if (m < M) {
            const float mx = fmaxf(l0[k], fmaxf(l1[k], l2[k])); const float e0 = __expf(l0[k] - mx), e1 = __expf(l1[k] - mx), e2 = __expf(l2[k] - mx); const float inv = 1.0f / (e0 + e1 + e2);
            const float w0 = e0 * inv, w1 = e1 * inv, w2 = e2 * inv; const v4u A = a[k], B = b[k], C = c[k];
            v4u o;
            o.x = pk2(w0 * bflo(A.x) + w1 * bflo(B.x) + w2 * bflo(C.x), w0 * bfhi(A.x) + w1 * bfhi(B.x) + w2 * bfhi(C.x));
            o.y = pk2(w0 * bflo(A.y) + w1 * bflo(B.y) + w2 * bflo(C.y), w0 * bfhi(A.y) + w1 * bfhi(B.y) + w2 * bfhi(C.y));
            o.z = pk2(w0 * bflo(A.z) + w1 * bflo(B.z) + w2 * bflo(C.z), w0 * bfhi(A.z) + w1 * bfhi(B.z) + w2 * bfhi(C.z));
            o.w = pk2(w0 * bflo(A.w) + w1 * bflo(B.w) + w2 * bflo(C.w), w0 * bfhi(A.w) + w1 * bfhi(B.w) + w2 * bfhi(C.w));
            *(GAS v4u*)(OA + (size_t)m * 512 + lane * 8) = o; } }
    }
}
struct Args { const float* in[16]; float* out; unsigned char* ws; int ph_lo, ph_hi; };
__global__ void __launch_bounds__(NWAVES * 64, 2) mk_fwd(Args args) {
    extern __shared__ __attribute__((aligned(16))) unsigned char lds_raw[];
    LAS unsigned char* lds = (LAS unsigned char*)lds_raw;
    volatile LAS unsigned* MISC = (volatile LAS unsigned*)(lds + MISC_OFF);
    LAS int* tab = (LAS int*)(lds + TAB_OFF);
    const int tid = threadIdx.x, lane = tid & 63, wave = __builtin_amdgcn_readfirstlane(tid >> 6);
    const int G = gridDim.x; const int bx = blockIdx.x; const int vcu = (G % 8 == 0) ? (bx % 8) * (G / 8) + bx / 8 : bx;
    const int gw = vcu * NWAVES + wave, NGW = G * NWAVES;
    Ptrs P;
    P.x = args.in[0]; P.w_in = args.in[1]; P.relb = args.in[2]; P.w_pool = args.in[3]; P.pscale = args.in[4]; P.w_ao = args.in[5]; P.w_po = args.in[6]; P.w_out = args.in[7];
    P.gains = args.in[8]; P.dwg = args.in[9]; P.dwu = args.in[10]; P.dwd = args.in[11]; P.wr = args.in[12]; P.mwg = args.in[13]; P.mwu = args.in[14]; P.mwd = args.in[15];
    P.out = args.out; P.ws = args.ws;
    unsigned char* ws = args.ws;
    gu32* ctl = (gu32*)(ws + WS_CTL);
    bf16* XN = (bf16*)(ws + WS_XN); bf16* Z = (bf16*)(ws + WS_Z); bf16* OG = (bf16*)(ws + WS_OG); bf16* OA = (bf16*)(ws + WS_OA); bf16* OP = (bf16*)(ws + WS_OP);
    bf16* TB = (bf16*)(ws + WS_T); bf16* MRG = (bf16*)(ws + WS_MRG); bf16* MIXb = (bf16*)(ws + WS_MIX); float* LSE = (float*)(ws + WS_LSE);
    bf16* HB = (bf16*)(ws + WS_HB);
    int* toke = (int*)(ws + WS_TOKE); int* tokp = (int*)(ws + WS_TOKP); float* tokw = (float*)(ws + WS_TOKW);
    for (int u = tid; u < (LDS_BYTES - LDSCTL_OFF) / 4; u += NWAVES * 64) ((LAS unsigned*)(lds + LDSCTL_OFF))[u] = 0u;
    __syncthreads();
    XcdBarrier bar; bar.bar = (unsigned*)(ctl + CW_BAR); bar.x = 0; bar.st = nullptr;
    if (!MK_SPLIT) bar = xcd_barrier_post((unsigned*)(ctl + CW_BAR), MISC + 8);
    const int lo = args.ph_lo, hi = args.ph_hi;
#define IN(k) (lo <= (k) && (k) < hi)
#define SEAM(k) do { if (IN(k) && IN((k) + 1)) xcd_barrier(bar); } while (0)
#define FRESH() int tid_ = threadIdx.x; asm volatile("" : "+v"(tid_)); const int lane_ = tid_ & 63, wave_ = __builtin_amdgcn_readfirstlane(tid_ >> 6), gw_ = vcu * NWAVES + wave_; (void)lane_; (void)wave_; (void)gw_

    if (IN(0)) { FRESH(); p0_convert(P, lds, gw_, NGW, wave_, lane_); norm_first(P.x, P.gains, XN, ws + WS_XN8, gw_, NGW, lane_); }
    SEAM(0);
    for (int layer = 0; layer < 2; ++layer) {
        const int pb = layer == 0 ? 1 : 10;
        const float* gl = P.gains + (size_t)layer * 4 * DM;
        if (IN(pb + 0)) {
            const bool conv_first = layer == 0 && ((bx >> 3) & 1) != 0, conv_last = layer == 0 && ((bx >> 3) & 1) == 0;
            if (conv_first) { FRESH(); conv_share_a(P, lds, gw_, NGW, wave_, lane_); __syncthreads(); }
            { pg8::Gemm g{XN, (const bf16*)(ws + WS_WIN) + (size_t)layer * INW * DM + (size_t)ZV * DM, M, ZGA - ZV, DM, 0}; pg8::StaticOrder S; S.init(M, ZGA - ZV, G, bx);
              pg8::EpiZ E{Z, INW, ZV, 1.0f, 1000, 0};
              pg8::gemm_phase<pg8::EpiZ, pg8::StaticOrder, true, true>(lds + RING_OFF, g, S, E); }
            { pg8::Gemm g{(const bf16*)(ws + WS_XN8), (const bf16*)(ws + WS_WIN8) + (size_t)layer * 3584 * DM, M, 7168, DM / 2, 0}; pg8::StaticOrder S; S.init(M, 7168, G, bx);
              pg8::EpiZ E{Z, INW, 0, 1.0f / WSCALE, 12, ZGA - 3072};
              pg8::gemm_phase<pg8::EpiZ, pg8::StaticOrder, true, true, true>(lds + RING_OFF, g, S, E); }
            if (QW > 0 && bx >= 128) { FRESH(); conv_quota(P, lds, layer ? 2 : 0, bx, wave_, lane_); }
            if (conv_last) { FRESH(); conv_share_a(P, lds, gw_, NGW, wave_, lane_); }
        }
        SEAM(pb + 0);
        if (IN(pb + 1)) { FRESH(); attn_phase(Z, P.relb, OG, LSE, lds, G, tid_, wave_, lane_); }
        SEAM(pb + 1);
        if (IN(pb + 2)) { FRESH(); combine_pool_phase(Z, OG, LSE, (const bf16*)(ws + WS_WPOOL) + (size_t)layer * 4 * 128 * 128, P.pscale + (size_t)layer * 512, OA, OP, gw_, NGW, lane_); }
        SEAM(pb + 2);
        if (IN(pb + 3)) {
            { pg8::Gemm g{OA, (const bf16*)(ws + WS_WAO) + (size_t)layer * DM * 512, M, DM, 512}; pg8::StaticOrder S; S.init(M, DM, G, bx);
              pg8::EpiGate<0> E{Z + ZGA, INW, nullptr, TB, DM};
              pg8::gemm_phase<pg8::EpiGate<0>, pg8::StaticOrder, true, true>(lds + RING_OFF, g, S, E); }
            { pg8::Gemm g{OP, (const bf16*)(ws + WS_WPO) + (size_t)layer * DM * 512, M, DM, 512}; pg8::StaticOrder S; S.init(M, DM, G, bx);
              pg8::EpiGate<1> E{Z + ZGB, INW, TB, MRG, DM};
              pg8::gemm_phase<pg8::EpiGate<1>, pg8::StaticOrder, true, true>(lds + RING_OFF, g, S, E); }
        }
        SEAM(pb + 3);
        if (IN(pb + 4)) {
            pg8::Gemm g{MRG, (const bf16*)(ws + WS_WOUT) + (size_t)layer * DM * DM, M, DM, DM}; pg8::StaticOrder S; S.init(M, DM, G, bx);
            pg8::EpiZ E{MIXb, DM, 0, 1.0f, 1000, 0};
            pg8::gemm_phase<pg8::EpiZ, pg8::StaticOrder, true, true>(lds + RING_OFF, g, S, E);
        }
        SEAM(pb + 4);
        if (IN(pb + 5)) {
            FRESH();
            if (layer == 0) norm_mid<false, false>(MIXb, P.x, HB, gl + DM, gl + 2 * DM, nullptr, ws + WS_XN8, nullptr, ctl, toke, tokp, tokw, nullptr, gw_, NGW, lane_);
            else {
                LAS float* wrl = (LAS float*)(lds + RING_OFF);
                { float tmp[32];
#pragma unroll
                  for (int k = 0; k < 32; ++k) tmp[k] = P.wr[tid_ + 512 * k];
                  __builtin_amdgcn_sched_barrier(0);
#pragma unroll
                  for (int k = 0; k < 32; ++k) { const int i = tid_ + 512 * k; wrl[(i & 7) * DM + (i >> 3)] = tmp[k]; } }
                __syncthreads();
                norm_mid<true, true>(MIXb, HB, HB, gl + DM, gl + 2 * DM, XN, nullptr, wrl, ctl, toke, tokp, tokw, ws + WS_XP, gw_, NGW, lane_);
            }
        }
        SEAM(pb + 5);
        if (layer == 0) {
            if (IN(7)) {
                pg8::Gemm g{(const bf16*)(ws + WS_XN8), (const bf16*)(ws + WS_DGU), M, 2 * DFF, DM / 2}; pg8::StaticOrder S; S.init(M, 2 * DFF, G, bx);
                pg8::EpiSwiGLU E{(bf16*)(ws + WS_HM), DFF, 1.0f / WSCALE};
                pg8::gemm_phase<pg8::EpiSwiGLU, pg8::StaticOrder, true, true, true>(lds + RING_OFF, g, S, E);
                if (QW > 0 && bx >= 128) { FRESH(); conv_quota(P, lds, 1, bx, wave_, lane_); }
            }
            SEAM(7);
            if (IN(8)) {
                pg8::Gemm g{(const bf16*)(ws + WS_HM), (const bf16*)(ws + WS_DD), M, DM, DFF}; pg8::StaticOrder S; S.init(M, DM, G, bx);
                pg8::EpiZ E{MIXb, DM, 0, 1.0f, 1000, 0};
                const bool conv_first = ((bx >> 3) & 1) != 0;
                if (conv_first) { FRESH(); conv_share_gu(P, lds, gw_, NGW, wave_, lane_); __syncthreads(); }
                pg8::gemm_phase<pg8::EpiZ, pg8::StaticOrder, true, true>(lds + RING_OFF, g, S, E);
                if (!conv_first) { FRESH(); conv_share_gu(P, lds, gw_, NGW, wave_, lane_); }
            }
            SEAM(8);
            if (IN(9)) { FRESH(); norm_mid<false, true>(MIXb, HB, HB, P.gains + 3 * DM, P.gains + 4 * DM, XN, ws + WS_XN8, nullptr, ctl, toke, tokp, tokw, nullptr, gw_, NGW, lane_); }
            SEAM(9);
        } else {
            unsigned char* Xp = ws + WS_XP; unsigned char* HMp = ws + WS_HMP; bf16* Yp = (bf16*)(ws + WS_YP);
            if (IN(16)) { FRESH(); moe_tables(ctl, tab, tid_); }
            if (IN(17)) {
                if (MK_SPLIT) moe_tables(ctl, tab, tid);
                pg8::Gemm g{(const bf16*)Xp, (const bf16*)(ws + WS_MGU), MPAD, 2 * EFF, DM / 2}; pg8::MoeOrder S{__builtin_amdgcn_readfirstlane(tab[96]), (2 * EFF) / 256, G, bx, tab, XCAP / 256, 0, (2 * EFF) / 256, 0};
                pg8::EpiSwiGLU8 E{HMp, EFF, 1.0f / WSCALE};
                const int cut = 2 * ((bx >> 3) & 7);
#pragma unroll 1
                for (int part = 0; part < 2; ++part) {
                    pg8::SubOrder<pg8::MoeOrder> S2{S, part ? cut : 0, part ? (1 << 30) : cut};
                    pg8::gemm_phase<pg8::EpiSwiGLU8, pg8::SubOrder<pg8::MoeOrder>, true, true, true>(lds + RING_OFF, g, S2, E);
                    if (part == 0) { FRESH(); __syncthreads(); conv_share_down(P, lds, gw_, NGW, wave_, lane_); __syncthreads(); }
                }
            }
            SEAM(17);
            if (IN(18)) {
                if (MK_SPLIT) moe_tables(ctl, tab, tid);
                const int Pall = __builtin_amdgcn_readfirstlane(tab[96]), Pmain = Pall & ~31;
                pg8::EpiYp E{Yp, DM, 1.0f / WSCALE, (bf16*)(ws + WS_YT), Pmain};
                { pg8::Gemm g{(const bf16*)HMp, (const bf16*)(ws + WS_MD), MPAD, DM, EFF / 2, 0}; pg8::MoeOrder S{Pmain, DM / 256, G, bx, tab, 0, 0, DM / 256, 0};
                  pg8::gemm_phase<pg8::EpiYp, pg8::MoeOrder, true, true, true>(lds + RING_OFF, g, S, E); }
                if (Pall > Pmain) {
                  pg8::Gemm g{(const bf16*)HMp, (const bf16*)(ws + WS_MD), MPAD, DM, EFF / 8, EFF / 2}; pg8::MoeOrder S{Pall - Pmain, 4 * (DM / 256), G, bx, tab, 0, Pmain, DM / 256, EFF / 4};
                  pg8::gemm_phase<pg8::EpiYp, pg8::MoeOrder, true, true, true>(lds + RING_OFF, g, S, E); }
            }
            SEAM(18);
            if (IN(19)) {
                FRESH();
                if (MK_SPLIT) moe_tables(ctl, tab, tid_);
                norm_final(Yp, (const bf16*)(ws + WS_YT), P.gains + (size_t)(4 + 3) * DM, HB, P.out, toke, tokp, tokw, tab, gw_, NGW, lane_);
            }
        }
    }
#undef IN
#undef SEAM
}

extern "C" void kernel_launch(void* const* d_in, const int* in_sizes, int n_in, void* d_out, int out_size, void* d_ws, size_t ws_size, hipStream_t stream) {
    static int grid = 0;
    if (grid == 0) {
        if (n_in != 16 || out_size != M * DM || ws_size < WS_END) { fprintf(stderr, "kernel_launch: unexpected shapes (n_in %d out %d ws %zu, need %zu)\n", n_in, out_size, ws_size, (size_t)WS_END); grid = -1; return; }
        int dev = 0, cus = 0, per_cu = 0;
        if (hipGetDevice(&dev) != hipSuccess || hipDeviceGetAttribute(&cus, hipDeviceAttributeMultiprocessorCount, dev) != hipSuccess) { grid = -1; return; }
        if (hipFuncSetAttribute((const void*)mk_fwd, hipFuncAttributeMaxDynamicSharedMemorySize, LDS_BYTES) != hipSuccess) { fprintf(stderr, "kernel_launch: hipFuncSetAttribute failed\n"); grid = -1; return; }
        if (hipOccupancyMaxActiveBlocksPerMultiprocessor(&per_cu, (const void*)mk_fwd, NWAVES * 64, LDS_BYTES) != hipSuccess || per_cu < 1) { fprintf(stderr, "kernel_launch: occupancy query says %d\n", per_cu); }
        (void)hipGetLastError();
        if (cus < 256) { fprintf(stderr, "kernel_launch: built for a 256-CU device (got %d CUs)\n", cus); grid = -1; return; }
        grid = 256;
    }
    if (grid < 0) return;
    if (hipMemsetAsync((char*)d_ws + WS_CTL, 0, CTL_ZERO_BYTES, stream) != hipSuccess) return;
    Args a{};
    for (int i = 0; i < 16; ++i) a.in[i] = (const float*)d_in[i];
    a.out = (float*)d_out; a.ws = (unsigned char*)d_ws;
#if MK_SPLIT
    for (int ph = 0; ph < NPH; ++ph) { a.ph_lo = ph; a.ph_hi = ph + 1; hipLaunchKernelGGL(mk_fwd, dim3(grid), dim3(NWAVES * 64), LDS_BYTES, stream, a); }
#else
    a.ph_lo = 0; a.ph_hi = NPH;
    hipLaunchKernelGGL(mk_fwd, dim3(grid), dim3(NWAVES * 64), LDS_BYTES, stream, a);
#endif
    const hipError_t le = hipPeekAtLastError();
    if (le != hipSuccess) fprintf(stderr, "kernel_launch: launch failed: %s\n", hipGetErrorName(le));
}
```

```cpp
#include <hip/hip_runtime.h>
#include <cstdio>
#include <cstdint>
#ifndef MK_SPLIT
#define MK_SPLIT 0
#endif
namespace pg8 {
#define PG8_LAS __attribute__((address_space(3)))
typedef unsigned short bf16_t;
typedef short bf16x8 __attribute__((ext_vector_type(8)));
typedef float f32x4 __attribute__((ext_vector_type(4)));
typedef unsigned u32x4 __attribute__((ext_vector_type(4)));
typedef int i32x4 __attribute__((ext_vector_type(4)));
typedef int i32x8 __attribute__((ext_vector_type(8)));
constexpr int BM = 256, BK = 64, HALF = 128, HTB = HALF * BK * 2  , STAGE_BYTES = 8 * HTB, NXCD = 8, WGM = 4;

__host__ __device__ __forceinline__ int lds_byte(int r, int c) { const int st = (r >> 4) * 2 + (c >> 5), rr = r & 15, cc = c & 31, ob = rr * 64 + cc * 2; return st * 1024 + (ob ^ (((ob >> 9) & 1) << 5)); }
__host__ __device__ __forceinline__ void stage_rc(int b, int& R, int& C) { const int st = b / 1024, sb = b % 1024, swz = sb ^ (((sb >> 9) & 1) << 5); R = (st >> 1) * 16 + swz / 64; C = (st & 1) * 32 + (swz % 64) / 2; }
__host__ __device__ __forceinline__ int perm32(int rho) { const int n = rho >> 4, i = rho & 15; return 8 * (i >> 2) + 4 * n + (i & 3); }

struct Unit { int pm, pn, pb, ko, ks, pa; };
struct Gemm { const bf16_t* A; const bf16_t* Bt; int M, N, K, ld; };

struct StaticOrder {
    int nM, nN, nwg, G, c;
    __host__ __device__ void init(int M, int N, int G_, int c_) { nM = M / BM; nN = N / BM; nwg = nM * nN; G = G_; c = c_; }
    __host__ __device__ bool next(int i, Unit& u) const {
        const long L = (long)i * G + c; if (L >= nwg) return false;
        int wgid = (int)L; { const int q = nwg / NXCD, r = nwg % NXCD, xcd = wgid % NXCD, off = wgid / NXCD; wgid = (xcd < r ? xcd * (q + 1) : r * (q + 1) + (xcd - r) * q) + off; }
        const int nig = WGM * nN, gid = wgid / nig, fm = gid * WGM, gsz = (nM - fm) < WGM ? (nM - fm) : WGM;
        u.pm = fm + ((wgid % nig) % gsz); u.pn = (wgid % nig) / gsz; u.pb = u.pn; u.ko = 0; u.ks = 0; u.pa = u.pm; return true;
    }
    __device__ __forceinline__ void a_ready(const Unit&) const {}
    __device__ __forceinline__ void done(const Unit&) const {}
};

typedef __bf16 bf16x2_t __attribute__((ext_vector_type(2)));
__device__ __forceinline__ unsigned cvt_pk_bf16(float lo, float hi) { typedef float f32x2v __attribute__((ext_vector_type(2))); const f32x2v v = {lo, hi}; return __builtin_bit_cast(unsigned, __builtin_convertvector(v, bf16x2_t)); }
typedef float f32x2 __attribute__((ext_vector_type(2)));
__device__ __forceinline__ f32x2 gelu_pk(f32x2 v) {
    const f32x2 av = __builtin_elementwise_abs(v), d = av * 0.2316418882f + 1.0f;
    f32x2 t; t.x = __builtin_amdgcn_rcpf(d.x); t.y = __builtin_amdgcn_rcpf(d.y);
    f32x2 q = t * 0.5307027145f + (-0.7265760135f); q = q * t + 0.7107068705f; q = q * t + (-0.142248368f); q = q * t + 0.127414796f; q = q * t;
    const f32x2 s = (v * v) * (-0.72134752044f);
    f32x2 e; e.x = __builtin_amdgcn_exp2f(s.x); e.y = __builtin_amdgcn_exp2f(s.y);
    const f32x2 m = v * (q * e), r = v - m;
    f32x2 o; o.x = v.x < 0.f ? m.x : r.x; o.y = v.y < 0.f ? m.y : r.y; return o;
}

__device__ __forceinline__ f32x2 sigmoid_pk(f32x2 x, float c1) { const f32x2 t = x * c1; f32x2 e; e.x = __builtin_amdgcn_exp2f(t.x); e.y = __builtin_amdgcn_exp2f(t.y); const f32x2 d = e + 1.0f;
    f32x2 r; r.x = __builtin_amdgcn_rcpf(d.x); r.y = __builtin_amdgcn_rcpf(d.y); return r; }
__device__ __forceinline__ f32x2 swiglu_pk(f32x2 a, f32x2 b, float c1, float k2) { return (a * b) * (sigmoid_pk(a, c1) * k2); }
__device__ __forceinline__ float sigmoid_f(float v) { return __builtin_amdgcn_rcpf(1.0f + __builtin_amdgcn_exp2f(-1.4426950408889634f * v)); }
__device__ __forceinline__ float bf_lo(unsigned w) { return __uint_as_float(w << 16); }
__device__ __forceinline__ float bf_hi(unsigned w) { return __uint_as_float(w & 0xffff0000u); }
struct EpiZ {
    static constexpr bool PERM = true, AFTER_DRAIN = false;
    bf16_t* O; int ldc; int col_off; float sc; int sig_from; int gap;
    __device__ __forceinline__ void operator()(const f32x4 (&acc)[2][2][4][2], const Unit& u, int wr, int wc, int fr, int fq) const {
        const bool sg = u.pn >= sig_from;
        const int row0 = u.pm * BM + wr * 64 + fr, col0 = col_off + u.pn * BM + (sg ? gap : 0) + wc * 32 + 8 * fq;
#pragma unroll
        for (int ai = 0; ai < 2; ++ai)
#pragma unroll
            for (int m = 0; m < 4; ++m) { bf16_t* rowp = O + (size_t)(row0 + ai * HALF + m * 16) * ldc + col0;
#pragma unroll
                for (int bj = 0; bj < 2; ++bj) { f32x4 v0, v1;
                    if (sg) { const float c1 = -1.4426950408889634f * sc; const f32x4 x0 = acc[ai][bj][m][0], x1 = acc[ai][bj][m][1];
                        const f32x2 a = sigmoid_pk((f32x2){x0[0], x0[1]}, c1), b = sigmoid_pk((f32x2){x0[2], x0[3]}, c1), c = sigmoid_pk((f32x2){x1[0], x1[1]}, c1), d = sigmoid_pk((f32x2){x1[2], x1[3]}, c1);
                        v0 = (f32x4){a.x, a.y, b.x, b.y}; v1 = (f32x4){c.x, c.y, d.x, d.y}; }
                    else { v0 = acc[ai][bj][m][0] * sc; v1 = acc[ai][bj][m][1] * sc; }
                    u32x4 w; w.x = cvt_pk_bf16(v0[0], v0[1]); w.y = cvt_pk_bf16(v0[2], v0[3]); w.z = cvt_pk_bf16(v1[0], v1[1]); w.w = cvt_pk_bf16(v1[2], v1[3]);
                    *(u32x4*)(rowp + bj * HALF) = w; } }
    }
};
template <int MODE> struct EpiGate {
    static constexpr bool PERM = true, AFTER_DRAIN = false;
    const bf16_t* G; int ldg; const bf16_t* Tin; bf16_t* O; int ldc;
    __device__ __forceinline__ void operator()(const f32x4 (&acc)[2][2][4][2], const Unit& u, int wr, int wc, int fr, int fq) const {
        const int row0 = u.pm * BM + wr * 64 + fr, col0 = u.pn * BM + wc * 32 + 8 * fq;
#pragma unroll
        for (int ai = 0; ai < 2; ++ai)
#pragma unroll
          for (int mh = 0; mh < 2; ++mh) {
            u32x4 gw[2][2], tw[2][2];
#pragma unroll
            for (int mm = 0; mm < 2; ++mm)
#pragma unroll
                for (int bj = 0; bj < 2; ++bj) { const size_t row = (size_t)(row0 + ai * HALF + (2 * mh + mm) * 16); const int col = col0 + bj * HALF;
                    gw[mm][bj] = *(const u32x4*)(G + row * ldg + col); if (MODE == 1) tw[mm][bj] = *(const u32x4*)(Tin + row * ldc + col); }
            __builtin_amdgcn_sched_barrier(0);
#pragma unroll
            for (int mm = 0; mm < 2; ++mm)
#pragma unroll
                for (int bj = 0; bj < 2; ++bj) { const int m = 2 * mh + mm; const size_t row = (size_t)(row0 + ai * HALF + m * 16); const int col = col0 + bj * HALF; const u32x4 g4 = gw[mm][bj];
                    f32x4 v0 = acc[ai][bj][m][0], v1 = acc[ai][bj][m][1];
                    v0[0] *= bf_lo(g4.x); v0[1] *= bf_hi(g4.x); v0[2] *= bf_lo(g4.y); v0[3] *= bf_hi(g4.y);
                    v1[0] *= bf_lo(g4.z); v1[1] *= bf_hi(g4.z); v1[2] *= bf_lo(g4.w); v1[3] *= bf_hi(g4.w);
                    if (MODE == 1) { const u32x4 t4 = tw[mm][bj];
                        v0[0] += bf_lo(t4.x); v0[1] += bf_hi(t4.x); v0[2] += bf_lo(t4.y); v0[3] += bf_hi(t4.y);
                        v1[0] += bf_lo(t4.z); v1[1] += bf_hi(t4.z); v1[2] += bf_lo(t4.w); v1[3] += bf_hi(t4.w); }
                    u32x4 w; w.x = cvt_pk_bf16(v0[0], v0[1]); w.y = cvt_pk_bf16(v0[2], v0[3]); w.z = cvt_pk_bf16(v1[0], v1[1]); w.w = cvt_pk_bf16(v1[2], v1[3]);
                    *(u32x4*)(O + row * ldc + col) = w; }
            __builtin_amdgcn_sched_barrier(0);
          }
    }
};
struct EpiF32 {
    static constexpr bool PERM = false, AFTER_DRAIN = false;
    float* C; int ldc;
    __device__ __forceinline__ void operator()(const f32x4 (&acc)[2][2][4][2], const Unit& u, int wr, int wc, int fr, int fq) const {
        const int row0 = u.pm * BM + wr * 64 + fr, col0 = u.pn * BM + wc * 32 + 4 * fq;
#pragma unroll
        for (int ai = 0; ai < 2; ++ai)
#pragma unroll
            for (int m = 0; m < 4; ++m) { float* rowp = C + (size_t)(row0 + ai * HALF + m * 16) * ldc + col0;
#pragma unroll
                for (int bj = 0; bj < 2; ++bj)
#pragma unroll
                    for (int n = 0; n < 2; ++n) *(f32x4*)(rowp + bj * HALF + n * 16) = acc[ai][bj][m][n]; }
    }
};
struct EpiSwiGLU {
    static constexpr bool PERM = true, AFTER_DRAIN = false;
    bf16_t* O; int ldo; float sc;
    __device__ __forceinline__ void operator()(const f32x4 (&acc)[2][2][4][2], const Unit& u, int wr, int wc, int fr, int fq) const {
        const int row0 = u.pm * BM + wr * 64 + fr, col0 = u.pn * HALF + wc * 32 + 8 * fq;
#pragma unroll
        for (int ai = 0; ai < 2; ++ai)
#pragma unroll
            for (int m = 0; m < 4; ++m) { bf16_t* rowp = O + (size_t)(row0 + ai * HALF + m * 16) * ldo + col0;
                f32x4 v0, v1;
                { const f32x4 g0 = acc[ai][0][m][0], g1 = acc[ai][0][m][1], u0 = acc[ai][1][m][0], u1 = acc[ai][1][m][1]; const float c1 = -1.4426950408889634f * sc, k2 = sc * sc;
                  const f32x2 a = swiglu_pk((f32x2){g0[0], g0[1]}, (f32x2){u0[0], u0[1]}, c1, k2), b = swiglu_pk((f32x2){g0[2], g0[3]}, (f32x2){u0[2], u0[3]}, c1, k2),
                              c = swiglu_pk((f32x2){g1[0], g1[1]}, (f32x2){u1[0], u1[1]}, c1, k2), d = swiglu_pk((f32x2){g1[2], g1[3]}, (f32x2){u1[2], u1[3]}, c1, k2);
                  v0 = (f32x4){a.x, a.y, b.x, b.y}; v1 = (f32x4){c.x, c.y, d.x, d.y}; }
                u32x4 w; w.x = cvt_pk_bf16(v0[0], v0[1]); w.y = cvt_pk_bf16(v0[2], v0[3]); w.z = cvt_pk_bf16(v1[0], v1[1]); w.w = cvt_pk_bf16(v1[2], v1[3]);
                *(u32x4*)rowp = w; __builtin_amdgcn_sched_barrier(0); }
    }
};
__device__ __forceinline__ float clamp8(float v) { return __builtin_fminf(__builtin_fmaxf(v, -440.f), 440.f); }
__device__ __forceinline__ unsigned pack4_fp8(float a, float b, float c, float d) { int w = __builtin_amdgcn_cvt_pk_fp8_f32(clamp8(a), clamp8(b), 0, false); w = __builtin_amdgcn_cvt_pk_fp8_f32(clamp8(c), clamp8(d), w, true); return (unsigned)w; }
struct EpiSwiGLU8 {
    static constexpr bool PERM = true, AFTER_DRAIN = false;
    unsigned char* O; int ldo; float sc;
    __device__ __forceinline__ void operator()(const f32x4 (&acc)[2][2][4][2], const Unit& u, int wr, int wc, int fr, int fq) const {
        const int row0 = u.pm * BM + wr * 64 + fr, col0 = u.pn * HALF + wc * 32 + 8 * fq;
#pragma unroll
        for (int ai = 0; ai < 2; ++ai)
#pragma unroll
            for (int m = 0; m < 4; ++m) { unsigned char* rowp = O + (size_t)(row0 + ai * HALF + m * 16) * ldo + col0;
                f32x4 v0, v1;
                { const f32x4 g0 = acc[ai][0][m][0], g1 = acc[ai][0][m][1], u0 = acc[ai][1][m][0], u1 = acc[ai][1][m][1]; const float c1 = -1.4426950408889634f * sc, k2 = sc * sc;
                  const f32x2 a = swiglu_pk((f32x2){g0[0], g0[1]}, (f32x2){u0[0], u0[1]}, c1, k2), b = swiglu_pk((f32x2){g0[2], g0[3]}, (f32x2){u0[2], u0[3]}, c1, k2),
                              c = swiglu_pk((f32x2){g1[0], g1[1]}, (f32x2){u1[0], u1[1]}, c1, k2), d = swiglu_pk((f32x2){g1[2], g1[3]}, (f32x2){u1[2], u1[3]}, c1, k2);
                  v0 = (f32x4){a.x, a.y, b.x, b.y}; v1 = (f32x4){c.x, c.y, d.x, d.y}; }
                typedef unsigned u32x2 __attribute__((ext_vector_type(2)));
                u32x2 w; w.x = pack4_fp8(v0[0], v0[1], v0[2], v0[3]); w.y = pack4_fp8(v1[0], v1[1], v1[2], v1[3]);
                *(u32x2*)rowp = w; __builtin_amdgcn_sched_barrier(0); }
    }
};
struct EpiYp {
    static constexpr bool PERM = true, AFTER_DRAIN = false;
    bf16_t* C; int ldc; float sc; bf16_t* Ct; int pm0;
    __device__ __forceinline__ void operator()(const f32x4 (&acc)[2][2][4][2], const Unit& u, int wr, int wc, int fr, int fq) const {
        const int row0 = u.pm * BM + wr * 64 + fr, col0 = u.pn * BM + wc * 32 + 8 * fq;
        bf16_t* base = u.ks == 0 ? C + (size_t)row0 * ldc : Ct + ((size_t)(u.ks - 1) * 2048 + (row0 - pm0 * BM)) * ldc;
#pragma unroll
        for (int ai = 0; ai < 2; ++ai)
#pragma unroll
            for (int m = 0; m < 4; ++m) { bf16_t* rowp = base + (size_t)(ai * HALF + m * 16) * ldc + col0;
#pragma unroll
                for (int bj = 0; bj < 2; ++bj) { const f32x4 v0 = acc[ai][bj][m][0] * sc, v1 = acc[ai][bj][m][1] * sc;
                    u32x4 w; w.x = cvt_pk_bf16(v0[0], v0[1]); w.y = cvt_pk_bf16(v0[2], v0[3]); w.z = cvt_pk_bf16(v1[0], v1[1]); w.w = cvt_pk_bf16(v1[2], v1[3]);
                    *(u32x4*)(rowp + bj * HALF) = w; } }
    }
};
struct MoeOrder {
    int P, NT, G, c; const PG8_LAS int* pexp;
    int acap;
    int pm0, NTC, kbytes;
    __device__ __forceinline__ bool next(int i, Unit& u) const {
        const int U = ((i * 8 + (c & 7)) * 32) + (c >> 3); if (U >= P * NT) return false;
        const int gsz = 4 * NT, g = U / gsz, up = U - g * gsz; int pl = P - 4 * g; pl = pl > 4 ? 4 : pl;
        const int blk = pl * 8, j = up / blk, rr = up - j * blk, v = 8 * j + rr / pl;
        u.pm = pm0 + 4 * g + rr % pl; u.ks = v / NTC; u.pn = v - u.ks * NTC; u.ko = u.ks * kbytes; const int e = __builtin_amdgcn_readfirstlane(pexp[u.pm]); u.pb = e * NTC + u.pn;
        u.pa = acap ? e * acap + u.pm - (__builtin_amdgcn_readfirstlane(pexp[80 + e]) >> 8) : u.pm; return true;
    }
    __device__ __forceinline__ void a_ready(const Unit&) const {}
    __device__ __forceinline__ void done(const Unit&) const {}
};

template <class S> struct SubOrder {
    S s; int lo, hi;
    __device__ __forceinline__ bool next(int i, Unit& u) const { return (lo + i < hi) && s.next(lo + i, u); }
    __device__ __forceinline__ void a_ready(const Unit& u) const { s.a_ready(u); }
    __device__ __forceinline__ void done(const Unit& u) const { s.done(u); }
};

template <bool F8> struct Frag;
template <> struct Frag<false> { bf16x8 v[2]; __device__ __forceinline__ void set(int k, bf16x8 x) { v[k] = x; } };
template <> struct Frag<true> { i32x8 w; __device__ __forceinline__ void set(int k, bf16x8 x) { if (k == 0) w.lo = __builtin_bit_cast(i32x4, x); else w.hi = __builtin_bit_cast(i32x4, x); } };
template <class Epi, class Sched, bool ALIGN_EPI = false, bool SP2 = false, bool FP8 = false>
__device__ __forceinline__ void gemm_phase(PG8_LAS unsigned char* lds, const Gemm g, const Sched& S, const Epi& E) {
    int tid = threadIdx.x; asm volatile("" : "+v"(tid));
    const int wid = __builtin_amdgcn_readfirstlane(tid >> 6), lane = tid & 63, wr = wid >> 2, wc = wid & 3, fr = lane & 15, fq = lane >> 4;
    const int K = g.K, nt = K / BK, LD = g.ld ? g.ld : g.K;
    unsigned voffA[2], voffB[2];
#pragma unroll
    for (int i = 0; i < 2; ++i) { int R, C; stage_rc(tid * 16 + i * 8192, R, C); const int Rb = Epi::PERM ? ((R & ~31) + perm32(R & 31)) : R;
        voffA[i] = (unsigned)(R * LD + C) * 2u; voffB[i] = (unsigned)(Rb * LD + C) * 2u; }
    const size_t kstep = (size_t)(BK * 2);
    const size_t hstep = (size_t)HALF * LD * 2;
    const size_t tstep = 2 * hstep;
    const unsigned ldsw = (unsigned)wid * 1024u;
    const int aoff = lds_byte(wr * 64 + fr, fq * 8), boff = lds_byte(wc * 32 + fr, fq * 8);
#define PG8_SA(b, h) (((b) * 2 + (h)) * HTB)
#define PG8_SB(b, h) ((4 + (b) * 2 + (h)) * HTB)
#define PG8_STAGE(bufoff, gbase, voff) do { _Pragma("unroll") for (int _i = 0; _i < 2; ++_i) \
        __builtin_amdgcn_global_load_lds((const unsigned*)((const char*)(gbase) + (voff)[_i]), (PG8_LAS unsigned*)(lds + (bufoff) + ldsw + _i * 8192), 16, 0, 0); } while (0)
#define PG8_LDA(dst, b, h) do { _Pragma("unroll") for (int m = 0; m < 4; ++m) _Pragma("unroll") for (int k = 0; k < 2; ++k) dst[m].set(k, *(const PG8_LAS bf16x8*)(lds + PG8_SA(b, h) + aoff + m * 2048 + k * 1024)); } while (0)
#define PG8_LDB(dst, b, h) do { _Pragma("unroll") for (int n = 0; n < 2; ++n) _Pragma("unroll") for (int k = 0; k < 2; ++k) dst[n].set(k, *(const PG8_LAS bf16x8*)(lds + PG8_SB(b, h) + boff + n * 2048 + k * 1024)); } while (0)
#define PG8_MMA(ai, bj, At, Bt) do { __builtin_amdgcn_s_setprio(1); _Pragma("unroll") for (int m = 0; m < 4; ++m) _Pragma("unroll") for (int n = 0; n < 2; ++n) { \
        if constexpr (FP8) asm volatile("v_mfma_scale_f32_16x16x128_f8f6f4 %0, %1, %2, %0, %3, %3 op_sel_hi:[0,0,0]" : "+v"(acc[ai][bj][m][n]) : "v"(Bt[n].w), "v"(At[m].w), "v"(sc1));   \
        else { _Pragma("unroll") for (int k = 0; k < 2; ++k) acc[ai][bj][m][n] = __builtin_amdgcn_mfma_f32_16x16x32_bf16(Bt[n].v[k], At[m].v[k], acc[ai][bj][m][n], 0, 0, 0); } } __builtin_amdgcn_s_setprio(0); } while (0)
#define PG8_MMAZ(ai, bj, At, Bt) do { __builtin_amdgcn_s_setprio(1); _Pragma("unroll") for (int m = 0; m < 4; ++m) _Pragma("unroll") for (int n = 0; n < 2; ++n) { \
        if constexpr (FP8) asm volatile("v_mfma_scale_f32_16x16x128_f8f6f4 %0, %1, %2, 0, %3, %3 op_sel_hi:[0,0,0]" : "=&v"(acc[ai][bj][m][n]) : "v"(Bt[n].w), "v"(At[m].w), "v"(sc1)); \
        else { acc[ai][bj][m][n] = __builtin_amdgcn_mfma_f32_16x16x32_bf16(Bt[n].v[0], At[m].v[0], (f32x4){0.f, 0.f, 0.f, 0.f}, 0, 0, 0); \
               acc[ai][bj][m][n] = __builtin_amdgcn_mfma_f32_16x16x32_bf16(Bt[n].v[1], At[m].v[1], acc[ai][bj][m][n], 0, 0, 0); } } __builtin_amdgcn_s_setprio(0); } while (0)
#define PG8_WAIT_V(n) asm volatile("s_waitcnt vmcnt(" #n ")" ::: "memory")
#define PG8_WAIT_L(n) asm volatile("s_waitcnt lgkmcnt(" #n ")" ::: "memory")
#define PG8_BAR __builtin_amdgcn_s_barrier()
#define PG8_SCHED __builtin_amdgcn_sched_barrier(0)
    Unit cur, nxt; int ui = 0;
    if (!S.next(0, cur)) return;
    f32x4 acc[2][2][4][2];
#pragma unroll
    for (int a = 0; a < 2; ++a)
#pragma unroll
        for (int b = 0; b < 2; ++b)
#pragma unroll
            for (int m = 0; m < 4; ++m)
#pragma unroll
                for (int n = 0; n < 2; ++n) { if constexpr (SP2 && FP8) asm volatile("" : "=v"(acc[a][b][m][n])); else acc[a][b][m][n] = (f32x4){0.f, 0.f, 0.f, 0.f}; }
    Frag<FP8> At[4], B0[2], B1[2];
    int sc1 = 0x7f7f7f7f; asm volatile("" : "+v"(sc1));
    (void)sc1;
    const char* cA = (const char*)g.A + (size_t)cur.pa * tstep + cur.ko; const char* cB = (const char*)g.Bt + (size_t)cur.pb * tstep + cur.ko;
    asm volatile("" : "+v"(voffA[0]), "+v"(voffA[1]), "+v"(voffB[0]), "+v"(voffB[1]));
    S.a_ready(cur);
    if constexpr (SP2) {
        PG8_STAGE(PG8_SB(0, 0), cB, voffB); PG8_STAGE(PG8_SB(0, 1), cB + hstep, voffB); PG8_STAGE(PG8_SA(0, 0), cA, voffA); PG8_STAGE(PG8_SA(0, 1), cA + hstep, voffA);
        if (wr == 1) PG8_BAR;
        PG8_WAIT_V(2); PG8_BAR;
        PG8_STAGE(PG8_SB(1, 0), cB + kstep, voffB); PG8_STAGE(PG8_SA(1, 0), cA + kstep, voffA); PG8_STAGE(PG8_SB(1, 1), cB + hstep + kstep, voffB);
        PG8_WAIT_V(6); PG8_BAR;
    } else {
        PG8_STAGE(PG8_SB(0, 0), cB, voffB); PG8_STAGE(PG8_SA(0, 0), cA, voffA); PG8_STAGE(PG8_SB(0, 1), cB + hstep, voffB); PG8_STAGE(PG8_SA(0, 1), cA + hstep, voffA);
        if (wr == 1) PG8_BAR;
        PG8_WAIT_V(4); PG8_BAR;
        PG8_STAGE(PG8_SB(1, 0), cB + kstep, voffB); PG8_STAGE(PG8_SA(1, 0), cA + kstep, voffA); PG8_STAGE(PG8_SB(1, 1), cB + hstep + kstep, voffB);
        PG8_WAIT_V(6); PG8_BAR;
    }
    for (;;) {
        const bool has_next = S.next(ui + 1, nxt);
        const char* nA = has_next ? (const char*)g.A + (size_t)nxt.pa * tstep + nxt.ko : cA; const char* nB = has_next ? (const char*)g.Bt + (size_t)nxt.pb * tstep + nxt.ko : cB;
        for (int t = 0; t < nt; t += 2) {
            const bool last = (t == nt - 2);
            const char* a1 = cA + (size_t)(t + 1) * kstep;
            const char* a2 = last ? nA : cA + (size_t)(t + 2) * kstep; const char* b2 = last ? nB : cB + (size_t)(t + 2) * kstep;
            const char* a3 = a2 + kstep; const char* b3 = b2 + kstep;
            if (last && has_next) S.a_ready(nxt);
            if constexpr (SP2) {
            PG8_LDB(B0, 0, 0); PG8_LDB(B1, 0, 1); PG8_SCHED; PG8_LDA(At, 0, 0); PG8_STAGE(PG8_SA(1, 1), a1 + hstep, voffA);
            PG8_WAIT_V(8); PG8_WAIT_L(0); PG8_BAR; if (FP8 && t == 0) { PG8_MMAZ(0, 0, At, B0); PG8_MMAZ(0, 1, At, B1); } else { PG8_MMA(0, 0, At, B0); PG8_MMA(0, 1, At, B1); } PG8_BAR; PG8_SCHED;
            PG8_LDA(At, 0, 1); PG8_STAGE(PG8_SB(0, 0), b2, voffB); PG8_STAGE(PG8_SB(0, 1), b2 + hstep, voffB); PG8_STAGE(PG8_SA(0, 0), a2, voffA);
            PG8_WAIT_V(8); PG8_WAIT_L(0); PG8_BAR; if (FP8 && t == 0) { PG8_MMAZ(1, 0, At, B0); PG8_MMAZ(1, 1, At, B1); } else { PG8_MMA(1, 0, At, B0); PG8_MMA(1, 1, At, B1); } PG8_BAR; PG8_SCHED;
            PG8_LDB(B0, 1, 0); PG8_LDB(B1, 1, 1); PG8_SCHED; PG8_LDA(At, 1, 0); PG8_STAGE(PG8_SA(0, 1), a2 + hstep, voffA);
            PG8_WAIT_V(8); PG8_WAIT_L(0); PG8_BAR; PG8_MMA(0, 0, At, B0); PG8_MMA(0, 1, At, B1); PG8_BAR; PG8_SCHED;
            PG8_LDA(At, 1, 1); PG8_STAGE(PG8_SB(1, 0), b3, voffB); PG8_STAGE(PG8_SB(1, 1), b3 + hstep, voffB); PG8_STAGE(PG8_SA(1, 0), a3, voffA);
            PG8_WAIT_V(8); PG8_WAIT_L(0); PG8_BAR; PG8_MMA(1, 0, At, B0); PG8_MMA(1, 1, At, B1); PG8_BAR; PG8_SCHED;
            } else {
            PG8_LDB(B0, 0, 0); PG8_SCHED; PG8_LDA(At, 0, 0); PG8_STAGE(PG8_SA(1, 1), a1 + hstep, voffA);
            PG8_WAIT_L(8); PG8_BAR; PG8_WAIT_L(0); PG8_MMA(0, 0, At, B0); PG8_BAR; PG8_SCHED;
            PG8_LDB(B1, 0, 1); PG8_STAGE(PG8_SB(0, 0), b2, voffB);
            PG8_BAR; PG8_WAIT_L(0); PG8_MMA(0, 1, At, B1); PG8_BAR;
            PG8_LDA(At, 0, 1); PG8_STAGE(PG8_SA(0, 0), a2, voffA);
            PG8_BAR; PG8_WAIT_L(0); PG8_MMA(1, 0, At, B0); PG8_BAR; PG8_SCHED;
            PG8_STAGE(PG8_SB(0, 1), b2 + hstep, voffB);
            PG8_WAIT_V(6); PG8_BAR; PG8_MMA(1, 1, At, B1); PG8_BAR;
            PG8_LDB(B0, 1, 0); PG8_SCHED; PG8_LDA(At, 1, 0); PG8_STAGE(PG8_SA(0, 1), a2 + hstep, voffA);
            PG8_WAIT_L(8); PG8_BAR; PG8_WAIT_L(0); PG8_MMA(0, 0, At, B0); PG8_BAR; PG8_SCHED;
            PG8_LDB(B1, 1, 1); PG8_STAGE(PG8_SB(1, 0), b3, voffB);
            PG8_BAR; PG8_WAIT_L(0); PG8_MMA(0, 1, At, B1); PG8_BAR;
            PG8_LDA(At, 1, 1); PG8_STAGE(PG8_SA(1, 0), a3, voffA);
            PG8_BAR; PG8_WAIT_L(0); PG8_MMA(1, 0, At, B0); PG8_BAR; PG8_SCHED;
            PG8_STAGE(PG8_SB(1, 1), b3 + hstep, voffB);
            PG8_WAIT_V(6); PG8_BAR; PG8_MMA(1, 1, At, B1); PG8_BAR;
            }
        }
        if constexpr (FP8) asm volatile("s_nop 7\n\ts_nop 7\n\ts_nop 7" ::: "memory");
        if constexpr (FP8) {
#pragma unroll
            for (int a = 0; a < 2; ++a)
#pragma unroll
                for (int b = 0; b < 2; ++b)
#pragma unroll
                    for (int m = 0; m < 4; ++m)
#pragma unroll
                        for (int n = 0; n < 2; ++n) asm volatile("" : "+v"(acc[a][b][m][n]));
        }
        if constexpr (ALIGN_EPI) { if (wr == 0) PG8_BAR; }
        if constexpr (!Epi::AFTER_DRAIN) { E(acc, cur, wr, wc, fr, fq); S.done(cur); }
        if (!has_next) break;
#pragma unroll
        for (int a = 0; a < 2; ++a)
#pragma unroll
            for (int b = 0; b < 2; ++b)
#pragma unroll
                for (int m = 0; m < 4; ++m)
#pragma unroll
                    for (int n = 0; n < 2; ++n) { if constexpr (!(SP2 && FP8)) acc[a][b][m][n] = (f32x4){0.f, 0.f, 0.f, 0.f}; }
        cur = nxt; cA = nA; cB = nB; ++ui;
        if constexpr (ALIGN_EPI) { if (wr == 1) PG8_BAR; }
    }
    PG8_WAIT_V(0);
    if constexpr (!ALIGN_EPI) { if (wr == 0) PG8_BAR; }
    PG8_BAR;
    if constexpr (Epi::AFTER_DRAIN) { E.fused(acc, cur, wr, wc, fr, fq, lds, wid, lane); S.done(cur); }
#undef PG8_SA
#undef PG8_SB
#undef PG8_STAGE
#undef PG8_LDA
#undef PG8_LDB
#undef PG8_MMA
#undef PG8_MMAZ
#undef PG8_WAIT_V
#undef PG8_WAIT_L
#undef PG8_BAR
#undef PG8_SCHED
}
}
constexpr int NWAVES = 8;
constexpr int BATCH = 2, SEQ = 4096, DM = 2048, M = BATCH * SEQ;
constexpr int INW = 9216, ZQ = 0, ZK = 1536, ZV = 3072, ZP = 4608, ZGA = 5120, ZGB = 7168;
constexpr int DFF = 5632, EFF = 7168, NEXP = 8;
constexpr int XCAP = M;
constexpr int MPAD = 2 * M + NEXP * 256;
constexpr float RMS_EPS = 1e-6f;
constexpr int NPH = 20;
constexpr size_t MiB = 1u << 20;
constexpr size_t WS_CTL = 0, CTL_ZERO_BYTES = 1 * MiB;
constexpr size_t WS_LSE = 1 * MiB, WS_TOKE = WS_LSE + 512 * 1024, WS_TOKP = WS_TOKE + 64 * 1024, WS_TOKW = WS_TOKP + 64 * 1024;
constexpr size_t WS_WIN = 2 * MiB;
constexpr size_t WS_WAO = WS_WIN + 72 * MiB;
constexpr size_t WS_WPO = WS_WAO + 4 * MiB;
constexpr size_t WS_WOUT = WS_WPO + 4 * MiB;
constexpr size_t WS_WPOOL = WS_WOUT + 16 * MiB;
constexpr size_t WS_DGU = WS_WPOOL + 1 * MiB;
constexpr size_t WS_DD = WS_DGU + 44 * MiB;
constexpr size_t WS_MGU = WS_DD + 22 * MiB;
constexpr size_t WS_MD = WS_MGU + 448 * MiB;
constexpr size_t WS_XN = WS_MD + 224 * MiB;
constexpr size_t WS_A = WS_XN + 32 * MiB;
constexpr size_t WS_Z = WS_A, WS_OG = WS_A + 144 * MiB, WS_OA = WS_A + 168 * MiB, WS_OP = WS_A + 176 * MiB, WS_HM = WS_A, WS_HMP = WS_A;
constexpr size_t WS_B = WS_A + 252 * MiB;
constexpr size_t WS_T = WS_B, WS_MRG = WS_B + 32 * MiB, WS_MIX = WS_B + 64 * MiB, WS_YP = WS_B;
constexpr size_t WS_XP = WS_WIN;
static_assert(WS_XP + (size_t)NEXP * XCAP * DM <= WS_MGU, "Xp must end before the MoE weight copies");
constexpr size_t WS_YT = WS_B + 144 * MiB;
constexpr size_t WS_WIN8 = WS_YT + 48 * MiB;
constexpr size_t WS_XN8 = WS_WIN8 + 32 * MiB;
constexpr size_t WS_HB = WS_XN8 + 16 * MiB;
constexpr size_t WS_END = WS_HB + 32 * MiB;
static_assert((size_t)MPAD * EFF * 2 <= 252 * MiB && (size_t)MPAD * DM * 4 <= 144 * MiB && (size_t)M * INW * 2 <= 144 * MiB, "arena sizes");
constexpr int CW_TMO = 0, CW_CODE = 1;
constexpr int CW_BAR = 4096;
constexpr int CW_CNT = 8192;
constexpr int RING_OFF = 0, RING_BYTES = 131072;
constexpr int LDSCTL_OFF = RING_BYTES, MISC_OFF = LDSCTL_OFF + 320, TAB_OFF = LDSCTL_OFF + 512;
constexpr int LDS_BYTES = 147456;

#define GAS __attribute__((address_space(1)))
#define LAS __attribute__((address_space(3)))
typedef unsigned short bf16;
typedef unsigned v4u __attribute__((ext_vector_type(4)));
typedef unsigned v2u __attribute__((ext_vector_type(2)));
typedef float f32x4 __attribute__((ext_vector_type(4)));
typedef short bf16x8 __attribute__((ext_vector_type(8)));
typedef short bf16x4 __attribute__((ext_vector_type(4)));
typedef GAS unsigned gu32;
#define RLX_AGENT __ATOMIC_RELAXED, __HIP_MEMORY_SCOPE_AGENT
#define LDS_WAIT() asm volatile("s_waitcnt lgkmcnt(0)" ::: "memory")
#define VM_WAIT() asm volatile("s_waitcnt vmcnt(0)" ::: "memory")
__device__ __forceinline__ unsigned f2bf(float f) { unsigned u = __builtin_bit_cast(unsigned, f); return (u + 0x7fffu + ((u >> 16) & 1u)) >> 16; }
__device__ __forceinline__ unsigned pk2(float lo, float hi) { return pg8::cvt_pk_bf16(lo, hi); }
__device__ __forceinline__ float bflo(unsigned w) { return __uint_as_float(w << 16); }
__device__ __forceinline__ float bfhi(unsigned w) { return __uint_as_float(w & 0xffff0000u); }
#define XB_TMO      128
#define XB_XCNT(j)  (256  + 64 * (j))
#define XB_XSUB(j)  (1280 + 64 * (j))
#define XB_XGEN(j)  (2304 + 64 * (j))
#define XB_TOP      3328
#define XB_TOPGEN   3392
#define XCD_BAR_WORDS 3456
#define XB_SPIN_CAP (1u << 18)

__device__ __forceinline__ unsigned xb_ld(unsigned* p)              { return __hip_atomic_load(p, __ATOMIC_RELAXED, __HIP_MEMORY_SCOPE_AGENT); }
__device__ __forceinline__ unsigned xb_add(unsigned* p, unsigned v) { return __hip_atomic_fetch_add(p, v, __ATOMIC_RELAXED, __HIP_MEMORY_SCOPE_AGENT); }
__device__ __forceinline__ unsigned xb_xcc_id() { return (unsigned)__builtin_amdgcn_s_getreg((3 << 11) | 20) & 0xFu; }
#define XB_SPIN(cond, bar) do { unsigned _sp = 0; while (cond) { __builtin_amdgcn_s_sleep(1); \
    if ((++_sp & 255u) == 0u) { if (xb_ld(&(bar)[XB_TMO])) break; if (_sp > XB_SPIN_CAP) { atomicAdd(&(bar)[XB_TMO], 1u); break; } } } } while (0)

struct XcdBarrier {
    unsigned* bar; unsigned x;
    volatile LAS unsigned* st;
};

__device__ __forceinline__ XcdBarrier xcd_barrier_post(unsigned* bar, volatile LAS unsigned* st) {
    XcdBarrier b; b.bar = bar; b.x = xb_xcc_id(); b.st = st;
    if (threadIdx.x == 0) (void)xb_add(&bar[XB_XCNT(b.x)], 1u);
    return b;
}
__device__ __forceinline__ void xcd_barrier_complete(unsigned* bar, unsigned x, unsigned& nloc, unsigned& nx) {
    const unsigned G = gridDim.x * gridDim.y * gridDim.z;
    unsigned sum, cnt, mine, sp = 0u;
    for (;;) {
        sum = 0u; cnt = 0u; mine = 0u;
#pragma unroll
        for (unsigned j = 0; j < 16; ++j) { const unsigned c = xb_ld(&bar[XB_XCNT(j)]); sum += c; cnt += (c > 0u) ? 1u : 0u; mine = (j == x) ? c : mine; }
        if (sum == G) break;
        __builtin_amdgcn_s_sleep(1);
        if ((++sp & 255u) == 0u) { if (xb_ld(&bar[XB_TMO])) break; if (sp > XB_SPIN_CAP) { atomicAdd(&bar[XB_TMO], 1u); break; } }
    }
    nloc = mine > 0u ? mine : 1u; nx = cnt > 0u ? cnt : 1u;
}

__device__ __forceinline__ void xcd_barrier(const XcdBarrier& b) {
    asm volatile("s_waitcnt vmcnt(0)" ::: "memory");
    __syncthreads();
    if (threadIdx.x == 0) {
        unsigned* bar = b.bar;
        __builtin_amdgcn_s_waitcnt(0);
        unsigned nloc = b.st[0], nx = b.st[1];
        if (nloc == 0u) { xcd_barrier_complete(bar, b.x, nloc, nx); b.st[0] = nloc; b.st[1] = nx; }
        const unsigned old = xb_add(&bar[XB_XSUB(b.x)], 1u);
        const unsigned gen = old / nloc;
        if (old + 1u == (gen + 1u) * nloc) {
            __builtin_amdgcn_fence(__ATOMIC_RELEASE, "agent");
            asm volatile("s_waitcnt vmcnt(0)" ::: "memory");
            const unsigned og = xb_add(&bar[XB_TOP], 1u);
            const unsigned tg = og / nx;
            if (og + 1u == (tg + 1u) * nx) xb_add(&bar[XB_TOPGEN], 1u);
            else XB_SPIN(xb_ld(&bar[XB_TOPGEN]) == tg, bar);
            __builtin_amdgcn_fence(__ATOMIC_ACQUIRE, "agent");
            xb_add(&bar[XB_XGEN(b.x)], 1u);
            asm volatile("s_waitcnt vmcnt(0)" ::: "memory");
        } else {
            XB_SPIN(xb_ld(&bar[XB_XGEN(b.x)]) == gen, bar);
            __builtin_amdgcn_fence(__ATOMIC_ACQUIRE, "agent");
            asm volatile("s_waitcnt vmcnt(0)" ::: "memory");
        }
    }
    __syncthreads();
}

__device__ __forceinline__ float wave_sum(float v) {
#pragma unroll
    for (int o = 1; o < 64; o <<= 1) v += __shfl_xor(v, o);
    return v;
}
__device__ __forceinline__ void conv64(const float* W, int ldn, int k0, int n0, bf16* dst, int ldk, int drow0, LAS float* scr, int lane) {
    { const int r = lane >> 4, j = lane & 15; f32x4 v[16];
      const GAS f32x4* src = (const GAS f32x4*)(W + (size_t)(k0 + r) * ldn + n0 + 4 * j);
#pragma unroll
      for (int i = 0; i < 16; ++i) v[i] = __builtin_nontemporal_load(src + (size_t)i * ldn);
#pragma unroll
      for (int i = 0; i < 16; ++i) { const int kk = 4 * i + r; *(LAS f32x4*)(scr + kk * 64 + ((4 * j) ^ (4 * ((kk >> 3) & 7)))) = v[i]; } }
    LDS_WAIT(); asm volatile("" ::: "memory");
    const int c = lane & 7, nn = lane >> 3;
#pragma unroll
    for (int t = 0; t < 8; ++t) { const int n = nn + 8 * t; const LAS float* sp = scr + (8 * c) * 64 + (n ^ (4 * c));
        v4u o; o.x = pk2(sp[0 * 64], sp[1 * 64]); o.y = pk2(sp[2 * 64], sp[3 * 64]); o.z = pk2(sp[4 * 64], sp[5 * 64]); o.w = pk2(sp[6 * 64], sp[7 * 64]);
        *(GAS v4u*)(dst + (size_t)(drow0 + n) * ldk + k0 + 8 * c) = o; }
    LDS_WAIT(); asm volatile("" ::: "memory");
}
constexpr float WSCALE = 64.0f;
__device__ __forceinline__ unsigned pk4_fp8(float a, float b, float c, float d) { int w = __builtin_amdgcn_cvt_pk_fp8_f32(a, b, 0, false); w = __builtin_amdgcn_cvt_pk_fp8_f32(c, d, w, true); return (unsigned)w; }
__device__ __forceinline__ void conv8(const float* W, int ldn, int k0, int n0, unsigned char* dst, int ldk, int drow0, LAS float* scr, int lane) {
    { const int r = lane >> 3, j = lane & 7; f32x4 v[16];
      const GAS f32x4* src = (const GAS f32x4*)(W + (size_t)(k0 + r) * ldn + n0 + 4 * j);
#pragma unroll
      for (int i = 0; i < 16; ++i) v[i] = __builtin_nontemporal_load(src + (size_t)i * 2 * ldn);
#pragma unroll
      for (int i = 0; i < 16; ++i) { const int kk = 8 * i + r; *(LAS f32x4*)(scr + kk * 32 + ((4 * j) ^ (4 * (i & 7)))) = v[i] * WSCALE; } }
    LDS_WAIT(); asm volatile("" ::: "memory");
    const int c = lane & 15, nn = lane >> 4;
#pragma unroll
    for (int t = 0; t < 8; ++t) { const int n = nn + 4 * t; const LAS float* sp = scr + (8 * c) * 32 + (n ^ (4 * (c & 7)));
        v2u o; o.x = pk4_fp8(sp[0 * 32], sp[1 * 32], sp[2 * 32], sp[3 * 32]); o.y = pk4_fp8(sp[4 * 32], sp[5 * 32], sp[6 * 32], sp[7 * 32]);
        *(GAS v2u*)(dst + (size_t)(drow0 + n) * ldk + k0 + 8 * c) = o; }
    LDS_WAIT(); asm volatile("" ::: "memory");
}
struct Ptrs {
    const float *x, *w_in, *relb, *w_pool, *pscale, *w_ao, *w_po, *w_out, *gains, *dwg, *dwu, *dwd, *wr, *mwg, *mwu, *mwd;
    float* out; unsigned char* ws;
};
constexpr int I_WIN = 2 * 32 * 32, I_WIN8 = 2 * 16 * 224, I_AO = 2 * 8 * 32, I_PO = I_AO, I_WOUT = 2 * 32 * 32, I_POOL = 8 * 2 * 2, I_DG = 16 * 176, I_DU = I_DG, I_DD = 88 * 32,
              I_MG = 8 * 16 * 224, I_MU = I_MG, I_MD = 8 * 56 * 64;
constexpr int N_ITEMS_A = I_WIN + I_WIN8 + I_AO + I_PO + I_WOUT + I_POOL + I_DG + I_DU + I_DD, N_ITEMS_B = I_MG + I_MU + I_MD;
#ifndef QW_ITEMS
#define QW_ITEMS 14
#endif
constexpr int QW = QW_ITEMS / 2, QWZ = QW_ITEMS / 2;
constexpr int N_DEFER = 128 * NWAVES * (QW + 2 * QWZ);
static_assert(N_DEFER <= N_ITEMS_B, "deferred conversion quota");
__device__ __forceinline__ void conv_a(const Ptrs& P, int it, LAS float* scr, int lane) {
    unsigned char* ws = P.ws; int r = it;
    if (r < I_WIN) { const int l = r / (32 * 32), q = r % (32 * 32), kb = q / 32, nb = q % 32;
        conv64(P.w_in + (size_t)l * DM * INW, INW, 64 * kb, ZV + 64 * nb, (bf16*)(ws + WS_WIN) + (size_t)l * INW * DM, DM, ZV + 64 * nb, scr, lane); return; } r -= I_WIN;
    if (r < I_WIN8) { const int l = r / (16 * 224), q = r % (16 * 224), kb = q / 224, nb = q % 224;
        const int n0 = nb < 96 ? 32 * nb : ZGA + 32 * (nb - 96);
        conv8(P.w_in + (size_t)l * DM * INW, INW, 128 * kb, n0, (unsigned char*)(ws + WS_WIN8) + (size_t)l * 7168 * DM, DM, 32 * nb, scr, lane); return; } r -= I_WIN8;
    if (r < I_AO) { const int l = r / 256, q = r % 256, kb = q / 32, nb = q % 32;
        conv64(P.w_ao + (size_t)l * 512 * DM, DM, 64 * kb, 64 * nb, (bf16*)(ws + WS_WAO) + (size_t)l * DM * 512, 512, 64 * nb, scr, lane); return; } r -= I_AO;
    if (r < I_PO) { const int l = r / 256, q = r % 256, kb = q / 32, nb = q % 32;
        conv64(P.w_po + (size_t)l * 512 * DM, DM, 64 * kb, 64 * nb, (bf16*)(ws + WS_WPO) + (size_t)l * DM * 512, 512, 64 * nb, scr, lane); return; } r -= I_PO;
    if (r < I_WOUT) { const int l = r / 1024, q = r % 1024, kb = q / 32, nb = q % 32;
        conv64(P.w_out + (size_t)l * DM * DM, DM, 64 * kb, 64 * nb, (bf16*)(ws + WS_WOUT) + (size_t)l * DM * DM, DM, 64 * nb, scr, lane); return; } r -= I_WOUT;
    if (r < I_POOL) { const int mtx = r / 4, q = r % 4, kb = q / 2, nb = q % 2;
        conv64(P.w_pool + (size_t)mtx * 128 * 128, 128, 64 * kb, 64 * nb, (bf16*)(ws + WS_WPOOL) + (size_t)mtx * 128 * 128, 128, 64 * nb, scr, lane); return; } r -= I_POOL;
    if (r < I_DG + I_DU) { const int up = r >= I_DG; const int q = up ? r - I_DG : r; const int kb = q / 176, nb = q % 176, n0 = 32 * nb;
        conv8(up ? P.dwu : P.dwg, DFF, 128 * kb, n0, (unsigned char*)(ws + WS_DGU), DM, (n0 >> 7) * 256 + (n0 & 127) + (up ? 128 : 0), scr, lane); return; } r -= I_DG + I_DU;
    { const int kb = r / 32, nb = r % 32;
        conv64(P.dwd, DM, 64 * kb, 64 * nb, (bf16*)(ws + WS_DD), DFF, 64 * nb, scr, lane); }
}
__device__ __forceinline__ void conv_b(const Ptrs& P, int it, LAS float* scr, int lane) {
    unsigned char* ws = P.ws; int r = it;
    if (r < I_MG + I_MU) { const int up = r >= I_MG; const int q0 = up ? r - I_MG : r; const int e = q0 / (16 * 224), q = q0 % (16 * 224), kb = q / 224, nb = q % 224, n0 = 32 * nb;
        conv8((up ? P.mwu : P.mwg) + (size_t)e * DM * EFF, EFF, 128 * kb, n0, (unsigned char*)(ws + WS_MGU) + (size_t)e * 2 * EFF * DM, DM, (n0 >> 7) * 256 + (n0 & 127) + (up ? 128 : 0), scr, lane); return; } r -= I_MG + I_MU;
    { const int e = r / (56 * 64), q = r % (56 * 64), kb = q / 64, nb = q % 64;
        conv8(P.mwd + (size_t)e * EFF * DM, DM, 128 * kb, 32 * nb, (unsigned char*)(ws + WS_MD) + (size_t)e * DM * EFF, EFF, 32 * nb, scr, lane); }
}
__device__ __forceinline__ void p0_convert(const Ptrs& P, LAS unsigned char* lds, int gw, int NGW, int wave, int lane) {
    LAS float* scr = (LAS float*)(lds + RING_OFF + wave * 16384);
#pragma unroll 1
    for (int j = gw; j < I_WIN / 2 + I_WIN8 / 2; j += NGW) conv_a(P, j < I_WIN / 2 ? j : I_WIN + (j - I_WIN / 2), scr, lane);
}
__device__ __forceinline__ void conv_share_down(const Ptrs& P, LAS unsigned char* lds, int gw, int NGW, int wave, int lane) {
    LAS float* scr = (LAS float*)(lds + RING_OFF + wave * 16384);
    constexpr int PER = I_MD / 256; static_assert(I_MD % 256 == 0 && PER % NWAVES == 0, "conv_share_down: whole steps of eight items per workgroup");
    const int first = I_MG + I_MU + (gw / NWAVES) * PER + wave;
#pragma unroll 1
    for (int j = 0; j < PER; j += NWAVES) conv_b(P, first + j, scr, lane);
}
__device__ __forceinline__ void conv_share_a(const Ptrs& P, LAS unsigned char* lds, int gw, int NGW, int wave, int lane) {
    LAS float* scr = (LAS float*)(lds + RING_OFF + wave * 16384);
    constexpr int NA1 = N_ITEMS_A - I_WIN / 2 - I_WIN8 / 2;
#pragma unroll 1
    for (int j = gw; j < NA1; j += NGW) conv_a(P, j < I_WIN / 2 ? I_WIN / 2 + j : I_WIN + I_WIN8 / 2 + (j - I_WIN / 2), scr, lane);
}
__device__ __forceinline__ void conv_share_gu(const Ptrs& P, LAS unsigned char* lds, int gw, int NGW, int wave, int lane) {
    LAS float* scr = (LAS float*)(lds + RING_OFF + wave * 16384);
    constexpr int PER = (I_MG + I_MU - N_DEFER) / 256; static_assert((I_MG + I_MU - N_DEFER) % 256 == 0, "conv_share_gu: equal runs");
    const int first = N_DEFER + (gw / NWAVES) * PER;
#pragma unroll 1
    for (int j = wave; j < PER; j += NWAVES) conv_b(P, first + j, scr, lane);
}
__device__ __forceinline__ void conv_quota(const Ptrs& P, LAS unsigned char* lds, int site, int bx, int wave, int lane) {
    LAS float* scr = (LAS float*)(lds + RING_OFF + wave * 16384);
    const int w = (bx - 128) * NWAVES + wave, nq = site == 1 ? QW : QWZ, base = 128 * NWAVES * (site == 0 ? 0 : (site == 1 ? QWZ : QWZ + QW));
#pragma unroll 1
    for (int q = 0; q < nq; ++q) conv_b(P, base + q * (128 * NWAVES) + w, scr, lane);
}
__device__ __forceinline__ void ld_row(const float* p, int lane, f32x4 (&v)[8]) { const GAS f32x4* r = (const GAS f32x4*)p + lane;
#pragma unroll
    for (int j = 0; j < 8; ++j) v[j] = r[64 * j]; }
__device__ __forceinline__ void ld_row_bfraw(const bf16* p, int lane, v2u (&w)[8]) { const GAS v2u* r = (const GAS v2u*)p + lane;
#pragma unroll
    for (int j = 0; j < 8; ++j) w[j] = r[64 * j]; }
__device__ __forceinline__ void unpack_bf(const v2u (&w)[8], f32x4 (&v)[8]) {
#pragma unroll
    for (int j = 0; j < 8; ++j) v[j] = (f32x4){bflo(w[j].x), bfhi(w[j].x), bflo(w[j].y), bfhi(w[j].y)}; }
__device__ __forceinline__ void ld_row_bf(const bf16* p, int lane, f32x4 (&v)[8]) { v2u w[8]; ld_row_bfraw(p, lane, w); __builtin_amdgcn_sched_barrier(0); unpack_bf(w, v); }
__device__ __forceinline__ float sumsq(const f32x4 (&v)[8]) { float s = 0.f;
#pragma unroll
    for (int j = 0; j < 8; ++j) s += (v[j].x * v[j].x + v[j].y * v[j].y) + (v[j].z * v[j].z + v[j].w * v[j].w);
    return wave_sum(s); }
__device__ __forceinline__ void st_row_bf16(bf16* p, int lane, const f32x4 (&v)[8]) { GAS v2u* o = (GAS v2u*)p + lane;
#pragma unroll
    for (int j = 0; j < 8; ++j) { v2u w; w.x = pk2(v[j].x, v[j].y); w.y = pk2(v[j].z, v[j].w); o[64 * j] = w; } }
__device__ __forceinline__ void st_row_fp8(unsigned char* p, int lane, const f32x4 (&v)[8]) { GAS unsigned* o = (GAS unsigned*)p + lane;
#pragma unroll
    for (int j = 0; j < 8; ++j) o[64 * j] = pk4_fp8(v[j].x, v[j].y, v[j].z, v[j].w); }
__device__ __forceinline__ void norm_first(const float* x, const float* g, bf16* XN, unsigned char* XN8, int gw, int NGW, int lane) {
    f32x4 gv[8]; ld_row(g, lane, gv);
#pragma unroll 1
    for (int m = gw; m < M; m += NGW) { f32x4 v[8]; ld_row(x + (size_t)m * DM, lane, v);
        const float r = 1.0f / sqrtf(sumsq(v) * (1.0f / DM) + RMS_EPS);
#pragma unroll
        for (int j = 0; j < 8; ++j) v[j] = v[j] * r * gv[j];
        st_row_bf16(XN + (size_t)m * DM, lane, v); st_row_fp8(XN8 + (size_t)m * DM, lane, v); }
}
template <bool ROUTER, bool RES_BF>
__device__ __forceinline__ void norm_mid(const bf16* src, const void* res, bf16* hout, const float* gpost, const float* gpre, bf16* XN, unsigned char* XN8,
                                         const LAS float* wrl, gu32* ctl, int* toke, int* tokp, float* tokw, unsigned char* Xp, int gw, int NGW, int lane) {
    f32x4 v[8], h[8], hn[8]; v2u vr[8], hr[8];
    unsigned pend[8]; int pe1 = 0, pe2 = 0; unsigned pp1 = 0u, pp2 = 0u; bool have = false;
    if (gw < M) { ld_row_bfraw(src + (size_t)gw * DM, lane, vr);
        if constexpr (RES_BF) ld_row_bfraw((const bf16*)res + (size_t)gw * DM, lane, hr); else ld_row((const float*)res + (size_t)gw * DM, lane, hn); }
#pragma unroll 1
    for (int m = gw; m < M; m += NGW) {
        const int mn = m + NGW;
        unpack_bf(vr, v);
        if constexpr (RES_BF) unpack_bf(hr, h); else {
#pragma unroll
            for (int j = 0; j < 8; ++j) h[j] = hn[j]; }
        __builtin_amdgcn_sched_barrier(0);
        if (mn < M) { ld_row_bfraw(src + (size_t)mn * DM, lane, vr);
            if constexpr (RES_BF) ld_row_bfraw((const bf16*)res + (size_t)mn * DM, lane, hr); else ld_row((const float*)res + (size_t)mn * DM, lane, hn); }
        __builtin_amdgcn_sched_barrier(0);
        f32x4 gv[8]; ld_row(gpost, lane, gv);
        const float r = 1.0f / sqrtf(sumsq(v) * (1.0f / DM) + RMS_EPS);
#pragma unroll
        for (int j = 0; j < 8; ++j) h[j] = h[j] + v[j] * r * gv[j];
        st_row_bf16(hout + (size_t)m * DM, lane, h);
        const float r2 = 1.0f / sqrtf(sumsq(h) * (1.0f / DM) + RMS_EPS);
        ld_row(gpre, lane, gv);
#pragma unroll
        for (int j = 0; j < 8; ++j) h[j] = h[j] * r2 * gv[j];
        if (!ROUTER && XN) st_row_bf16(XN + (size_t)m * DM, lane, h);
        if (XN8) st_row_fp8(XN8 + (size_t)m * DM, lane, h);
        if (ROUTER) {
            int e1 = 0, e2 = 0; float v1 = -3.0e38f, v2 = -3.0e38f;
#pragma unroll 1
            for (int e = 0; e < NEXP; ++e) { float s = 0.f; const LAS f32x4* wp = (const LAS f32x4*)(wrl + e * DM) + lane;
#pragma unroll
                for (int j = 0; j < 8; ++j) { const f32x4 w = wp[64 * j]; s += (h[j].x * w.x + h[j].y * w.y) + (h[j].z * w.z + h[j].w * w.w); }
                s = wave_sum(s);
                if (s > v1) { v2 = v1; e2 = e1; v1 = s; e1 = e; } else if (s > v2) { v2 = s; e2 = e; } }
            if (have) {
                const unsigned q1 = __builtin_amdgcn_readfirstlane(pp1), q2 = __builtin_amdgcn_readfirstlane(pp2);
                GAS unsigned* o1 = (GAS unsigned*)(Xp + ((size_t)pe1 * XCAP + q1) * DM) + lane; GAS unsigned* o2 = (GAS unsigned*)(Xp + ((size_t)pe2 * XCAP + q2) * DM) + lane;
#pragma unroll
                for (int j = 0; j < 8; ++j) { o1[64 * j] = pend[j]; o2[64 * j] = pend[j]; } }
#pragma unroll
            for (int j = 0; j < 8; ++j) pend[j] = pk4_fp8(h[j].x, h[j].y, h[j].z, h[j].w);
            pe1 = e1; pe2 = e2; have = true;
            if (lane == 0) {
                const float w1 = 1.0f / (1.0f + __expf(v2 - v1)), w2 = 1.0f - w1;
                pp1 = __hip_atomic_fetch_add(ctl + CW_CNT + 64 * e1, 1u, RLX_AGENT);
                pp2 = __hip_atomic_fetch_add(ctl + CW_CNT + 64 * e2, 1u, RLX_AGENT);
                toke[2 * m] = e1; toke[2 * m + 1] = e2; tokp[2 * m] = (int)pp1; tokp[2 * m + 1] = (int)pp2; tokw[2 * m] = w1; tokw[2 * m + 1] = w2;
            }
        }
    }
    if (ROUTER && have) {
        const unsigned q1 = __builtin_amdgcn_readfirstlane(pp1), q2 = __builtin_amdgcn_readfirstlane(pp2);
        GAS unsigned* o1 = (GAS unsigned*)(Xp + ((size_t)pe1 * XCAP + q1) * DM) + lane; GAS unsigned* o2 = (GAS unsigned*)(Xp + ((size_t)pe2 * XCAP + q2) * DM) + lane;
#pragma unroll
        for (int j = 0; j < 8; ++j) { o1[64 * j] = pend[j]; o2[64 * j] = pend[j]; } }
}
__device__ __forceinline__ void moe_tables(gu32* ctl, LAS int* tab, int tid) {
    if (tid < NEXP) { int c = (int)__hip_atomic_load(ctl + CW_CNT + 64 * tid, RLX_AGENT); if (c > XCAP) c = XCAP; tab[88 + tid] = c; }
    __syncthreads();
    if (tid == 0) { int off = 0, p = 0;
        for (int e = 0; e < NEXP; ++e) { const int c = tab[88 + e], np = (c + 255) >> 8;
            tab[80 + e] = off; for (int i = 0; i < np && p < 80; ++i) tab[p++] = e; off += np * 256; }
        tab[96] = p; }
    __syncthreads();
}
__device__ __forceinline__ void add_ytail(const bf16* Yt, int r, int rt0, int lane, f32x4 (&a)[8]) {
    if (r >= rt0) {
#pragma unroll 1
        for (int k = 0; k < 3; ++k) { f32x4 t[8]; ld_row_bf(Yt + ((size_t)k * 2048 + (r - rt0)) * DM, lane, t);
#pragma unroll
            for (int j = 0; j < 8; ++j) a[j] = a[j] + t[j]; } }
}
__device__ __forceinline__ void norm_final(const bf16* Yp, const bf16* Yt, const float* g, const bf16* hb, float* out, const int* toke, const int* tokp, const float* tokw, const LAS int* tab, int gw, int NGW, int lane) {
    const int rt0 = (tab[96] & ~31) * 256;
    v2u ar[8], br[8]; int r1 = 0, r2 = 0, r1n = 0, r2n = 0; float w1 = 0.f, w2 = 0.f, w1n = 0.f, w2n = 0.f;
    if (gw < M) { const int m = gw; r1 = tab[80 + toke[2 * m]] + tokp[2 * m]; r2 = tab[80 + toke[2 * m + 1]] + tokp[2 * m + 1]; w1 = tokw[2 * m]; w2 = tokw[2 * m + 1];
        ld_row_bfraw(Yp + (size_t)r1 * DM, lane, ar); ld_row_bfraw(Yp + (size_t)r2 * DM, lane, br); }
#pragma unroll 1
    for (int m = gw; m < M; m += NGW) {
        const int mn = m + NGW;
        f32x4 a[8], b[8]; unpack_bf(ar, a); unpack_bf(br, b);
        __builtin_amdgcn_sched_barrier(0);
        if (mn < M) { r1n = tab[80 + toke[2 * mn]] + tokp[2 * mn]; r2n = tab[80 + toke[2 * mn + 1]] + tokp[2 * mn + 1]; w1n = tokw[2 * mn]; w2n = tokw[2 * mn + 1];
            ld_row_bfraw(Yp + (size_t)r1n * DM, lane, ar); ld_row_bfraw(Yp + (size_t)r2n * DM, lane, br); }
        __builtin_amdgcn_sched_barrier(0);
        add_ytail(Yt, r1, rt0, lane, a); add_ytail(Yt, r2, rt0, lane, b);
#pragma unroll
        for (int j = 0; j < 8; ++j) a[j] = a[j] * w1 + b[j] * w2;
        ld_row_bf(hb + (size_t)m * DM, lane, b);
        const float r = 1.0f / sqrtf(sumsq(a) * (1.0f / DM) + RMS_EPS);
        GAS f32x4* o = (GAS f32x4*)(out + (size_t)m * DM) + lane; const GAS f32x4* gp = (const GAS f32x4*)g + lane;
#pragma unroll
        for (int j = 0; j < 8; ++j) o[64 * j] = b[j] + a[j] * r * gp[64 * j];
        r1 = r1n; r2 = r2n; w1 = w1n; w2 = w2n;
    }
}
__device__ __forceinline__ int t5_bucket(int d) {
    if (d < 16) return d;
    return 16 + (d >= 22) + (d >= 30) + (d >= 40) + (d >= 54) + (d >= 73) + (d >= 99) + (d >= 134) + (d >= 182) + (d >= 246) + (d >= 332) + (d >= 450) + (d >= 609) + (d >= 825) + (d >= 1117) + (d >= 1513);
}
struct AttnU { int b, g, d, r, n, hh, head; };
__device__ __forceinline__ AttnU attn_decode(int ui) { AttnU u; u.hh = ui & 3; const int u2 = ui >> 2; u.b = u2 / 96; const int s = u2 % 96;
    if (s < 32) { u.g = 0; u.d = 1; u.r = 0; u.n = s; } else if (s < 64) { u.g = 1; u.d = 4; u.r = (s - 32) >> 3; u.n = (s - 32) & 7; } else { u.g = 2; u.d = 16; u.r = (s - 64) >> 1; u.n = (s - 64) & 1; }
    u.head = u.g * 4 + u.hh; return u; }
__device__ __forceinline__ void att_dma16(const void* g, LAS unsigned char* piece) {
    unsigned sv; const unsigned base = (unsigned)(size_t)piece;
    asm volatile("s_mov_b32 %0, m0\n\ts_mov_b32 m0, %2\n\ts_nop 0\n\tglobal_load_lds_dwordx4 %1, off\n\ts_mov_b32 m0, %0" : "=&s"(sv) : "v"(g), "s"(__builtin_amdgcn_readfirstlane(base)) : "memory");
}
__device__ __forceinline__ int v_swz(int row) { return ((row & 3) << 2) | ((row >> 2) & 3); }
__device__ __forceinline__ void attn_dma_v(const bf16* Z, const AttnU& u, LAS unsigned char* buf, int wave, int lane) {
#pragma unroll
    for (int i = 0; i < 8; ++i) { const int piece = wave * 8 + i, p = 4 * piece + (lane >> 4), j = 128 * (u.n - 1) + p;
        const bf16* src = Z + (size_t)(u.b * SEQ + u.r + u.d * (j < 0 ? 0 : j)) * INW + ZV + u.head * 128 + 8 * ((lane & 15) ^ v_swz(p));
        att_dma16(src, buf + piece * 1024); }
}
constexpr int ATT_BT_OFF = LDSCTL_OFF + 1024;
__device__ __forceinline__ void attn_dma_k(const bf16* Z, const AttnU& u, LAS unsigned char* buf, int wave, int lane) {
#pragma unroll
    for (int i = 0; i < 8; ++i) { const int piece = wave * 8 + i, p = 4 * piece + (lane >> 4), j = 128 * (u.n - 1) + p;
        const bf16* src = Z + (size_t)(u.b * SEQ + u.r + u.d * (j < 0 ? 0 : j)) * INW + ZK + u.head * 128 + 8 * ((lane & 15) ^ (p & 15));
        att_dma16(src, buf + piece * 1024); }
}
__device__ __forceinline__ void attn_ld_q(const bf16* Z, const AttnU& u, int wave, int qi, int qd, bf16x8 (&qf)[4]) {
    const int jq = 128 * u.n + 16 * wave + qi; const size_t rowq = (size_t)(u.b * SEQ + u.r + u.d * jq);
#pragma unroll
    for (int s4 = 0; s4 < 4; ++s4) qf[s4] = *(const GAS bf16x8*)(Z + rowq * INW + ZQ + u.head * 128 + 32 * s4 + 8 * qd);
}
#define ATT_BAR() do { asm volatile("s_waitcnt lgkmcnt(0)" ::: "memory"); __builtin_amdgcn_s_barrier(); asm volatile("" ::: "memory"); } while (0)
__device__ __forceinline__ void attn_phase(const bf16* Z, const float* relb, bf16* OG, float* LSE, LAS unsigned char* lds, int G, int tid, int wave, int lane) {
    const int qi = lane & 15, qd = lane >> 4;
    constexpr float C2 = 0.08838834764831845f * 1.4426950408889634f;
    const int trq = (lane & 15) >> 2, trp = lane & 3, trrow = 4 * qd + trq, trswz = (trq << 2) | qd;
    LAS unsigned char* kbuf = lds + RING_OFF; LAS unsigned char* vbuf = lds + RING_OFF + 65536;
    const int tb = tid < 128 ? tid : 128;
    int it = 0;
    int bxl = blockIdx.x; asm volatile("" : "+s"(bxl));
    bf16x8 qf[4];
    if (bxl < 768) { const AttnU u0 = attn_decode(bxl);
        const float bv = relb[t5_bucket(tb * u0.d) * 12 + u0.head]; attn_ld_q(Z, u0, wave, qi, qd, qf);
        __builtin_amdgcn_sched_barrier(0);
        attn_dma_k(Z, u0, kbuf, wave, lane); attn_dma_v(Z, u0, vbuf, wave, lane);
        __builtin_amdgcn_sched_barrier(0);
        if (tid < 129) ((LAS float*)(lds + ATT_BT_OFF))[tid] = bv * 1.4426950408889634f; }
#pragma unroll 1
    for (int ui = bxl; ui < 768; ui += G, ++it) {
        const AttnU U = attn_decode(ui); const int b = U.b, g = U.g, d = U.d, r = U.r, n = U.n, hh = U.hh, head = U.head;
        const bool has_next = ui + G < 768;
        LAS float* btab = (LAS float*)(lds + ATT_BT_OFF) + (it & 1) * 132; LAS float* btabn = (LAS float*)(lds + ATT_BT_OFF) + ((it + 1) & 1) * 132;
        const int jq = 128 * n + 16 * wave + qi; const size_t rowq = (size_t)(b * SEQ + r + d * jq);
        __builtin_amdgcn_sched_barrier(0);
        asm volatile("s_waitcnt vmcnt(8)" ::: "memory");
        ATT_BAR();
        __builtin_amdgcn_sched_barrier(0);
        f32x4 sa[9];
        const LAS unsigned char* krow = kbuf + (16 * wave + qi) * 256;
        bf16x8 kfA[3][4], kfB[3][4];
#define ATT_LDK(dst, t0) do { _Pragma("unroll") for (int tt = 0; tt < 3; ++tt) _Pragma("unroll") for (int s4 = 0; s4 < 4; ++s4) dst[tt][s4] = *(const LAS bf16x8*)(krow + ((t0) + tt) * 4096 + 16 * ((4 * s4 + qd) ^ qi)); } while (0)
#define ATT_QK(src, t0) do { _Pragma("unroll") for (int tt = 0; tt < 3; ++tt) { f32x4 a_ = (f32x4){0.f, 0.f, 0.f, 0.f}; \
            _Pragma("unroll") for (int s4 = 0; s4 < 4; ++s4) a_ = __builtin_amdgcn_mfma_f32_16x16x32_bf16(src[tt][s4], qf[s4], a_, 0, 0, 0); sa[(t0) + tt] = a_; } } while (0)
        ATT_LDK(kfA, 0); ATT_LDK(kfB, 3); __builtin_amdgcn_sched_barrier(0);
        ATT_QK(kfA, 0); __builtin_amdgcn_sched_barrier(0);
        ATT_LDK(kfA, 6); __builtin_amdgcn_sched_barrier(0);
        ATT_QK(kfB, 3); __builtin_amdgcn_sched_barrier(0);
        ATT_QK(kfA, 6);
#undef ATT_LDK
#undef ATT_QK
        __builtin_amdgcn_sched_barrier(0);
        ATT_BAR();
        __builtin_amdgcn_sched_barrier(0);
        float bvn = 0.f;
        if (has_next) { const AttnU un = attn_decode(ui + G);
            bvn = relb[t5_bucket(tb * un.d) * 12 + un.head]; __builtin_amdgcn_sched_barrier(0);
            attn_ld_q(Z, un, wave, qi, qd, qf); __builtin_amdgcn_sched_barrier(0);
            attn_dma_k(Z, un, kbuf, wave, lane); }
        __builtin_amdgcn_sched_barrier(0);
        float bs[9][4];
#pragma unroll
        for (int t = 0; t < 9; ++t)
#pragma unroll
            for (int rr = 0; rr < 4; ++rr) { const int e = qi - 4 * qd - rr;
                bs[t][rr] = btab[t == 0 ? (e > 0 ? 128 : 128 + e) : (t == 8 ? (e < 0 ? 0 : e) : 128 - 16 * t + e)]; }
        __builtin_amdgcn_sched_barrier(0);
        float mx = -__builtin_inff();
#pragma unroll
        for (int t = 0; t < 9; ++t)
#pragma unroll
            for (int rr = 0; rr < 4; ++rr) { const int e = qi - 4 * qd - rr;
                const bool valid = (t == 0 ? e <= 0 : (t == 8 ? e >= 0 : true)) && (n > 0 || wave + t >= 8);
                const float sc = valid ? sa[t][rr] * C2 + bs[t][rr] : -__builtin_inff();
                sa[t][rr] = sc; mx = fmaxf(mx, sc); }
        mx = fmaxf(mx, __shfl_xor(mx, 16)); mx = fmaxf(mx, __shfl_xor(mx, 32));
        float sum = 0.f;
#pragma unroll
        for (int t = 0; t < 9; ++t)
#pragma unroll
            for (int rr = 0; rr < 4; ++rr) { const float p = __builtin_amdgcn_exp2f(sa[t][rr] - mx); sa[t][rr] = p; sum += p; }
        sum += __shfl_xor(sum, 16); sum += __shfl_xor(sum, 32);
        __builtin_amdgcn_sched_barrier(0);
        if (has_next) asm volatile("s_waitcnt vmcnt(13)" ::: "memory");
        else asm volatile("s_waitcnt vmcnt(0)" ::: "memory");
        ATT_BAR();
        __builtin_amdgcn_sched_barrier(0);
        f32x4 o[8];
#pragma unroll
        for (int dt = 0; dt < 8; ++dt) o[dt] = (f32x4){0.f, 0.f, 0.f, 0.f};
        const LAS unsigned char* vrow = vbuf + (16 * wave + trrow) * 256 + 8 * (trp & 1);
#pragma unroll
        for (int t = 0; t < 9; ++t) { v2u pw; pw.x = pk2(sa[t][0], sa[t][1]); pw.y = pk2(sa[t][2], sa[t][3]); const bf16x4 pf = __builtin_bit_cast(bf16x4, pw);
            bf16x4 vf[8];
#pragma unroll
            for (int dt = 0; dt < 8; ++dt) vf[dt] = __builtin_amdgcn_ds_read_tr16_b64_v4i16((LAS bf16x4*)(vrow + t * 4096 + 16 * ((2 * dt + (trp >> 1)) ^ trswz)));
            __builtin_amdgcn_sched_barrier(0);
#pragma unroll
            for (int dt = 0; dt < 8; ++dt) o[dt] = __builtin_amdgcn_mfma_f32_16x16x16bf16_1k(vf[dt], pf, o[dt], 0, 0, 0); }
        __builtin_amdgcn_sched_barrier(0);
        ATT_BAR();
        __builtin_amdgcn_sched_barrier(0);
        asm volatile("" : "+v"(bvn));
        if (has_next && tid < 129) btabn[tid] = bvn * 1.4426950408889634f;
        __builtin_amdgcn_sched_barrier(0);
        const float inv = 1.0f / sum;
        bf16* op = OG + ((size_t)g * M + rowq) * 512 + hh * 128 + 4 * qd;
#pragma unroll
        for (int dt = 0; dt < 8; ++dt) { v2u w; w.x = pk2(o[dt][0] * inv, o[dt][1] * inv); w.y = pk2(o[dt][2] * inv, o[dt][3] * inv); *(GAS v2u*)(op + 16 * dt) = w; }
        if (qd == 0) LSE[((size_t)g * M + rowq) * 4 + hh] = (mx + __builtin_amdgcn_logf(sum)) * 0.6931471805599453f;
        __builtin_amdgcn_sched_barrier(0);
        if (has_next) { const AttnU un = attn_decode(ui + G); attn_dma_v(Z, un, vbuf, wave, lane); }
        __builtin_amdgcn_sched_barrier(0);
    }
    asm volatile("s_waitcnt vmcnt(0)" ::: "memory"); __syncthreads();
}
template <int K> __device__ __forceinline__ float row_shr(float x) { return __int_as_float(__builtin_amdgcn_update_dpp(0, __float_as_int(x), 0x110 + K, 0xF, 0xF, true)); }
template <int K> __device__ __forceinline__ float row_shl(float x) { return __int_as_float(__builtin_amdgcn_update_dpp(0, __float_as_int(x), 0x100 + K, 0xF, 0xF, true)); }
template <int SZ>
__device__ __forceinline__ void pool_window(const bf16* Z, int g, int tile, int lane, bf16x8 (&yf)[4]) {
    static_assert(SZ == 2 || SZ == 4 || SZ == 8 || SZ == 16, "window");
    const int qi = lane & 15, qd = lane >> 4, row = tile * 16 + qi, tseq = row & (SEQ - 1); const int cnt = (tseq + 1 < SZ) ? tseq + 1 : SZ;
    const float rc = 1.0f / (float)cnt; const bool hasprev = ((tile * 16) & (SEQ - 1)) != 0;
    v4u cw[4], pw[4];
#pragma unroll
    for (int s4 = 0; s4 < 4; ++s4) { const bf16* zp = Z + (size_t)row * INW + ZP + 128 * g + 32 * s4 + 8 * qd;
        cw[s4] = *(const GAS v4u*)zp; pw[s4] = *(const GAS v4u*)(zp - (hasprev ? (size_t)16 * INW : (size_t)0)); }
    __builtin_amdgcn_sched_barrier(0);
#pragma unroll
    for (int s4 = 0; s4 < 4; ++s4) {
        const float c[8] = {bflo(cw[s4].x), bfhi(cw[s4].x), bflo(cw[s4].y), bfhi(cw[s4].y), bflo(cw[s4].z), bfhi(cw[s4].z), bflo(cw[s4].w), bfhi(cw[s4].w)};
        const float p[8] = {bflo(pw[s4].x), bfhi(pw[s4].x), bflo(pw[s4].y), bfhi(pw[s4].y), bflo(pw[s4].z), bfhi(pw[s4].z), bflo(pw[s4].w), bfhi(pw[s4].w)};
        float y[8];
#pragma unroll
        for (int e = 0; e < 8; ++e) {
            float Pc = c[e]; Pc += row_shr<1>(Pc); Pc += row_shr<2>(Pc); Pc += row_shr<4>(Pc); Pc += row_shr<8>(Pc);
            float Sp = hasprev ? p[e] : 0.f; Sp += row_shl<1>(Sp); Sp += row_shl<2>(Sp); Sp += row_shl<4>(Sp); Sp += row_shl<8>(Sp);
            float w = Pc + row_shl<17 - SZ>(Sp);
            if (SZ < 16) w -= row_shr<(SZ < 16 ? SZ : 1)>(Pc);
            y[e] = w * rc - c[e]; }
        v4u yw; yw.x = pk2(y[0], y[1]); yw.y = pk2(y[2], y[3]); yw.z = pk2(y[4], y[5]); yw.w = pk2(y[6], y[7]);
        yf[s4] = __builtin_bit_cast(bf16x8, yw); }
}
__device__ __forceinline__ void pool_mma(const bf16* WPt, const float* pscale, bf16* OP, int g, int tile, int lane, const bf16x8 (&yf)[4]) {
    const int qi = lane & 15, qd = lane >> 4, row = tile * 16 + qi;
#pragma unroll
    for (int h = 0; h < 2; ++h) {
        bf16x8 wf[4][4]; f32x4 ps[4];
#pragma unroll
        for (int k = 0; k < 4; ++k) { const int nt = 4 * h + k; const bf16* wp = WPt + ((size_t)g * 128 + 16 * nt + qi) * 128 + 8 * qd;
#pragma unroll
            for (int s4 = 0; s4 < 4; ++s4) wf[k][s4] = *(const GAS bf16x8*)(wp + 32 * s4);
            ps[k] = *(const GAS f32x4*)(pscale + 128 * g + 16 * nt + 4 * qd); }
        __builtin_amdgcn_sched_barrier(0);
#pragma unroll
        for (int k = 0; k < 4; ++k) { const int nt = 4 * h + k; f32x4 acc = (f32x4){0.f, 0.f, 0.f, 0.f};
#pragma unroll
            for (int s4 = 0; s4 < 4; ++s4) acc = __builtin_amdgcn_mfma_f32_16x16x32_bf16(wf[k][s4], yf[s4], acc, 0, 0, 0);
            v2u w; w.x = pk2(acc[0] * ps[k][0], acc[1] * ps[k][1]); w.y = pk2(acc[2] * ps[k][2], acc[3] * ps[k][3]);
            *(GAS v2u*)(OP + (size_t)row * 512 + 128 * g + 16 * nt + 4 * qd) = w; }
        __builtin_amdgcn_sched_barrier(0);
    }
}
__device__ __forceinline__ void combine_pool_phase(const bf16* Z, const bf16* OG, const float* LSE, const bf16* WPt, const float* pscale, bf16* OA, bf16* OP, int gw, int NGW, int lane) {
#pragma unroll 1
    for (int task = gw; task < (M / 16) * 4; task += NGW) { const int g = 3 - (task & 3), tile = task >> 2;
        bf16x8 yf[4];
        if (g == 3) pool_window<16>(Z, 3, tile, lane, yf); else if (g == 2) pool_window<8>(Z, 2, tile, lane, yf);
        else if (g == 1) pool_window<4>(Z, 1, tile, lane, yf); else pool_window<2>(Z, 0, tile, lane, yf);
        pool_mma(WPt, pscale, OP, g, tile, lane, yf); }
    const int hh = lane >> 4;
#pragma unroll 1
    for (int m0 = gw; m0 < M; m0 += 4 * NGW) {
        v4u a[4], b[4], c[4]; float l0[4], l1[4], l2[4];
#pragma unroll
        for (int k = 0; k < 4; ++k) { const int m = m0 + k * NGW; if (m < M) {
            l0[k] = LSE[(size_t)m * 4 + hh]; l1[k] = LSE[((size_t)M + m) * 4 + hh]; l2[k] = LSE[((size_t)2 * M + m) * 4 + hh];
            a[k] = *(const GAS v4u*)(OG + (size_t)m * 512 + lane * 8); b[k] = *(const GAS v4u*)(OG + ((size_t)M + m) * 512 + lane * 8); c[k] = *(const GAS v4u*)(OG + ((size_t)2 * M + m) * 512 + lane * 8); } }
#pragma unroll
        for (int k = 0; k < 4; ++k) { const int m = m0 + k * NGW; if (m < M) {
            const float mx = fmaxf(l0[k], fmaxf(l1[k], l2[k])); const float e0 = __expf(l0[k] - mx), e1 = __expf(l1[k] - mx), e2 = __expf(l2[k] - mx); const float inv = 1.0f / (e0 + e1 + e2);
            const float w0 = e0 * inv, w1 = e1 * inv, w2 = e2 * inv; const v4u A = a[k], B = b[k], C = c[k];
            v4u o;
            o.x = pk2(w0 * bflo(A.x) + w1 * bflo(B.x) + w2 * bflo(C.x), w0 * bfhi(A.x) + w1 * bfhi(B.x) + w2 * bfhi(C.x));
            o.y = pk2(w0 * bflo(A.y) + w1 * bflo(B.y) + w2 * bflo(C.y), w0 * bfhi(A.y) + w1 * bfhi(B.y) + w2 * bfhi(C.y));
            o.z = pk2(w0 * bflo(A.z) + w1 * bflo(B.z) + w2 * bflo(C.z), w0 * bfhi(A.z) + w1 * bfhi(B.z) + w2 * bfhi(C.z));
            o.w = pk2(w0 * bflo(A.w) + w1 * bflo(B.w) + w2 * bflo(C.w), w0 * bfhi(A.w) + w1 * bfhi(B.w) + w2 * bfhi(C.w));
            *(GAS v4u*)(OA + (size_t)m * 512 + lane * 8) = o; } }
    }
}
struct Args { const float* in[16]; float* out; unsigned char* ws; int ph_lo, ph_hi; };
__global__ void __launch_bounds__(NWAVES * 64, 2) mk_fwd(Args args) {
    extern __shared__ __attribute__((aligned(16))) unsigned char lds_raw[];
    LAS unsigned char* lds = (LAS unsigned char*)lds_raw;
    volatile LAS unsigned* MISC = (volatile LAS unsigned*)(lds + MISC_OFF);
    LAS int* tab = (LAS int*)(lds + TAB_OFF);
    const int tid = threadIdx.x, lane = tid & 63, wave = __builtin_amdgcn_readfirstlane(tid >> 6);
    const int G = gridDim.x; const int bx = blockIdx.x; const int vcu = (G % 8 == 0) ? (bx % 8) * (G / 8) + bx / 8 : bx;
    const int gw = vcu * NWAVES + wave, NGW = G * NWAVES;
    Ptrs P;
    P.x = args.in[0]; P.w_in = args.in[1]; P.relb = args.in[2]; P.w_pool = args.in[3]; P.pscale = args.in[4]; P.w_ao = args.in[5]; P.w_po = args.in[6]; P.w_out = args.in[7];
    P.gains = args.in[8]; P.dwg = args.in[9]; P.dwu = args.in[10]; P.dwd = args.in[11]; P.wr = args.in[12]; P.mwg = args.in[13]; P.mwu = args.in[14]; P.mwd = args.in[15];
    P.out = args.out; P.ws = args.ws;
    unsigned char* ws = args.ws;
    gu32* ctl = (gu32*)(ws + WS_CTL);
    bf16* XN = (bf16*)(ws + WS_XN); bf16* Z = (bf16*)(ws + WS_Z); bf16* OG = (bf16*)(ws + WS_OG); bf16* OA = (bf16*)(ws + WS_OA); bf16* OP = (bf16*)(ws + WS_OP);
    bf16* TB = (bf16*)(ws + WS_T); bf16* MRG = (bf16*)(ws + WS_MRG); bf16* MIXb = (bf16*)(ws + WS_MIX); float* LSE = (float*)(ws + WS_LSE);
    bf16* HB = (bf16*)(ws + WS_HB);
    int* toke = (int*)(ws + WS_TOKE); int* tokp = (int*)(ws + WS_TOKP); float* tokw = (float*)(ws + WS_TOKW);
    for (int u = tid; u < (LDS_BYTES - LDSCTL_OFF) / 4; u += NWAVES * 64) ((LAS unsigned*)(lds + LDSCTL_OFF))[u] = 0u;
    __syncthreads();
    XcdBarrier bar; bar.bar = (unsigned*)(ctl + CW_BAR); bar.x = 0; bar.st = nullptr;
    if (!MK_SPLIT) bar = xcd_barrier_post((unsigned*)(ctl + CW_BAR), MISC + 8);
    const int lo = args.ph_lo, hi = args.ph_hi;
#define IN(k) (lo <= (k) && (k) < hi)
#define SEAM(k) do { if (IN(k) && IN((k) + 1)) xcd_barrier(bar); } while (0)
#define FRESH() int tid_ = threadIdx.x; asm volatile("" : "+v"(tid_)); const int lane_ = tid_ & 63, wave_ = __builtin_amdgcn_readfirstlane(tid_ >> 6), gw_ = vcu * NWAVES + wave_; (void)lane_; (void)wave_; (void)gw_

    if (IN(0)) { FRESH(); p0_convert(P, lds, gw_, NGW, wave_, lane_); norm_first(P.x, P.gains, XN, ws + WS_XN8, gw_, NGW, lane_); }
    SEAM(0);
    for (int layer = 0; layer < 2; ++layer) {
        const int pb = layer == 0 ? 1 : 10;
        const float* gl = P.gains + (size_t)layer * 4 * DM;
        if (IN(pb + 0)) {
            const bool conv_first = layer == 0 && ((bx >> 3) & 1) != 0, conv_last = layer == 0 && ((bx >> 3) & 1) == 0;
            if (conv_first) { FRESH(); conv_share_a(P, lds, gw_, NGW, wave_, lane_); __syncthreads(); }
            { pg8::Gemm g{XN, (const bf16*)(ws + WS_WIN) + (size_t)layer * INW * DM + (size_t)ZV * DM, M, ZGA - ZV, DM, 0}; pg8::StaticOrder S; S.init(M, ZGA - ZV, G, bx);
              pg8::EpiZ E{Z, INW, ZV, 1.0f, 1000, 0};
              pg8::gemm_phase<pg8::EpiZ, pg8::StaticOrder, true, true>(lds + RING_OFF, g, S, E); }
            { pg8::Gemm g{(const bf16*)(ws + WS_XN8), (const bf16*)(ws + WS_WIN8) + (size_t)layer * 3584 * DM, M, 7168, DM / 2, 0}; pg8::StaticOrder S; S.init(M, 7168, G, bx);
              pg8::EpiZ E{Z, INW, 0, 1.0f / WSCALE, 12, ZGA - 3072};
              pg8::gemm_phase<pg8::EpiZ, pg8::StaticOrder, true, true, true>(lds + RING_OFF, g, S, E); }
            if (QW > 0 && bx >= 128) { FRESH(); conv_quota(P, lds, layer ? 2 : 0, bx, wave_, lane_); }
            if (conv_last) { FRESH(); conv_share_a(P, lds, gw_, NGW, wave_, lane_); }
        }
        SEAM(pb + 0);
        if (IN(pb + 1)) { FRESH(); attn_phase(Z, P.relb, OG, LSE, lds, G, tid_, wave_, lane_); }
        SEAM(pb + 1);
        if (IN(pb + 2)) { FRESH(); combine_pool_phase(Z, OG, LSE, (const bf16*)(ws + WS_WPOOL) + (size_t)layer * 4 * 128 * 128, P.pscale + (size_t)layer * 512, OA, OP, gw_, NGW, lane_); }
        SEAM(pb + 2);
        if (IN(pb + 3)) {
            { pg8::Gemm g{OA, (const bf16*)(ws + WS_WAO) + (size_t)layer * DM * 512, M, DM, 512}; pg8::StaticOrder S; S.init(M, DM, G, bx);
              pg8::EpiGate<0> E{Z + ZGA, INW, nullptr, TB, DM};
              pg8::gemm_phase<pg8::EpiGate<0>, pg8::StaticOrder, true, true>(lds + RING_OFF, g, S, E); }
            { pg8::Gemm g{OP, (const bf16*)(ws + WS_WPO) + (size_t)layer * DM * 512, M, DM, 512}; pg8::StaticOrder S; S.init(M, DM, G, bx);
              pg8::EpiGate<1> E{Z + ZGB, INW, TB, MRG, DM};
              pg8::gemm_phase<pg8::EpiGate<1>, pg8::StaticOrder, true, true>(lds + RING_OFF, g, S, E); }
        }
        SEAM(pb + 3);
        if (IN(pb + 4)) {
            pg8::Gemm g{MRG, (const bf16*)(ws + WS_WOUT) + (size_t)layer * DM * DM, M, DM, DM}; pg8::StaticOrder S; S.init(M, DM, G, bx);
            pg8::EpiZ E{MIXb, DM, 0, 1.0f, 1000, 0};
            pg8::gemm_phase<pg8::EpiZ, pg8::StaticOrder, true, true>(lds + RING_OFF, g, S, E);
        }
        SEAM(pb + 4);
        if (IN(pb + 5)) {
            FRESH();
            if (layer == 0) norm_mid<false, false>(MIXb, P.x, HB, gl + DM, gl + 2 * DM, nullptr, ws + WS_XN8, nullptr, ctl, toke, tokp, tokw, nullptr, gw_, NGW, lane_);
            else {
                LAS float* wrl = (LAS float*)(lds + RING_OFF);
                { float tmp[32];
#pragma unroll
                  for (int k = 0; k < 32; ++k) tmp[k] = P.wr[tid_ + 512 * k];
                  __builtin_amdgcn_sched_barrier(0);
#pragma unroll
                  for (int k = 0; k < 32; ++k) { const int i = tid_ + 512 * k; wrl[(i & 7) * DM + (i >> 3)] = tmp[k]; } }
                __syncthreads();
                norm_mid<true, true>(MIXb, HB, HB, gl + DM, gl + 2 * DM, XN, nullptr, wrl, ctl, toke, tokp, tokw, ws + WS_XP, gw_, NGW, lane_);
            }
        }
        SEAM(pb + 5);
        if (layer == 0) {
            if (IN(7)) {
                pg8::Gemm g{(const bf16*)(ws + WS_XN8), (const bf16*)(ws + WS_DGU), M, 2 * DFF, DM / 2}; pg8::StaticOrder S; S.init(M, 2 * DFF, G, bx);
                pg8::EpiSwiGLU E{(bf16*)(ws + WS_HM), DFF, 1.0f / WSCALE};
                pg8::gemm_phase<pg8::EpiSwiGLU, pg8::StaticOrder, true, true, true>(lds + RING_OFF, g, S, E);
                if (QW > 0 && bx >= 128) { FRESH(); conv_quota(P, lds, 1, bx, wave_, lane_); }
            }
            SEAM(7);
            if (IN(8)) {
                pg8::Gemm g{(const bf16*)(ws + WS_HM), (const bf16*)(ws + WS_DD), M, DM, DFF}; pg8::StaticOrder S; S.init(M, DM, G, bx);
                pg8::EpiZ E{MIXb, DM, 0, 1.0f, 1000, 0};
                const bool conv_first = ((bx >> 3) & 1) != 0;
                if (conv_first) { FRESH(); conv_share_gu(P, lds, gw_, NGW, wave_, lane_); __syncthreads(); }
                pg8::gemm_phase<pg8::EpiZ, pg8::StaticOrder, true, true>(lds + RING_OFF, g, S, E);
                if (!conv_first) { FRESH(); conv_share_gu(P, lds, gw_, NGW, wave_, lane_); }
            }
            SEAM(8);
            if (IN(9)) { FRESH(); norm_mid<false, true>(MIXb, HB, HB, P.gains + 3 * DM, P.gains + 4 * DM, XN, ws + WS_XN8, nullptr, ctl, toke, tokp, tokw, nullptr, gw_, NGW, lane_); }
            SEAM(9);
        } else {
            unsigned char* Xp = ws + WS_XP; unsigned char* HMp = ws + WS_HMP; bf16* Yp = (bf16*)(ws + WS_YP);
            if (IN(16)) { FRESH(); moe_tables(ctl, tab, tid_); }
            if (IN(17)) {
                if (MK_SPLIT) moe_tables(ctl, tab, tid);
                pg8::Gemm g{(const bf16*)Xp, (const bf16*)(ws + WS_MGU), MPAD, 2 * EFF, DM / 2}; pg8::MoeOrder S{__builtin_amdgcn_readfirstlane(tab[96]), (2 * EFF) / 256, G, bx, tab, XCAP / 256, 0, (2 * EFF) / 256, 0};
                pg8::EpiSwiGLU8 E{HMp, EFF, 1.0f / WSCALE};
                const int cut = 2 * ((bx >> 3) & 7);
#pragma unroll 1
                for (int part = 0; part < 2; ++part) {
                    pg8::SubOrder<pg8::MoeOrder> S2{S, part ? cut : 0, part ? (1 << 30) : cut};
                    pg8::gemm_phase<pg8::EpiSwiGLU8, pg8::SubOrder<pg8::MoeOrder>, true, true, true>(lds + RING_OFF, g, S2, E);
                    if (part == 0) { FRESH(); __syncthreads(); conv_share_down(P, lds, gw_, NGW, wave_, lane_); __syncthreads(); }
                }
            }
            SEAM(17);
            if (IN(18)) {
                if (MK_SPLIT) moe_tables(ctl, tab, tid);
                const int Pall = __builtin_amdgcn_readfirstlane(tab[96]), Pmain = Pall & ~31;
                pg8::EpiYp E{Yp, DM, 1.0f / WSCALE, (bf16*)(ws + WS_YT), Pmain};
                { pg8::Gemm g{(const bf16*)HMp, (const bf16*)(ws + WS_MD), MPAD, DM, EFF / 2, 0}; pg8::MoeOrder S{Pmain, DM / 256, G, bx, tab, 0, 0, DM / 256, 0};
                  pg8::gemm_phase<pg8::EpiYp, pg8::MoeOrder, true, true, true>(lds + RING_OFF, g, S, E); }
                if (Pall > Pmain) {
                  pg8::Gemm g{(const bf16*)HMp, (const bf16*)(ws + WS_MD), MPAD, DM, EFF / 8, EFF / 2}; pg8::MoeOrder S{Pall - Pmain, 4 * (DM / 256), G, bx, tab, 0, Pmain, DM / 256, EFF / 4};
                  pg8::gemm_phase<pg8::EpiYp, pg8::MoeOrder, true, true, true>(lds + RING_OFF, g, S, E); }
            }
            SEAM(18);
            if (IN(19)) {
                FRESH();
                if (MK_SPLIT) moe_tables(ctl, tab, tid_);
                norm_final(Yp, (const bf16*)(ws + WS_YT), P.gains + (size_t)(4 + 3) * DM, HB, P.out, toke, tokp, tokw, tab, gw_, NGW, lane_);
            }
        }
    }
#undef IN
#undef SEAM
}

extern "C" void kernel_launch(void* const* d_in, const int* in_sizes, int n_in, void* d_out, int out_size, void* d_ws, size_t ws_size, hipStream_t stream) {
    static int grid = 0;
    if (grid == 0) {
        if (n_in != 16 || out_size != M * DM || ws_size < WS_END) { fprintf(stderr, "kernel_launch: unexpected shapes (n_in %d out %d ws %zu, need %zu)\n", n_in, out_size, ws_size, (size_t)WS_END); grid = -1; return; }
        int dev = 0, cus = 0, per_cu = 0;
        if (hipGetDevice(&dev) != hipSuccess || hipDeviceGetAttribute(&cus, hipDeviceAttributeMultiprocessorCount, dev) != hipSuccess) { grid = -1; return; }
        if (hipFuncSetAttribute((const void*)mk_fwd, hipFuncAttributeMaxDynamicSharedMemorySize, LDS_BYTES) != hipSuccess) { fprintf(stderr, "kernel_launch: hipFuncSetAttribute failed\n"); grid = -1; return; }
        if (hipOccupancyMaxActiveBlocksPerMultiprocessor(&per_cu, (const void*)mk_fwd, NWAVES * 64, LDS_BYTES) != hipSuccess || per_cu < 1) { fprintf(stderr, "kernel_launch: occupancy query says %d\n", per_cu); }
        (void)hipGetLastError();
        if (cus < 256) { fprintf(stderr, "kernel_launch: built for a 256-CU device (got %d CUs)\n", cus); grid = -1; return; }
        grid = 256;
    }
    if (grid < 0) return;
    if (hipMemsetAsync((char*)d_ws + WS_CTL, 0, CTL_ZERO_BYTES, stream) != hipSuccess) return;
    Args a{};
    for (int i = 0; i < 16; ++i) a.in[i] = (const float*)d_in[i];
    a.out = (float*)d_out; a.ws = (unsigned char*)d_ws;
#if MK_SPLIT
    for (int ph = 0; ph < NPH; ++ph) { a.ph_lo = ph; a.ph_hi = ph + 1; hipLaunchKernelGGL(mk_fwd, dim3(grid), dim3(NWAVES * 64), LDS_BYTES, stream, a); }
#else
    a.ph_lo = 0; a.ph_hi = NPH;
    hipLaunchKernelGGL(mk_fwd, dim3(grid), dim3(NWAVES * 64), LDS_BYTES, stream, a);
#endif
    const hipError_t le = hipPeekAtLastError();
    if (le != hipSuccess) fprintf(stderr, "kernel_launch: launch failed: %s\n", hipGetErrorName(le));
}
```

```cpp
#include <hip/hip_runtime.h>
#include <cstdio>
#include <cstdint>
#ifndef MK_SPLIT
#define MK_SPLIT 0
#endif
namespace pg8 {
#define PG8_LAS __attribute__((address_space(3)))
typedef unsigned short bf16_t;
typedef short bf16x8 __attribute__((ext_vector_type(8)));
typedef float f32x4 __attribute__((ext_vector_type(4)));
typedef unsigned u32x4 __attribute__((ext_vector_type(4)));
typedef int i32x4 __attribute__((ext_vector_type(4)));
typedef int i32x8 __attribute__((ext_vector_type(8)));
constexpr int BM = 256, BK = 64, HALF = 128, HTB = HALF * BK * 2  , STAGE_BYTES = 8 * HTB, NXCD = 8, WGM = 8;

__host__ __device__ __forceinline__ int lds_byte(int r, int c) { const int st = (r >> 4) * 2 + (c >> 5), rr = r & 15, cc = c & 31, ob = rr * 64 + cc * 2; return st * 1024 + (ob ^ (((ob >> 9) & 1) << 5)); }
__host__ __device__ __forceinline__ void stage_rc(int b, int& R, int& C) { const int st = b / 1024, sb = b % 1024, swz = sb ^ (((sb >> 9) & 1) << 5); R = (st >> 1) * 16 + swz / 64; C = (st & 1) * 32 + (swz % 64) / 2; }
__host__ __device__ __forceinline__ int perm32(int rho) { const int n = rho >> 4, i = rho & 15; return 8 * (i >> 2) + 4 * n + (i & 3); }

struct Unit { int pm, pn, pb, ko, ks, pa; };
struct Gemm { const bf16_t* A; const bf16_t* Bt; int M, N, K, ld; };

struct StaticOrder {
    int nM, nN, nwg, G, c;
    __host__ __device__ void init(int M, int N, int G_, int c_) { nM = M / BM; nN = N / BM; nwg = nM * nN; G = G_; c = c_; }
    __host__ __device__ bool next(int i, Unit& u) const {
        const long L = (long)i * G + c; if (L >= nwg) return false;
        int wgid = (int)L; { const int q = nwg / NXCD, r = nwg % NXCD, xcd = wgid % NXCD, off = wgid / NXCD; wgid = (xcd < r ? xcd * (q + 1) : r * (q + 1) + (xcd - r) * q) + off; }
        const int nig = WGM * nN, gid = wgid / nig, fm = gid * WGM, gsz = (nM - fm) < WGM ? (nM - fm) : WGM;
        u.pm = fm + ((wgid % nig) % gsz); u.pn = (wgid % nig) / gsz; u.pb = u.pn; u.ko = 0; u.ks = 0; u.pa = u.pm; return true;
    }
    __device__ __forceinline__ void a_ready(const Unit&) const {}
    __device__ __forceinline__ void done(const Unit&) const {}
};

typedef __bf16 bf16x2_t __attribute__((ext_vector_type(2)));
__device__ __forceinline__ unsigned cvt_pk_bf16(float lo, float hi) { typedef float f32x2v __attribute__((ext_vector_type(2))); const f32x2v v = {lo, hi}; return __builtin_bit_cast(unsigned, __builtin_convertvector(v, bf16x2_t)); }
typedef float f32x2 __attribute__((ext_vector_type(2)));
__device__ __forceinline__ f32x2 gelu_pk(f32x2 v) {
    const f32x2 av = __builtin_elementwise_abs(v), d = av * 0.2316418882f + 1.0f;
    f32x2 t; t.x = __builtin_amdgcn_rcpf(d.x); t.y = __builtin_amdgcn_rcpf(d.y);
    f32x2 q = t * 0.5307027145f + (-0.7265760135f); q = q * t + 0.7107068705f; q = q * t + (-0.142248368f); q = q * t + 0.127414796f; q = q * t;
    const f32x2 s = (v * v) * (-0.72134752044f);
    f32x2 e; e.x = __builtin_amdgcn_exp2f(s.x); e.y = __builtin_amdgcn_exp2f(s.y);
    const f32x2 m = v * (q * e), r = v - m;
    f32x2 o; o.x = v.x < 0.f ? m.x : r.x; o.y = v.y < 0.f ? m.y : r.y; return o;
}

__device__ __forceinline__ f32x2 sigmoid_pk(f32x2 x, float c1) { const f32x2 t = x * c1; f32x2 e; e.x = __builtin_amdgcn_exp2f(t.x); e.y = __builtin_amdgcn_exp2f(t.y); const f32x2 d = e + 1.0f;
    f32x2 r; r.x = __builtin_amdgcn_rcpf(d.x); r.y = __builtin_amdgcn_rcpf(d.y); return r; }
__device__ __forceinline__ f32x2 swiglu_pk(f32x2 a, f32x2 b, float c1, float k2) { return (a * b) * (sigmoid_pk(a, c1) * k2); }
__device__ __forceinline__ float sigmoid_f(float v) { return __builtin_amdgcn_rcpf(1.0f + __builtin_amdgcn_exp2f(-1.4426950408889634f * v)); }
__device__ __forceinline__ float bf_lo(unsigned w) { return __uint_as_float(w << 16); }
__device__ __forceinline__ float bf_hi(unsigned w) { return __uint_as_float(w & 0xffff0000u); }
struct EpiZ {
    static constexpr bool PERM = true, AFTER_DRAIN = false;
    bf16_t* O; int ldc; int col_off; float sc; int sig_from; int gap;
    __device__ __forceinline__ void operator()(const f32x4 (&acc)[2][2][4][2], const Unit& u, int wr, int wc, int fr, int fq) const {
        const bool sg = u.pn >= sig_from;
        const int row0 = u.pm * BM + wr * 64 + fr, col0 = col_off + u.pn * BM + (sg ? gap : 0) + wc * 32 + 8 * fq;
#pragma unroll
        for (int ai = 0; ai < 2; ++ai)
#pragma unroll
            for (int m = 0; m < 4; ++m) { bf16_t* rowp = O + (size_t)(row0 + ai * HALF + m * 16) * ldc + col0;
#pragma unroll
                for (int bj = 0; bj < 2; ++bj) { f32x4 v0, v1;
                    if (sg) { const float c1 = -1.4426950408889634f * sc; const f32x4 x0 = acc[ai][bj][m][0], x1 = acc[ai][bj][m][1];
                        const f32x2 a = sigmoid_pk((f32x2){x0[0], x0[1]}, c1), b = sigmoid_pk((f32x2){x0[2], x0[3]}, c1), c = sigmoid_pk((f32x2){x1[0], x1[1]}, c1), d = sigmoid_pk((f32x2){x1[2], x1[3]}, c1);
                        v0 = (f32x4){a.x, a.y, b.x, b.y}; v1 = (f32x4){c.x, c.y, d.x, d.y}; }
                    else { v0 = acc[ai][bj][m][0] * sc; v1 = acc[ai][bj][m][1] * sc; }
                    u32x4 w; w.x = cvt_pk_bf16(v0[0], v0[1]); w.y = cvt_pk_bf16(v0[2], v0[3]); w.z = cvt_pk_bf16(v1[0], v1[1]); w.w = cvt_pk_bf16(v1[2], v1[3]);
                    *(u32x4*)(rowp + bj * HALF) = w; } }
    }
};
template <int MODE> struct EpiGate {
    static constexpr bool PERM = true, AFTER_DRAIN = false;
    const bf16_t* G; int ldg; const bf16_t* Tin; bf16_t* O; int ldc;
    __device__ __forceinline__ void operator()(const f32x4 (&acc)[2][2][4][2], const Unit& u, int wr, int wc, int fr, int fq) const {
        const int row0 = u.pm * BM + wr * 64 + fr, col0 = u.pn * BM + wc * 32 + 8 * fq;
#pragma unroll
        for (int ai = 0; ai < 2; ++ai)
#pragma unroll
          for (int mh = 0; mh < 2; ++mh) {
            u32x4 gw[2][2], tw[2][2];
#pragma unroll
            for (int mm = 0; mm < 2; ++mm)
#pragma unroll
                for (int bj = 0; bj < 2; ++bj) { const size_t row = (size_t)(row0 + ai * HALF + (2 * mh + mm) * 16); const int col = col0 + bj * HALF;
                    gw[mm][bj] = *(const u32x4*)(G + row * ldg + col); if (MODE == 1) tw[mm][bj] = *(const u32x4*)(Tin + row * ldc + col); }
            __builtin_amdgcn_sched_barrier(0);
#pragma unroll
            for (int mm = 0; mm < 2; ++mm)
#pragma unroll
                for (int bj = 0; bj < 2; ++bj) { const int m = 2 * mh + mm; const size_t row = (size_t)(row0 + ai * HALF + m * 16); const int col = col0 + bj * HALF; const u32x4 g4 = gw[mm][bj];
                    f32x4 v0 = acc[ai][bj][m][0], v1 = acc[ai][bj][m][1];
                    v0[0] *= bf_lo(g4.x); v0[1] *= bf_hi(g4.x); v0[2] *= bf_lo(g4.y); v0[3] *= bf_hi(g4.y);
                    v1[0] *= bf_lo(g4.z); v1[1] *= bf_hi(g4.z); v1[2] *= bf_lo(g4.w); v1[3] *= bf_hi(g4.w);
                    if (MODE == 1) { const u32x4 t4 = tw[mm][bj];
                        v0[0] += bf_lo(t4.x); v0[1] += bf_hi(t4.x); v0[2] += bf_lo(t4.y); v0[3] += bf_hi(t4.y);
                        v1[0] += bf_lo(t4.z); v1[1] += bf_hi(t4.z); v1[2] += bf_lo(t4.w); v1[3] += bf_hi(t4.w); }
                    u32x4 w; w.x = cvt_pk_bf16(v0[0], v0[1]); w.y = cvt_pk_bf16(v0[2], v0[3]); w.z = cvt_pk_bf16(v1[0], v1[1]); w.w = cvt_pk_bf16(v1[2], v1[3]);
                    *(u32x4*)(O + row * ldc + col) = w; }
            __builtin_amdgcn_sched_barrier(0);
          }
    }
};
struct EpiF32 {
    static constexpr bool PERM = false, AFTER_DRAIN = false;
    float* C; int ldc;
    __device__ __forceinline__ void operator()(const f32x4 (&acc)[2][2][4][2], const Unit& u, int wr, int wc, int fr, int fq) const {
        const int row0 = u.pm * BM + wr * 64 + fr, col0 = u.pn * BM + wc * 32 + 4 * fq;
#pragma unroll
        for (int ai = 0; ai < 2; ++ai)
#pragma unroll
            for (int m = 0; m < 4; ++m) { float* rowp = C + (size_t)(row0 + ai * HALF + m * 16) * ldc + col0;
#pragma unroll
                for (int bj = 0; bj < 2; ++bj)
#pragma unroll
                    for (int n = 0; n < 2; ++n) *(f32x4*)(rowp + bj * HALF + n * 16) = acc[ai][bj][m][n]; }
    }
};
struct EpiSwiGLU {
    static constexpr bool PERM = true, AFTER_DRAIN = false;
    bf16_t* O; int ldo; float sc;
    __device__ __forceinline__ void operator()(const f32x4 (&acc)[2][2][4][2], const Unit& u, int wr, int wc, int fr, int fq) const {
        const int row0 = u.pm * BM + wr * 64 + fr, col0 = u.pn * HALF + wc * 32 + 8 * fq;
#pragma unroll
        for (int ai = 0; ai < 2; ++ai)
#pragma unroll
            for (int m = 0; m < 4; ++m) { bf16_t* rowp = O + (size_t)(row0 + ai * HALF + m * 16) * ldo + col0;
                f32x4 v0, v1;
                { const f32x4 g0 = acc[ai][0][m][0], g1 = acc[ai][0][m][1], u0 = acc[ai][1][m][0], u1 = acc[ai][1][m][1]; const float c1 = -1.4426950408889634f * sc, k2 = sc * sc;
                  const f32x2 a = swiglu_pk((f32x2){g0[0], g0[1]}, (f32x2){u0[0], u0[1]}, c1, k2), b = swiglu_pk((f32x2){g0[2], g0[3]}, (f32x2){u0[2], u0[3]}, c1, k2),
                              c = swiglu_pk((f32x2){g1[0], g1[1]}, (f32x2){u1[0], u1[1]}, c1, k2), d = swiglu_pk((f32x2){g1[2], g1[3]}, (f32x2){u1[2], u1[3]}, c1, k2);
                  v0 = (f32x4){a.x, a.y, b.x, b.y}; v1 = (f32x4){c.x, c.y, d.x, d.y}; }
                u32x4 w; w.x = cvt_pk_bf16(v0[0], v0[1]); w.y = cvt_pk_bf16(v0[2], v0[3]); w.z = cvt_pk_bf16(v1[0], v1[1]); w.w = cvt_pk_bf16(v1[2], v1[3]);
                *(u32x4*)rowp = w; __builtin_amdgcn_sched_barrier(0); }
    }
};
__device__ __forceinline__ float clamp8(float v) { return __builtin_fminf(__builtin_fmaxf(v, -440.f), 440.f); }
__device__ __forceinline__ unsigned pack4_fp8(float a, float b, float c, float d) { int w = __builtin_amdgcn_cvt_pk_fp8_f32(clamp8(a), clamp8(b), 0, false); w = __builtin_amdgcn_cvt_pk_fp8_f32(clamp8(c), clamp8(d), w, true); return (unsigned)w; }
struct EpiSwiGLU8 {
    static constexpr bool PERM = true, AFTER_DRAIN = false;
    unsigned char* O; int ldo; float sc;
    __device__ __forceinline__ void operator()(const f32x4 (&acc)[2][2][4][2], const Unit& u, int wr, int wc, int fr, int fq) const {
        const int row0 = u.pm * BM + wr * 64 + fr, col0 = u.pn * HALF + wc * 32 + 8 * fq;
#pragma unroll
        for (int ai = 0; ai < 2; ++ai)
#pragma unroll
            for (int m = 0; m < 4; ++m) { unsigned char* rowp = O + (size_t)(row0 + ai * HALF + m * 16) * ldo + col0;
                f32x4 v0, v1;
                { const f32x4 g0 = acc[ai][0][m][0], g1 = acc[ai][0][m][1], u0 = acc[ai][1][m][0], u1 = acc[ai][1][m][1]; const float c1 = -1.4426950408889634f * sc, k2 = sc * sc;
                  const f32x2 a = swiglu_pk((f32x2){g0[0], g0[1]}, (f32x2){u0[0], u0[1]}, c1, k2), b = swiglu_pk((f32x2){g0[2], g0[3]}, (f32x2){u0[2], u0[3]}, c1, k2),
                              c = swiglu_pk((f32x2){g1[0], g1[1]}, (f32x2){u1[0], u1[1]}, c1, k2), d = swiglu_pk((f32x2){g1[2], g1[3]}, (f32x2){u1[2], u1[3]}, c1, k2);
                  v0 = (f32x4){a.x, a.y, b.x, b.y}; v1 = (f32x4){c.x, c.y, d.x, d.y}; }
                typedef unsigned u32x2 __attribute__((ext_vector_type(2)));
                u32x2 w; w.x = pack4_fp8(v0[0], v0[1], v0[2], v0[3]); w.y = pack4_fp8(v1[0], v1[1], v1[2], v1[3]);
                *(u32x2*)rowp = w; __builtin_amdgcn_sched_barrier(0); }
    }
};
struct EpiYp {
    static constexpr bool PERM = true, AFTER_DRAIN = false;
    bf16_t* C; int ldc; float sc; bf16_t* Ct; int pm0;
    __device__ __forceinline__ void operator()(const f32x4 (&acc)[2][2][4][2], const Unit& u, int wr, int wc, int fr, int fq) const {
        const int row0 = u.pm * BM + wr * 64 + fr, col0 = u.pn * BM + wc * 32 + 8 * fq;
        bf16_t* base = u.ks == 0 ? C + (size_t)row0 * ldc : Ct + ((size_t)(u.ks - 1) * 2048 + (row0 - pm0 * BM)) * ldc;
#pragma unroll
        for (int ai = 0; ai < 2; ++ai)
#pragma unroll
            for (int m = 0; m < 4; ++m) { bf16_t* rowp = base + (size_t)(ai * HALF + m * 16) * ldc + col0;
#pragma unroll
                for (int bj = 0; bj < 2; ++bj) { const f32x4 v0 = acc[ai][bj][m][0] * sc, v1 = acc[ai][bj][m][1] * sc;
                    u32x4 w; w.x = cvt_pk_bf16(v0[0], v0[1]); w.y = cvt_pk_bf16(v0[2], v0[3]); w.z = cvt_pk_bf16(v1[0], v1[1]); w.w = cvt_pk_bf16(v1[2], v1[3]);
                    *(u32x4*)(rowp + bj * HALF) = w; } }
    }
};
struct MoeOrder {
    int P, NT, G, c; const PG8_LAS int* pexp;
    int acap;
    int pm0, NTC, kbytes;
    __device__ __forceinline__ bool next(int i, Unit& u) const {
        const int U = ((i * 8 + (c & 7)) * 32) + (c >> 3); if (U >= P * NT) return false;
        const int gsz = 4 * NT, g = U / gsz, up = U - g * gsz; int pl = P - 4 * g; pl = pl > 4 ? 4 : pl;
        const int blk = pl * 8, j = up / blk, rr = up - j * blk, v = 8 * j + rr / pl;
        u.pm = pm0 + 4 * g + rr % pl; u.ks = v / NTC; u.pn = v - u.ks * NTC; u.ko = u.ks * kbytes; const int e = __builtin_amdgcn_readfirstlane(pexp[u.pm]); u.pb = e * NTC + u.pn;
        u.pa = acap ? e * acap + u.pm - (__builtin_amdgcn_readfirstlane(pexp[80 + e]) >> 8) : u.pm; return true;
    }
    __device__ __forceinline__ void a_ready(const Unit&) const {}
    __device__ __forceinline__ void done(const Unit&) const {}
};

template <class S> struct SubOrder {
    S s; int lo, hi;
    __device__ __forceinline__ bool next(int i, Unit& u) const { return (lo + i < hi) && s.next(lo + i, u); }
    __device__ __forceinline__ void a_ready(const Unit& u) const { s.a_ready(u); }
    __device__ __forceinline__ void done(const Unit& u) const { s.done(u); }
};

template <bool F8> struct Frag;
template <> struct Frag<false> { bf16x8 v[2]; __device__ __forceinline__ void set(int k, bf16x8 x) { v[k] = x; } };
template <> struct Frag<true> { i32x8 w; __device__ __forceinline__ void set(int k, bf16x8 x) { if (k == 0) w.lo = __builtin_bit_cast(i32x4, x); else w.hi = __builtin_bit_cast(i32x4, x); } };
template <class Epi, class Sched, bool ALIGN_EPI = false, bool SP2 = false, bool FP8 = false>
__device__ __forceinline__ void gemm_phase(PG8_LAS unsigned char* lds, const Gemm g, const Sched& S, const Epi& E) {
    int tid = threadIdx.x; asm volatile("" : "+v"(tid));
    const int wid = __builtin_amdgcn_readfirstlane(tid >> 6), lane = tid & 63, wr = wid >> 2, wc = wid & 3, fr = lane & 15, fq = lane >> 4;
    const int K = g.K, nt = K / BK, LD = g.ld ? g.ld : g.K;
    unsigned voffA[2], voffB[2];
#pragma unroll
    for (int i = 0; i < 2; ++i) { int R, C; stage_rc(tid * 16 + i * 8192, R, C); const int Rb = Epi::PERM ? ((R & ~31) + perm32(R & 31)) : R;
        voffA[i] = (unsigned)(R * LD + C) * 2u; voffB[i] = (unsigned)(Rb * LD + C) * 2u; }
    const size_t kstep = (size_t)(BK * 2);
    const size_t hstep = (size_t)HALF * LD * 2;
    const size_t tstep = 2 * hstep;
    const unsigned ldsw = (unsigned)wid * 1024u;
    const int aoff = lds_byte(wr * 64 + fr, fq * 8), boff = lds_byte(wc * 32 + fr, fq * 8);
#define PG8_SA(b, h) (((b) * 2 + (h)) * HTB)
#define PG8_SB(b, h) ((4 + (b) * 2 + (h)) * HTB)
#define PG8_STAGE(bufoff, gbase, voff) do { _Pragma("unroll") for (int _i = 0; _i < 2; ++_i) \
        __builtin_amdgcn_global_load_lds((const unsigned*)((const char*)(gbase) + (voff)[_i]), (PG8_LAS unsigned*)(lds + (bufoff) + ldsw + _i * 8192), 16, 0, 0); } while (0)
#define PG8_LDA(dst, b, h) do { _Pragma("unroll") for (int m = 0; m < 4; ++m) _Pragma("unroll") for (int k = 0; k < 2; ++k) dst[m].set(k, *(const PG8_LAS bf16x8*)(lds + PG8_SA(b, h) + aoff + m * 2048 + k * 1024)); } while (0)
#define PG8_LDB(dst, b, h) do { _Pragma("unroll") for (int n = 0; n < 2; ++n) _Pragma("unroll") for (int k = 0; k < 2; ++k) dst[n].set(k, *(const PG8_LAS bf16x8*)(lds + PG8_SB(b, h) + boff + n * 2048 + k * 1024)); } while (0)
#define PG8_MMA(ai, bj, At, Bt) do { __builtin_amdgcn_s_setprio(1); _Pragma("unroll") for (int m = 0; m < 4; ++m) _Pragma("unroll") for (int n = 0; n < 2; ++n) { \
        if constexpr (FP8) asm volatile("v_mfma_scale_f32_16x16x128_f8f6f4 %0, %1, %2, %0, %3, %3 op_sel_hi:[0,0,0]" : "+v"(acc[ai][bj][m][n]) : "v"(Bt[n].w), "v"(At[m].w), "v"(sc1));   \
        else { _Pragma("unroll") for (int k = 0; k < 2; ++k) acc[ai][bj][m][n] = __builtin_amdgcn_mfma_f32_16x16x32_bf16(Bt[n].v[k], At[m].v[k], acc[ai][bj][m][n], 0, 0, 0); } } __builtin_amdgcn_s_setprio(0); } while (0)
#define PG8_MMAZ(ai, bj, At, Bt) do { __builtin_amdgcn_s_setprio(1); _Pragma("unroll") for (int m = 0; m < 4; ++m) _Pragma("unroll") for (int n = 0; n < 2; ++n) { \
        if constexpr (FP8) asm volatile("v_mfma_scale_f32_16x16x128_f8f6f4 %0, %1, %2, 0, %3, %3 op_sel_hi:[0,0,0]" : "=&v"(acc[ai][bj][m][n]) : "v"(Bt[n].w), "v"(At[m].w), "v"(sc1)); \
        else { acc[ai][bj][m][n] = __builtin_amdgcn_mfma_f32_16x16x32_bf16(Bt[n].v[0], At[m].v[0], (f32x4){0.f, 0.f, 0.f, 0.f}, 0, 0, 0); \
               acc[ai][bj][m][n] = __builtin_amdgcn_mfma_f32_16x16x32_bf16(Bt[n].v[1], At[m].v[1], acc[ai][bj][m][n], 0, 0, 0); } } __builtin_amdgcn_s_setprio(0); } while (0)
#define PG8_WAIT_V(n) asm volatile("s_waitcnt vmcnt(" #n ")" ::: "memory")
#define PG8_WAIT_L(n) asm volatile("s_waitcnt lgkmcnt(" #n ")" ::: "memory")
#define PG8_BAR __builtin_amdgcn_s_barrier()
#define PG8_SCHED __builtin_amdgcn_sched_barrier(0)
    Unit cur, nxt; int ui = 0;
    if (!S.next(0, cur)) return;
    f32x4 acc[2][2][4][2];
#pragma unroll
    for (int a = 0; a < 2; ++a)
#pragma unroll
        for (int b = 0; b < 2; ++b)
#pragma unroll
            for (int m = 0; m < 4; ++m)
#pragma unroll
                for (int n = 0; n < 2; ++n) { if constexpr (SP2 && FP8) asm volatile("" : "=v"(acc[a][b][m][n])); else acc[a][b][m][n] = (f32x4){0.f, 0.f, 0.f, 0.f}; }
    Frag<FP8> At[4], B0[2], B1[2];
    int sc1 = 0x7f7f7f7f; asm volatile("" : "+v"(sc1));
    (void)sc1;
    const char* cA = (const char*)g.A + (size_t)cur.pa * tstep + cur.ko; const char* cB = (const char*)g.Bt + (size_t)cur.pb * tstep + cur.ko;
    asm volatile("" : "+v"(voffA[0]), "+v"(voffA[1]), "+v"(voffB[0]), "+v"(voffB[1]));
    S.a_ready(cur);
    if constexpr (SP2) {
        PG8_STAGE(PG8_SB(0, 0), cB, voffB); PG8_STAGE(PG8_SB(0, 1), cB + hstep, voffB); PG8_STAGE(PG8_SA(0, 0), cA, voffA); PG8_STAGE(PG8_SA(0, 1), cA + hstep, voffA);
        if (wr == 1) PG8_BAR;
        PG8_WAIT_V(2); PG8_BAR;
        PG8_STAGE(PG8_SB(1, 0), cB + kstep, voffB); PG8_STAGE(PG8_SA(1, 0), cA + kstep, voffA); PG8_STAGE(PG8_SB(1, 1), cB + hstep + kstep, voffB);
        PG8_WAIT_V(6); PG8_BAR;
    } else {
        PG8_STAGE(PG8_SB(0, 0), cB, voffB); PG8_STAGE(PG8_SA(0, 0), cA, voffA); PG8_STAGE(PG8_SB(0, 1), cB + hstep, voffB); PG8_STAGE(PG8_SA(0, 1), cA + hstep, voffA);
        if (wr == 1) PG8_BAR;
        PG8_WAIT_V(4); PG8_BAR;
        PG8_STAGE(PG8_SB(1, 0), cB + kstep, voffB); PG8_STAGE(PG8_SA(1, 0), cA + kstep, voffA); PG8_STAGE(PG8_SB(1, 1), cB + hstep + kstep, voffB);
        PG8_WAIT_V(6); PG8_BAR;
    }
    for (;;) {
        const bool has_next = S.next(ui + 1, nxt);
        const char* nA = has_next ? (const char*)g.A + (size_t)nxt.pa * tstep + nxt.ko : cA; const char* nB = has_next ? (const char*)g.Bt + (size_t)nxt.pb * tstep + nxt.ko : cB;
        for (int t = 0; t < nt; t += 2) {
            const bool last = (t == nt - 2);
            const char* a1 = cA + (size_t)(t + 1) * kstep;
            const char* a2 = last ? nA : cA + (size_t)(t + 2) * kstep; const char* b2 = last ? nB : cB + (size_t)(t + 2) * kstep;
            const char* a3 = a2 + kstep; const char* b3 = b2 + kstep;
            if (last && has_next) S.a_ready(nxt);
            if constexpr (SP2) {
            PG8_LDB(B0, 0, 0); PG8_LDB(B1, 0, 1); PG8_SCHED; PG8_LDA(At, 0, 0); PG8_STAGE(PG8_SA(1, 1), a1 + hstep, voffA);
            PG8_WAIT_V(8); PG8_WAIT_L(0); PG8_BAR; if (FP8 && t == 0) { PG8_MMAZ(0, 0, At, B0); PG8_MMAZ(0, 1, At, B1); } else { PG8_MMA(0, 0, At, B0); PG8_MMA(0, 1, At, B1); } PG8_BAR; PG8_SCHED;
            PG8_LDA(At, 0, 1); PG8_STAGE(PG8_SB(0, 0), b2, voffB); PG8_STAGE(PG8_SB(0, 1), b2 + hstep, voffB); PG8_STAGE(PG8_SA(0, 0), a2, voffA);
            PG8_WAIT_V(8); PG8_WAIT_L(0); PG8_BAR; if (FP8 && t == 0) { PG8_MMAZ(1, 0, At, B0); PG8_MMAZ(1, 1, At, B1); } else { PG8_MMA(1, 0, At, B0); PG8_MMA(1, 1, At, B1); } PG8_BAR; PG8_SCHED;
            PG8_LDB(B0, 1, 0); PG8_LDB(B1, 1, 1); PG8_SCHED; PG8_LDA(At, 1, 0); PG8_STAGE(PG8_SA(0, 1), a2 + hstep, voffA);
            PG8_WAIT_V(8); PG8_WAIT_L(0); PG8_BAR; PG8_MMA(0, 0, At, B0); PG8_MMA(0, 1, At, B1); PG8_BAR; PG8_SCHED;
            PG8_LDA(At, 1, 1); PG8_STAGE(PG8_SB(1, 0), b3, voffB); PG8_STAGE(PG8_SB(1, 1), b3 + hstep, voffB); PG8_STAGE(PG8_SA(1, 0), a3, voffA);
            PG8_WAIT_V(8); PG8_WAIT_L(0); PG8_BAR; PG8_MMA(1, 0, At, B0); PG8_MMA(1, 1, At, B1); PG8_BAR; PG8_SCHED;
            } else {
            PG8_LDB(B0, 0, 0); PG8_SCHED; PG8_LDA(At, 0, 0); PG8_STAGE(PG8_SA(1, 1), a1 + hstep, voffA);
            PG8_WAIT_L(8); PG8_BAR; PG8_WAIT_L(0); PG8_MMA(0, 0, At, B0); PG8_BAR; PG8_SCHED;
            PG8_LDB(B1, 0, 1); PG8_STAGE(PG8_SB(0, 0), b2, voffB);
            PG8_BAR; PG8_WAIT_L(0); PG8_MMA(0, 1, At, B1); PG8_BAR;
            PG8_LDA(At, 0, 1); PG8_STAGE(PG8_SA(0, 0), a2, voffA);
            PG8_BAR; PG8_WAIT_L(0); PG8_MMA(1, 0, At, B0); PG8_BAR; PG8_SCHED;
            PG8_STAGE(PG8_SB(0, 1), b2 + hstep, voffB);
            PG8_WAIT_V(6); PG8_BAR; PG8_MMA(1, 1, At, B1); PG8_BAR;
            PG8_LDB(B0, 1, 0); PG8_SCHED; PG8_LDA(At, 1, 0); PG8_STAGE(PG8_SA(0, 1), a2 + hstep, voffA);
            PG8_WAIT_L(8); PG8_BAR; PG8_WAIT_L(0); PG8_MMA(0, 0, At, B0); PG8_BAR; PG8_SCHED;
            PG8_LDB(B1, 1, 1); PG8_STAGE(PG8_SB(1, 0), b3, voffB);
            PG8_BAR; PG8_WAIT_L(0); PG8_MMA(0, 1, At, B1); PG8_BAR;
            PG8_LDA(At, 1, 1); PG8_STAGE(PG8_SA(1, 0), a3, voffA);
            PG8_BAR; PG8_WAIT_L(0); PG8_MMA(1, 0, At, B0); PG8_BAR; PG8_SCHED;
            PG8_STAGE(PG8_SB(1, 1), b3 + hstep, voffB);
            PG8_WAIT_V(6); PG8_BAR; PG8_MMA(1, 1, At, B1); PG8_BAR;
            }
        }
        if constexpr (FP8) asm volatile("s_nop 7\n\ts_nop 7\n\ts_nop 7" ::: "memory");
        if constexpr (FP8) {
#pragma unroll
            for (int a = 0; a < 2; ++a)
#pragma unroll
                for (int b = 0; b < 2; ++b)
#pragma unroll
                    for (int m = 0; m < 4; ++m)
#pragma unroll
                        for (int n = 0; n < 2; ++n) asm volatile("" : "+v"(acc[a][b][m][n]));
        }
        if constexpr (ALIGN_EPI) { if (wr == 0) PG8_BAR; }
        if constexpr (!Epi::AFTER_DRAIN) { E(acc, cur, wr, wc, fr, fq); S.done(cur); }
        if (!has_next) break;
#pragma unroll
        for (int a = 0; a < 2; ++a)
#pragma unroll
            for (int b = 0; b < 2; ++b)
#pragma unroll
                for (int m = 0; m < 4; ++m)
#pragma unroll
                    for (int n = 0; n < 2; ++n) { if constexpr (!(SP2 && FP8)) acc[a][b][m][n] = (f32x4){0.f, 0.f, 0.f, 0.f}; }
        cur = nxt; cA = nA; cB = nB; ++ui;
        if constexpr (ALIGN_EPI) { if (wr == 1) PG8_BAR; }
    }
    PG8_WAIT_V(0);
    if constexpr (!ALIGN_EPI) { if (wr == 0) PG8_BAR; }
    PG8_BAR;
    if constexpr (Epi::AFTER_DRAIN) { E.fused(acc, cur, wr, wc, fr, fq, lds, wid, lane); S.done(cur); }
#undef PG8_SA
#undef PG8_SB
#undef PG8_STAGE
#undef PG8_LDA
#undef PG8_LDB
#undef PG8_MMA
#undef PG8_MMAZ
#undef PG8_WAIT_V
#undef PG8_WAIT_L
#undef PG8_BAR
#undef PG8_SCHED
}
}
constexpr int NWAVES = 8;
constexpr int BATCH = 2, SEQ = 4096, DM = 2048, M = BATCH * SEQ;
constexpr int INW = 9216, ZQ = 0, ZK = 1536, ZV = 3072, ZP = 4608, ZGA = 5120, ZGB = 7168;
constexpr int DFF = 5632, EFF = 7168, NEXP = 8;
constexpr int XCAP = M;
constexpr int MPAD = 2 * M + NEXP * 256;
constexpr float RMS_EPS = 1e-6f;
constexpr int NPH = 20;
constexpr size_t MiB = 1u << 20;
constexpr size_t WS_CTL = 0, CTL_ZERO_BYTES = 1 * MiB;
constexpr size_t WS_LSE = 1 * MiB, WS_TOKE = WS_LSE + 512 * 1024, WS_TOKP = WS_TOKE + 64 * 1024, WS_TOKW = WS_TOKP + 64 * 1024;
constexpr size_t WS_WIN = 2 * MiB;
constexpr size_t WS_WAO = WS_WIN + 72 * MiB;
constexpr size_t WS_WPO = WS_WAO + 4 * MiB;
constexpr size_t WS_WOUT = WS_WPO + 4 * MiB;
constexpr size_t WS_WPOOL = WS_WOUT + 16 * MiB;
constexpr size_t WS_DGU = WS_WPOOL + 1 * MiB;
constexpr size_t WS_DD = WS_DGU + 44 * MiB;
constexpr size_t WS_MGU = WS_DD + 22 * MiB;
constexpr size_t WS_MD = WS_MGU + 448 * MiB;
constexpr size_t WS_XN = WS_MD + 224 * MiB;
constexpr size_t WS_A = WS_XN + 32 * MiB;
constexpr size_t WS_Z = WS_A, WS_OG = WS_A + 144 * MiB, WS_OA = WS_A + 168 * MiB, WS_OP = WS_A + 176 * MiB, WS_HM = WS_A, WS_HMP = WS_A;
constexpr size_t WS_B = WS_A + 252 * MiB;
constexpr size_t WS_T = WS_B, WS_MRG = WS_B + 32 * MiB, WS_MIX = WS_B + 64 * MiB, WS_YP = WS_B;
constexpr size_t WS_XP = WS_WIN;
static_assert(WS_XP + (size_t)NEXP * XCAP * DM <= WS_MGU, "Xp must end before the MoE weight copies");
constexpr size_t WS_YT = WS_B + 144 * MiB;
constexpr size_t WS_WIN8 = WS_YT + 48 * MiB;
constexpr size_t WS_XN8 = WS_WIN8 + 32 * MiB;
constexpr size_t WS_HB = WS_XN8 + 16 * MiB;
constexpr size_t WS_END = WS_HB + 32 * MiB;
static_assert((size_t)MPAD * EFF * 2 <= 252 * MiB && (size_t)MPAD * DM * 4 <= 144 * MiB && (size_t)M * INW * 2 <= 144 * MiB, "arena sizes");
constexpr int CW_TMO = 0, CW_CODE = 1;
constexpr int CW_BAR = 4096;
constexpr int CW_CNT = 8192;
constexpr int RING_OFF = 0, RING_BYTES = 131072;
constexpr int LDSCTL_OFF = RING_BYTES, MISC_OFF = LDSCTL_OFF + 320, TAB_OFF = LDSCTL_OFF + 512;
constexpr int LDS_BYTES = 147456;

#define GAS __attribute__((address_space(1)))
#define LAS __attribute__((address_space(3)))
typedef unsigned short bf16;
typedef unsigned v4u __attribute__((ext_vector_type(4)));
typedef unsigned v2u __attribute__((ext_vector_type(2)));
typedef float f32x4 __attribute__((ext_vector_type(4)));
typedef short bf16x8 __attribute__((ext_vector_type(8)));
typedef short bf16x4 __attribute__((ext_vector_type(4)));
typedef GAS unsigned gu32;
#define RLX_AGENT __ATOMIC_RELAXED, __HIP_MEMORY_SCOPE_AGENT
#define LDS_WAIT() asm volatile("s_waitcnt lgkmcnt(0)" ::: "memory")
#define VM_WAIT() asm volatile("s_waitcnt vmcnt(0)" ::: "memory")
__device__ __forceinline__ unsigned f2bf(float f) { unsigned u = __builtin_bit_cast(unsigned, f); return (u + 0x7fffu + ((u >> 16) & 1u)) >> 16; }
__device__ __forceinline__ unsigned pk2(float lo, float hi) { return pg8::cvt_pk_bf16(lo, hi); }
__device__ __forceinline__ float bflo(unsigned w) { return __uint_as_float(w << 16); }
__device__ __forceinline__ float bfhi(unsigned w) { return __uint_as_float(w & 0xffff0000u); }
#define XB_TMO      128
#define XB_XCNT(j)  (256  + 64 * (j))
#define XB_XSUB(j)  (1280 + 64 * (j))
#define XB_XGEN(j)  (2304 + 64 * (j))
#define XB_TOP      3328
#define XB_TOPGEN   3392
#define XCD_BAR_WORDS 3456
#define XB_SPIN_CAP (1u << 18)

__device__ __forceinline__ unsigned xb_ld(unsigned* p)              { return __hip_atomic_load(p, __ATOMIC_RELAXED, __HIP_MEMORY_SCOPE_AGENT); }
__device__ __forceinline__ unsigned xb_add(unsigned* p, unsigned v) { return __hip_atomic_fetch_add(p, v, __ATOMIC_RELAXED, __HIP_MEMORY_SCOPE_AGENT); }
__device__ __forceinline__ unsigned xb_xcc_id() { return (unsigned)__builtin_amdgcn_s_getreg((3 << 11) | 20) & 0xFu; }
#define XB_SPIN(cond, bar) do { unsigned _sp = 0; while (cond) { __builtin_amdgcn_s_sleep(1); \
    if ((++_sp & 255u) == 0u) { if (xb_ld(&(bar)[XB_TMO])) break; if (_sp > XB_SPIN_CAP) { atomicAdd(&(bar)[XB_TMO], 1u); break; } } } } while (0)

struct XcdBarrier {
    unsigned* bar; unsigned x;
    volatile LAS unsigned* st;
};

__device__ __forceinline__ XcdBarrier xcd_barrier_post(unsigned* bar, volatile LAS unsigned* st) {
    XcdBarrier b; b.bar = bar; b.x = xb_xcc_id(); b.st = st;
    if (threadIdx.x == 0) (void)xb_add(&bar[XB_XCNT(b.x)], 1u);
    return b;
}
__device__ __forceinline__ void xcd_barrier_complete(unsigned* bar, unsigned x, unsigned& nloc, unsigned& nx) {
    const unsigned G = gridDim.x * gridDim.y * gridDim.z;
    unsigned sum, cnt, mine, sp = 0u;
    for (;;) {
        sum = 0u; cnt = 0u; mine = 0u;
#pragma unroll
        for (unsigned j = 0; j < 16; ++j) { const unsigned c = xb_ld(&bar[XB_XCNT(j)]); sum += c; cnt += (c > 0u) ? 1u : 0u; mine = (j == x) ? c : mine; }
        if (sum == G) break;
        __builtin_amdgcn_s_sleep(1);
        if ((++sp & 255u) == 0u) { if (xb_ld(&bar[XB_TMO])) break; if (sp > XB_SPIN_CAP) { atomicAdd(&bar[XB_TMO], 1u); break; } }
    }
    nloc = mine > 0u ? mine : 1u; nx = cnt > 0u ? cnt : 1u;
}

__device__ __forceinline__ void xcd_barrier(const XcdBarrier& b) {
    asm volatile("s_waitcnt vmcnt(0)" ::: "memory");
    __syncthreads();
    if (threadIdx.x == 0) {
        unsigned* bar = b.bar;
        __builtin_amdgcn_s_waitcnt(0);
        unsigned nloc = b.st[0], nx = b.st[1];
        if (nloc == 0u) { xcd_barrier_complete(bar, b.x, nloc, nx); b.st[0] = nloc; b.st[1] = nx; }
        const unsigned old = xb_add(&bar[XB_XSUB(b.x)], 1u);
        const unsigned gen = old / nloc;
        if (old + 1u == (gen + 1u) * nloc) {
            __builtin_amdgcn_fence(__ATOMIC_RELEASE, "agent");
            asm volatile("s_waitcnt vmcnt(0)" ::: "memory");
            const unsigned og = xb_add(&bar[XB_TOP], 1u);
            const unsigned tg = og / nx;
            if (og + 1u == (tg + 1u) * nx) xb_add(&bar[XB_TOPGEN], 1u);
            else XB_SPIN(xb_ld(&bar[XB_TOPGEN]) == tg, bar);
            __builtin_amdgcn_fence(__ATOMIC_ACQUIRE, "agent");
            xb_add(&bar[XB_XGEN(b.x)], 1u);
            asm volatile("s_waitcnt vmcnt(0)" ::: "memory");
        } else {
            XB_SPIN(xb_ld(&bar[XB_XGEN(b.x)]) == gen, bar);
            __builtin_amdgcn_fence(__ATOMIC_ACQUIRE, "agent");
            asm volatile("s_waitcnt vmcnt(0)" ::: "memory");
        }
    }
    __syncthreads();
}

__device__ __forceinline__ float wave_sum(float v) {
#pragma unroll
    for (int o = 1; o < 64; o <<= 1) v += __shfl_xor(v, o);
    return v;
}
__device__ __forceinline__ void conv64(const float* W, int ldn, int k0, int n0, bf16* dst, int ldk, int drow0, LAS float* scr, int lane) {
    { const int r = lane >> 4, j = lane & 15; f32x4 v[16];
      const GAS f32x4* src = (const GAS f32x4*)(W + (size_t)(k0 + r) * ldn + n0 + 4 * j);
#pragma unroll
      for (int i = 0; i < 16; ++i) v[i] = __builtin_nontemporal_load(src + (size_t)i * ldn);
#pragma unroll
      for (int i = 0; i < 16; ++i) { const int kk = 4 * i + r; *(LAS f32x4*)(scr + kk * 64 + ((4 * j) ^ (4 * ((kk >> 3) & 7)))) = v[i]; } }
    LDS_WAIT(); asm volatile("" ::: "memory");
    const int c = lane & 7, nn = lane >> 3;
#pragma unroll
    for (int t = 0; t < 8; ++t) { const int n = nn + 8 * t; const LAS float* sp = scr + (8 * c) * 64 + (n ^ (4 * c));
        v4u o; o.x = pk2(sp[0 * 64], sp[1 * 64]); o.y = pk2(sp[2 * 64], sp[3 * 64]); o.z = pk2(sp[4 * 64], sp[5 * 64]); o.w = pk2(sp[6 * 64], sp[7 * 64]);
        *(GAS v4u*)(dst + (size_t)(drow0 + n) * ldk + k0 + 8 * c) = o; }
    LDS_WAIT(); asm volatile("" ::: "memory");
}
constexpr float WSCALE = 64.0f;
__device__ __forceinline__ unsigned pk4_fp8(float a, float b, float c, float d) { int w = __builtin_amdgcn_cvt_pk_fp8_f32(a, b, 0, false); w = __builtin_amdgcn_cvt_pk_fp8_f32(c, d, w, true); return (unsigned)w; }
__device__ __forceinline__ void conv8(const float* W, int ldn, int k0, int n0, unsigned char* dst, int ldk, int drow0, LAS float* scr, int lane) {
    { const int r = lane >> 3, j = lane & 7; f32x4 v[16];
      const GAS f32x4* src = (const GAS f32x4*)(W + (size_t)(k0 + r) * ldn + n0 + 4 * j);
#pragma unroll
      for (int i = 0; i < 16; ++i) v[i] = __builtin_nontemporal_load(src + (size_t)i * 2 * ldn);
#pragma unroll
      for (int i = 0; i < 16; ++i) { const int kk = 8 * i + r; *(LAS f32x4*)(scr + kk * 32 + ((4 * j) ^ (4 * (i & 7)))) = v[i] * WSCALE; } }
    LDS_WAIT(); asm volatile("" ::: "memory");
    const int c = lane & 15, nn = lane >> 4;
#pragma unroll
    for (int t = 0; t < 8; ++t) { const int n = nn + 4 * t; const LAS float* sp = scr + (8 * c) * 32 + (n ^ (4 * (c & 7)));
        v2u o; o.x = pk4_fp8(sp[0 * 32], sp[1 * 32], sp[2 * 32], sp[3 * 32]); o.y = pk4_fp8(sp[4 * 32], sp[5 * 32], sp[6 * 32], sp[7 * 32]);
        *(GAS v2u*)(dst + (size_t)(drow0 + n) * ldk + k0 + 8 * c) = o; }
    LDS_WAIT(); asm volatile("" ::: "memory");
}
struct Ptrs {
    const float *x, *w_in, *relb, *w_pool, *pscale, *w_ao, *w_po, *w_out, *gains, *dwg, *dwu, *dwd, *wr, *mwg, *mwu, *mwd;
    float* out; unsigned char* ws;
};
constexpr int I_WIN = 2 * 32 * 32, I_WIN8 = 2 * 16 * 224, I_AO = 2 * 8 * 32, I_PO = I_AO, I_WOUT = 2 * 32 * 32, I_POOL = 8 * 2 * 2, I_DG = 16 * 176, I_DU = I_DG, I_DD = 88 * 32,
              I_MG = 8 * 16 * 224, I_MU = I_MG, I_MD = 8 * 56 * 64;
constexpr int N_ITEMS_A = I_WIN + I_WIN8 + I_AO + I_PO + I_WOUT + I_POOL + I_DG + I_DU + I_DD, N_ITEMS_B = I_MG + I_MU + I_MD;
#ifndef QW_ITEMS
#define QW_ITEMS 14
#endif
constexpr int QW = QW_ITEMS / 2, QWZ = QW_ITEMS / 2;
constexpr int N_DEFER = 128 * NWAVES * (QW + 2 * QWZ);
static_assert(N_DEFER <= N_ITEMS_B, "deferred conversion quota");
__device__ __forceinline__ void conv_a(const Ptrs& P, int it, LAS float* scr, int lane) {
    unsigned char* ws = P.ws; int r = it;
    if (r < I_WIN) { const int l = r / (32 * 32), q = r % (32 * 32), kb = q / 32, nb = q % 32;
        conv64(P.w_in + (size_t)l * DM * INW, INW, 64 * kb, ZV + 64 * nb, (bf16*)(ws + WS_WIN) + (size_t)l * INW * DM, DM, ZV + 64 * nb, scr, lane); return; } r -= I_WIN;
    if (r < I_WIN8) { const int l = r / (16 * 224), q = r % (16 * 224), kb = q / 224, nb = q % 224;
        const int n0 = nb < 96 ? 32 * nb : ZGA + 32 * (nb - 96);
        conv8(P.w_in + (size_t)l * DM * INW, INW, 128 * kb, n0, (unsigned char*)(ws + WS_WIN8) + (size_t)l * 7168 * DM, DM, 32 * nb, scr, lane); return; } r -= I_WIN8;
    if (r < I_AO) { const int l = r / 256, q = r % 256, kb = q / 32, nb = q % 32;
        conv64(P.w_ao + (size_t)l * 512 * DM, DM, 64 * kb, 64 * nb, (bf16*)(ws + WS_WAO) + (size_t)l * DM * 512, 512, 64 * nb, scr, lane); return; } r -= I_AO;
    if (r < I_PO) { const int l = r / 256, q = r % 256, kb = q / 32, nb = q % 32;
        conv64(P.w_po + (size_t)l * 512 * DM, DM, 64 * kb, 64 * nb, (bf16*)(ws + WS_WPO) + (size_t)l * DM * 512, 512, 64 * nb, scr, lane); return; } r -= I_PO;
    if (r < I_WOUT) { const int l = r / 1024, q = r % 1024, kb = q / 32, nb = q % 32;
        conv64(P.w_out + (size_t)l * DM * DM, DM, 64 * kb, 64 * nb, (bf16*)(ws + WS_WOUT) + (size_t)l * DM * DM, DM, 64 * nb, scr, lane); return; } r -= I_WOUT;
    if (r < I_POOL) { const int mtx = r / 4, q = r % 4, kb = q / 2, nb = q % 2;
        conv64(P.w_pool + (size_t)mtx * 128 * 128, 128, 64 * kb, 64 * nb, (bf16*)(ws + WS_WPOOL) + (size_t)mtx * 128 * 128, 128, 64 * nb, scr, lane); return; } r -= I_POOL;
    if (r < I_DG + I_DU) { const int up = r >= I_DG; const int q = up ? r - I_DG : r; const int kb = q / 176, nb = q % 176, n0 = 32 * nb;
        conv8(up ? P.dwu : P.dwg, DFF, 128 * kb, n0, (unsigned char*)(ws + WS_DGU), DM, (n0 >> 7) * 256 + (n0 & 127) + (up ? 128 : 0), scr, lane); return; } r -= I_DG + I_DU;
    { const int kb = r / 32, nb = r % 32;
        conv64(P.dwd, DM, 64 * kb, 64 * nb, (bf16*)(ws + WS_DD), DFF, 64 * nb, scr, lane); }
}
__device__ __forceinline__ void conv_b(const Ptrs& P, int it, LAS float* scr, int lane) {
    unsigned char* ws = P.ws; int r = it;
    if (r < I_MG + I_MU) { const int up = r >= I_MG; const int q0 = up ? r - I_MG : r; const int e = q0 / (16 * 224), q = q0 % (16 * 224), kb = q / 224, nb = q % 224, n0 = 32 * nb;
        conv8((up ? P.mwu : P.mwg) + (size_t)e * DM * EFF, EFF, 128 * kb, n0, (unsigned char*)(ws + WS_MGU) + (size_t)e * 2 * EFF * DM, DM, (n0 >> 7) * 256 + (n0 & 127) + (up ? 128 : 0), scr, lane); return; } r -= I_MG + I_MU;
    { const int e = r / (56 * 64), q = r % (56 * 64), kb = q / 64, nb = q % 64;
        conv8(P.mwd + (size_t)e * EFF * DM, DM, 128 * kb, 32 * nb, (unsigned char*)(ws + WS_MD) + (size_t)e * DM * EFF, EFF, 32 * nb, scr, lane); }
}
__device__ __forceinline__ void p0_convert(const Ptrs& P, LAS unsigned char* lds, int gw, int NGW, int wave, int lane) {
    LAS float* scr = (LAS float*)(lds + RING_OFF + wave * 16384);
#pragma unroll 1
    for (int j = gw; j < I_WIN / 2 + I_WIN8 / 2; j += NGW) conv_a(P, j < I_WIN / 2 ? j : I_WIN + (j - I_WIN / 2), scr, lane);
}
__device__ __forceinline__ void conv_share_down(const Ptrs& P, LAS unsigned char* lds, int gw, int NGW, int wave, int lane) {
    LAS float* scr = (LAS float*)(lds + RING_OFF + wave * 16384);
    constexpr int PER = I_MD / 256; static_assert(I_MD % 256 == 0 && PER % NWAVES == 0, "conv_share_down: whole steps of eight items per workgroup");
    const int first = I_MG + I_MU + (gw / NWAVES) * PER + wave;
#pragma unroll 1
    for (int j = 0; j < PER; j += NWAVES) conv_b(P, first + j, scr, lane);
}
__device__ __forceinline__ void conv_share_a(const Ptrs& P, LAS unsigned char* lds, int gw, int NGW, int wave, int lane) {
    LAS float* scr = (LAS float*)(lds + RING_OFF + wave * 16384);
    constexpr int NA1 = N_ITEMS_A - I_WIN / 2 - I_WIN8 / 2;
#pragma unroll 1
    for (int j = gw; j < NA1; j += NGW) conv_a(P, j < I_WIN / 2 ? I_WIN / 2 + j : I_WIN + I_WIN8 / 2 + (j - I_WIN / 2), scr, lane);
}
__device__ __forceinline__ void conv_share_gu(const Ptrs& P, LAS unsigned char* lds, int gw, int NGW, int wave, int lane) {
    LAS float* scr = (LAS float*)(lds + RING_OFF + wave * 16384);
    constexpr int PER = (I_MG + I_MU - N_DEFER) / 256; static_assert((I_MG + I_MU - N_DEFER) % 256 == 0, "conv_share_gu: equal runs");
    const int first = N_DEFER + (gw / NWAVES) * PER;
#pragma unroll 1
    for (int j = wave; j < PER; j += NWAVES) conv_b(P, first + j, scr, lane);
}
__device__ __forceinline__ void conv_quota(const Ptrs& P, LAS unsigned char* lds, int site, int bx, int wave, int lane) {
    LAS float* scr = (LAS float*)(lds + RING_OFF + wave * 16384);
    const int w = (bx - 128) * NWAVES + wave, nq = site == 1 ? QW : QWZ, base = 128 * NWAVES * (site == 0 ? 0 : (site == 1 ? QWZ : QWZ + QW));
#pragma unroll 1
    for (int q = 0; q < nq; ++q) conv_b(P, base + q * (128 * NWAVES) + w, scr, lane);
}
__device__ __forceinline__ void ld_row(const float* p, int lane, f32x4 (&v)[8]) { const GAS f32x4* r = (const GAS f32x4*)p + lane;
#pragma unroll
    for (int j = 0; j < 8; ++j) v[j] = r[64 * j]; }
__device__ __forceinline__ void ld_row_bfraw(const bf16* p, int lane, v2u (&w)[8]) { const GAS v2u* r = (const GAS v2u*)p + lane;
#pragma unroll
    for (int j = 0; j < 8; ++j) w[j] = r[64 * j]; }
__device__ __forceinline__ void unpack_bf(const v2u (&w)[8], f32x4 (&v)[8]) {
#pragma unroll
    for (int j = 0; j < 8; ++j) v[j] = (f32x4){bflo(w[j].x), bfhi(w[j].x), bflo(w[j].y), bfhi(w[j].y)}; }
__device__ __forceinline__ void ld_row_bf(const bf16* p, int lane, f32x4 (&v)[8]) { v2u w[8]; ld_row_bfraw(p, lane, w); __builtin_amdgcn_sched_barrier(0); unpack_bf(w, v); }
__device__ __forceinline__ float sumsq(const f32x4 (&v)[8]) { float s = 0.f;
#pragma unroll
    for (int j = 0; j < 8; ++j) s += (v[j].x * v[j].x + v[j].y * v[j].y) + (v[j].z * v[j].z + v[j].w * v[j].w);
    return wave_sum(s); }
__device__ __forceinline__ void st_row_bf16(bf16* p, int lane, const f32x4 (&v)[8]) { GAS v2u* o = (GAS v2u*)p + lane;
#pragma unroll
    for (int j = 0; j < 8; ++j) { v2u w; w.x = pk2(v[j].x, v[j].y); w.y = pk2(v[j].z, v[j].w); o[64 * j] = w; } }
__device__ __forceinline__ void st_row_fp8(unsigned char* p, int lane, const f32x4 (&v)[8]) { GAS unsigned* o = (GAS unsigned*)p + lane;
#pragma unroll
    for (int j = 0; j < 8; ++j) o[64 * j] = pk4_fp8(v[j].x, v[j].y, v[j].z, v[j].w); }
__device__ __forceinline__ void norm_first(const float* x, const float* g, bf16* XN, unsigned char* XN8, int gw, int NGW, int lane) {
    f32x4 gv[8]; ld_row(g, lane, gv);
#pragma unroll 1
    for (int m = gw; m < M; m += NGW) { f32x4 v[8]; ld_row(x + (size_t)m * DM, lane, v);
        const float r = 1.0f / sqrtf(sumsq(v) * (1.0f / DM) + RMS_EPS);
#pragma unroll
        for (int j = 0; j < 8; ++j) v[j] = v[j] * r * gv[j];
        st_row_bf16(XN + (size_t)m * DM, lane, v); st_row_fp8(XN8 + (size_t)m * DM, lane, v); }
}
template <bool ROUTER, bool RES_BF>
__device__ __forceinline__ void norm_mid(const bf16* src, const void* res, bf16* hout, const float* gpost, const float* gpre, bf16* XN, unsigned char* XN8,
                                         const LAS float* wrl, gu32* ctl, int* toke, int* tokp, float* tokw, unsigned char* Xp, int gw, int NGW, int lane) {
    f32x4 v[8], h[8], hn[8]; v2u vr[8], hr[8];
    unsigned pend[8]; int pe1 = 0, pe2 = 0; unsigned pp1 = 0u, pp2 = 0u; bool have = false;
    if (gw < M) { ld_row_bfraw(src + (size_t)gw * DM, lane, vr);
        if constexpr (RES_BF) ld_row_bfraw((const bf16*)res + (size_t)gw * DM, lane, hr); else ld_row((const float*)res + (size_t)gw * DM, lane, hn); }
#pragma unroll 1
    for (int m = gw; m < M; m += NGW) {
        const int mn = m + NGW;
        unpack_bf(vr, v);
        if constexpr (RES_BF) unpack_bf(hr, h); else {
#pragma unroll
            for (int j = 0; j < 8; ++j) h[j] = hn[j]; }
        __builtin_amdgcn_sched_barrier(0);
        if (mn < M) { ld_row_bfraw(src + (size_t)mn * DM, lane, vr);
            if constexpr (RES_BF) ld_row_bfraw((const bf16*)res + (size_t)mn * DM, lane, hr); else ld_row((const float*)res + (size_t)mn * DM, lane, hn); }
        __builtin_amdgcn_sched_barrier(0);
        f32x4 gv[8]; ld_row(gpost, lane, gv);
        const float r = 1.0f / sqrtf(sumsq(v) * (1.0f / DM) + RMS_EPS);
#pragma unroll
        for (int j = 0; j < 8; ++j) h[j] = h[j] + v[j] * r * gv[j];
        st_row_bf16(hout + (size_t)m * DM, lane, h);
        const float r2 = 1.0f / sqrtf(sumsq(h) * (1.0f / DM) + RMS_EPS);
        ld_row(gpre, lane, gv);
#pragma unroll
        for (int j = 0; j < 8; ++j) h[j] = h[j] * r2 * gv[j];
        if (!ROUTER && XN) st_row_bf16(XN + (size_t)m * DM, lane, h);
        if (XN8) st_row_fp8(XN8 + (size_t)m * DM, lane, h);
        if (ROUTER) {
            int e1 = 0, e2 = 0; float v1 = -3.0e38f, v2 = -3.0e38f;
#pragma unroll 1
            for (int e = 0; e < NEXP; ++e) { float s = 0.f; const LAS f32x4* wp = (const LAS f32x4*)(wrl + e * DM) + lane;
#pragma unroll
                for (int j = 0; j < 8; ++j) { const f32x4 w = wp[64 * j]; s += (h[j].x * w.x + h[j].y * w.y) + (h[j].z * w.z + h[j].w * w.w); }
                s = wave_sum(s);
                if (s > v1) { v2 = v1; e2 = e1; v1 = s; e1 = e; } else if (s > v2) { v2 = s; e2 = e; } }
            if (have) {
                const unsigned q1 = __builtin_amdgcn_readfirstlane(pp1), q2 = __builtin_amdgcn_readfirstlane(pp2);
                GAS unsigned* o1 = (GAS unsigned*)(Xp + ((size_t)pe1 * XCAP + q1) * DM) + lane; GAS unsigned* o2 = (GAS unsigned*)(Xp + ((size_t)pe2 * XCAP + q2) * DM) + lane;
#pragma unroll
                for (int j = 0; j < 8; ++j) { o1[64 * j] = pend[j]; o2[64 * j] = pend[j]; } }
#pragma unroll
            for (int j = 0; j < 8; ++j) pend[j] = pk4_fp8(h[j].x, h[j].y, h[j].z, h[j].w);
            pe1 = e1; pe2 = e2; have = true;
            if (lane == 0) {
                const float w1 = 1.0f / (1.0f + __expf(v2 - v1)), w2 = 1.0f - w1;
                pp1 = __hip_atomic_fetch_add(ctl + CW_CNT + 64 * e1, 1u, RLX_AGENT);
                pp2 = __hip_atomic_fetch_add(ctl + CW_CNT + 64 * e2, 1u, RLX_AGENT);
                toke[2 * m] = e1; toke[2 * m + 1] = e2; tokp[2 * m] = (int)pp1; tokp[2 * m + 1] = (int)pp2; tokw[2 * m] = w1; tokw[2 * m + 1] = w2;
            }
        }
    }
    if (ROUTER && have) {
        const unsigned q1 = __builtin_amdgcn_readfirstlane(pp1), q2 = __builtin_amdgcn_readfirstlane(pp2);
        GAS unsigned* o1 = (GAS unsigned*)(Xp + ((size_t)pe1 * XCAP + q1) * DM) + lane; GAS unsigned* o2 = (GAS unsigned*)(Xp + ((size_t)pe2 * XCAP + q2) * DM) + lane;
#pragma unroll
        for (int j = 0; j < 8; ++j) { o1[64 * j] = pend[j]; o2[64 * j] = pend[j]; } }
}
__device__ __forceinline__ void moe_tables(gu32* ctl, LAS int* tab, int tid) {
    if (tid < NEXP) { int c = (int)__hip_atomic_load(ctl + CW_CNT + 64 * tid, RLX_AGENT); if (c > XCAP) c = XCAP; tab[88 + tid] = c; }
    __syncthreads();
    if (tid == 0) { int off = 0, p = 0;
        for (int e = 0; e < NEXP; ++e) { const int c = tab[88 + e], np = (c + 255) >> 8;
            tab[80 + e] = off; for (int i = 0; i < np && p < 80; ++i) tab[p++] = e; off += np * 256; }
        tab[96] = p; }
    __syncthreads();
}
__device__ __forceinline__ void add_ytail(const bf16* Yt, int r, int rt0, int lane, f32x4 (&a)[8]) {
    if (r >= rt0) {
#pragma unroll 1
        for (int k = 0; k < 3; ++k) { f32x4 t[8]; ld_row_bf(Yt + ((size_t)k * 2048 + (r - rt0)) * DM, lane, t);
#pragma unroll
            for (int j = 0; j < 8; ++j) a[j] = a[j] + t[j]; } }
}
__device__ __forceinline__ void norm_final(const bf16* Yp, const bf16* Yt, const float* g, const bf16* hb, float* out, const int* toke, const int* tokp, const float* tokw, const LAS int* tab, int gw, int NGW, int lane) {
    const int rt0 = (tab[96] & ~31) * 256;
    v2u ar[8], br[8]; int r1 = 0, r2 = 0, r1n = 0, r2n = 0; float w1 = 0.f, w2 = 0.f, w1n = 0.f, w2n = 0.f;
    if (gw < M) { const int m = gw; r1 = tab[80 + toke[2 * m]] + tokp[2 * m]; r2 = tab[80 + toke[2 * m + 1]] + tokp[2 * m + 1]; w1 = tokw[2 * m]; w2 = tokw[2 * m + 1];
        ld_row_bfraw(Yp + (size_t)r1 * DM, lane, ar); ld_row_bfraw(Yp + (size_t)r2 * DM, lane, br); }
#pragma unroll 1
    for (int m = gw; m < M; m += NGW) {
        const int mn = m + NGW;
        f32x4 a[8], b[8]; unpack_bf(ar, a); unpack_bf(br, b);
        __builtin_amdgcn_sched_barrier(0);
        if (mn < M) { r1n = tab[80 + toke[2 * mn]] + tokp[2 * mn]; r2n = tab[80 + toke[2 * mn + 1]] + tokp[2 * mn + 1]; w1n = tokw[2 * mn]; w2n = tokw[2 * mn + 1];
            ld_row_bfraw(Yp + (size_t)r1n * DM, lane, ar); ld_row_bfraw(Yp + (size_t)r2n * DM, lane, br); }
        __builtin_amdgcn_sched_barrier(0);
        add_ytail(Yt, r1, rt0, lane, a); add_ytail(Yt, r2, rt0, lane, b);
#pragma unroll
        for (int j = 0; j < 8; ++j) a[j] = a[j] * w1 + b[j] * w2;
        ld_row_bf(hb + (size_t)m * DM, lane, b);
        const float r = 1.0f / sqrtf(sumsq(a) * (1.0f / DM) + RMS_EPS);
        GAS f32x4* o = (GAS f32x4*)(out + (size_t)m * DM) + lane; const GAS f32x4* gp = (const GAS f32x4*)g + lane;
#pragma unroll
        for (int j = 0; j < 8; ++j) o[64 * j] = b[j] + a[j] * r * gp[64 * j];
        r1 = r1n; r2 = r2n; w1 = w1n; w2 = w2n;
    }
}
__device__ __forceinline__ int t5_bucket(int d) {
    if (d < 16) return d;
    return 16 + (d >= 22) + (d >= 30) + (d >= 40) + (d >= 54) + (d >= 73) + (d >= 99) + (d >= 134) + (d >= 182) + (d >= 246) + (d >= 332) + (d >= 450) + (d >= 609) + (d >= 825) + (d >= 1117) + (d >= 1513);
}
struct AttnU { int b, g, d, r, n, hh, head; };
__device__ __forceinline__ AttnU attn_decode(int ui) { AttnU u; u.hh = ui & 3; const int u2 = ui >> 2; u.b = u2 / 96; const int s = u2 % 96;
    if (s < 32) { u.g = 0; u.d = 1; u.r = 0; u.n = s; } else if (s < 64) { u.g = 1; u.d = 4; u.r = (s - 32) >> 3; u.n = (s - 32) & 7; } else { u.g = 2; u.d = 16; u.r = (s - 64) >> 1; u.n = (s - 64) & 1; }
    u.head = u.g * 4 + u.hh; return u; }
__device__ __forceinline__ void att_dma16(const void* g, LAS unsigned char* piece) {
    unsigned sv; const unsigned base = (unsigned)(size_t)piece;
    asm volatile("s_mov_b32 %0, m0\n\ts_mov_b32 m0, %2\n\ts_nop 0\n\tglobal_load_lds_dwordx4 %1, off\n\ts_mov_b32 m0, %0" : "=&s"(sv) : "v"(g), "s"(__builtin_amdgcn_readfirstlane(base)) : "memory");
}
__device__ __forceinline__ int v_swz(int row) { return ((row & 3) << 2) | ((row >> 2) & 3); }
__device__ __forceinline__ void attn_dma_v(const bf16* Z, const AttnU& u, LAS unsigned char* buf, int wave, int lane) {
#pragma unroll
    for (int i = 0; i < 8; ++i) { const int piece = wave * 8 + i, p = 4 * piece + (lane >> 4), j = 128 * (u.n - 1) + p;
        const bf16* src = Z + (size_t)(u.b * SEQ + u.r + u.d * (j < 0 ? 0 : j)) * INW + ZV + u.head * 128 + 8 * ((lane & 15) ^ v_swz(p));
        att_dma16(src, buf + piece * 1024); }
}
constexpr int ATT_BT_OFF = LDSCTL_OFF + 1024;
__device__ __forceinline__ void attn_dma_k(const bf16* Z, const AttnU& u, LAS unsigned char* buf, int wave, int lane) {
#pragma unroll
    for (int i = 0; i < 8; ++i) { const int piece = wave * 8 + i, p = 4 * piece + (lane >> 4), j = 128 * (u.n - 1) + p;
        const bf16* src = Z + (size_t)(u.b * SEQ + u.r + u.d * (j < 0 ? 0 : j)) * INW + ZK + u.head * 128 + 8 * ((lane & 15) ^ (p & 15));
        att_dma16(src, buf + piece * 1024); }
}
__device__ __forceinline__ void attn_ld_q(const bf16* Z, const AttnU& u, int wave, int qi, int qd, bf16x8 (&qf)[4]) {
    const int jq = 128 * u.n + 16 * wave + qi; const size_t rowq = (size_t)(u.b * SEQ + u.r + u.d * jq);
#pragma unroll
    for (int s4 = 0; s4 < 4; ++s4) qf[s4] = *(const GAS bf16x8*)(Z + rowq * INW + ZQ + u.head * 128 + 32 * s4 + 8 * qd);
}
#define ATT_BAR() do { asm volatile("s_waitcnt lgkmcnt(0)" ::: "memory"); __builtin_amdgcn_s_barrier(); asm volatile("" ::: "memory"); } while (0)
__device__ __forceinline__ void attn_phase(const bf16* Z, const float* relb, bf16* OG, float* LSE, LAS unsigned char* lds, int G, int tid, int wave, int lane) {
    const int qi = lane & 15, qd = lane >> 4;
    constexpr float C2 = 0.08838834764831845f * 1.4426950408889634f;
    const int trq = (lane & 15) >> 2, trp = lane & 3, trrow = 4 * qd + trq, trswz = (trq << 2) | qd;
    LAS unsigned char* kbuf = lds + RING_OFF; LAS unsigned char* vbuf = lds + RING_OFF + 65536;
    const int tb = tid < 128 ? tid : 128;
    int it = 0;
    int bxl = blockIdx.x; asm volatile("" : "+s"(bxl));
    bf16x8 qf[4];
    if (bxl < 768) { const AttnU u0 = attn_decode(bxl);
        const float bv = relb[t5_bucket(tb * u0.d) * 12 + u0.head]; attn_ld_q(Z, u0, wave, qi, qd, qf);
        __builtin_amdgcn_sched_barrier(0);
        attn_dma_k(Z, u0, kbuf, wave, lane); attn_dma_v(Z, u0, vbuf, wave, lane);
        __builtin_amdgcn_sched_barrier(0);
        if (tid < 129) ((LAS float*)(lds + ATT_BT_OFF))[tid] = bv * 1.4426950408889634f; }
#pragma unroll 1
    for (int ui = bxl; ui < 768; ui += G, ++it) {
        const AttnU U = attn_decode(ui); const int b = U.b, g = U.g, d = U.d, r = U.r, n = U.n, hh = U.hh, head = U.head;
        const bool has_next = ui + G < 768;
        LAS float* btab = (LAS float*)(lds + ATT_BT_OFF) + (it & 1) * 132; LAS float* btabn = (LAS float*)(lds + ATT_BT_OFF) + ((it + 1) & 1) * 132;
        const int jq = 128 * n + 16 * wave + qi; const size_t rowq = (size_t)(b * SEQ + r + d * jq);
        __builtin_amdgcn_sched_barrier(0);
        asm volatile("s_waitcnt vmcnt(8)" ::: "memory");
        ATT_BAR();
        __builtin_amdgcn_sched_barrier(0);
        f32x4 sa[9];
        const LAS unsigned char* krow = kbuf + (16 * wave + qi) * 256;
        bf16x8 kfA[3][4], kfB[3][4];
#define ATT_LDK(dst, t0) do { _Pragma("unroll") for (int tt = 0; tt < 3; ++tt) _Pragma("unroll") for (int s4 = 0; s4 < 4; ++s4) dst[tt][s4] = *(const LAS bf16x8*)(krow + ((t0) + tt) * 4096 + 16 * ((4 * s4 + qd) ^ qi)); } while (0)
#define ATT_QK(src, t0) do { _Pragma("unroll") for (int tt = 0; tt < 3; ++tt) { f32x4 a_ = (f32x4){0.f, 0.f, 0.f, 0.f}; \
            _Pragma("unroll") for (int s4 = 0; s4 < 4; ++s4) a_ = __builtin_amdgcn_mfma_f32_16x16x32_bf16(src[tt][s4], qf[s4], a_, 0, 0, 0); sa[(t0) + tt] = a_; } } while (0)
        ATT_LDK(kfA, 0); ATT_LDK(kfB, 3); __builtin_amdgcn_sched_barrier(0);
        ATT_QK(kfA, 0); __builtin_amdgcn_sched_barrier(0);
        ATT_LDK(kfA, 6); __builtin_amdgcn_sched_barrier(0);
        ATT_QK(kfB, 3); __builtin_amdgcn_sched_barrier(0);
        ATT_QK(kfA, 6);
#undef ATT_LDK
#undef ATT_QK
        __builtin_amdgcn_sched_barrier(0);
        ATT_BAR();
        __builtin_amdgcn_sched_barrier(0);
        float bvn = 0.f;
        if (has_next) { const AttnU un = attn_decode(ui + G);
            bvn = relb[t5_bucket(tb * un.d) * 12 + un.head]; __builtin_amdgcn_sched_barrier(0);
            attn_ld_q(Z, un, wave, qi, qd, qf); __builtin_amdgcn_sched_barrier(0);
            attn_dma_k(Z, un, kbuf, wave, lane); }
        __builtin_amdgcn_sched_barrier(0);
        float bs[9][4];
#pragma unroll
        for (int t = 0; t < 9; ++t)
#pragma unroll
            for (int rr = 0; rr < 4; ++rr) { const int e = qi - 4 * qd - rr;
                bs[t][rr] = btab[t == 0 ? (e > 0 ? 128 : 128 + e) : (t == 8 ? (e < 0 ? 0 : e) : 128 - 16 * t + e)]; }
        __builtin_amdgcn_sched_barrier(0);
        float mx = -__builtin_inff();
#pragma unroll
        for (int t = 0; t < 9; ++t)
#pragma unroll
            for (int rr = 0; rr < 4; ++rr) { const int e = qi - 4 * qd - rr;
                const bool valid = (t == 0 ? e <= 0 : (t == 8 ? e >= 0 : true)) && (n > 0 || wave + t >= 8);
                const float sc = valid ? sa[t][rr] * C2 + bs[t][rr] : -__builtin_inff();
                sa[t][rr] = sc; mx = fmaxf(mx, sc); }
        mx = fmaxf(mx, __shfl_xor(mx, 16)); mx = fmaxf(mx, __shfl_xor(mx, 32));
        float sum = 0.f;
#pragma unroll
        for (int t = 0; t < 9; ++t)
#pragma unroll
            for (int rr = 0; rr < 4; ++rr) { const float p = __builtin_amdgcn_exp2f(sa[t][rr] - mx); sa[t][rr] = p; sum += p; }
        sum += __shfl_xor(sum, 16); sum += __shfl_xor(sum, 32);
        __builtin_amdgcn_sched_barrier(0);
        if (has_next) asm volatile("s_waitcnt vmcnt(13)" ::: "memory");
        else asm volatile("s_waitcnt vmcnt(0)" ::: "memory");
        ATT_BAR();
        __builtin_amdgcn_sched_barrier(0);
        f32x4 o[8];
#pragma unroll
        for (int dt = 0; dt < 8; ++dt) o[dt] = (f32x4){0.f, 0.f, 0.f, 0.f};
        const LAS unsigned char* vrow = vbuf + (16 * wave + trrow) * 256 + 8 * (trp & 1);
#pragma unroll
        for (int t = 0; t < 9; ++t) { v2u pw; pw.x = pk2(sa[t][0], sa[t][1]); pw.y = pk2(sa[t][2], sa[t][3]); const bf16x4 pf = __builtin_bit_cast(bf16x4, pw);
            bf16x4 vf[8];
#pragma unroll
            for (int dt = 0; dt < 8; ++dt) vf[dt] = __builtin_amdgcn_ds_read_tr16_b64_v4i16((LAS bf16x4*)(vrow + t * 4096 + 16 * ((2 * dt + (trp >> 1)) ^ trswz)));
            __builtin_amdgcn_sched_barrier(0);
#pragma unroll
            for (int dt = 0; dt < 8; ++dt) o[dt] = __builtin_amdgcn_mfma_f32_16x16x16bf16_1k(vf[dt], pf, o[dt], 0, 0, 0); }
        __builtin_amdgcn_sched_barrier(0);
        ATT_BAR();
        __builtin_amdgcn_sched_barrier(0);
        asm volatile("" : "+v"(bvn));
        if (has_next && tid < 129) btabn[tid] = bvn * 1.4426950408889634f;
        __builtin_amdgcn_sched_barrier(0);
        const float inv = 1.0f / sum;
        bf16* op = OG + ((size_t)g * M + rowq) * 512 + hh * 128 + 4 * qd;
#pragma unroll
        for (int dt = 0; dt < 8; ++dt) { v2u w; w.x = pk2(o[dt][0] * inv, o[dt][1] * inv); w.y = pk2(o[dt][2] * inv, o[dt][3] * inv); *(GAS v2u*)(op + 16 * dt) = w; }
        if (qd == 0) LSE[((size_t)g * M + rowq) * 4 + hh] = (mx + __builtin_amdgcn_logf(sum)) * 0.6931471805599453f;
        __builtin_amdgcn_sched_barrier(0);
        if (has_next) { const AttnU un = attn_decode(ui + G); attn_dma_v(Z, un, vbuf, wave, lane); }
        __builtin_amdgcn_sched_barrier(0);
    }
    asm volatile("s_waitcnt vmcnt(0)" ::: "memory"); __syncthreads();
}
template <int K> __device__ __forceinline__ float row_shr(float x) { return __int_as_float(__builtin_amdgcn_update_dpp(0, __float_as_int(x), 0x110 + K, 0xF, 0xF, true)); }
template <int K> __device__ __forceinline__ float row_shl(float x) { return __int_as_float(__builtin_amdgcn_update_dpp(0, __float_as_int(x), 0x100 + K, 0xF, 0xF, true)); }
template <int SZ>
__device__ __forceinline__ void pool_window(const bf16* Z, int g, int tile, int lane, bf16x8 (&yf)[4]) {
    static_assert(SZ == 2 || SZ == 4 || SZ == 8 || SZ == 16, "window");
    const int qi = lane & 15, qd = lane >> 4, row = tile * 16 + qi, tseq = row & (SEQ - 1); const int cnt = (tseq + 1 < SZ) ? tseq + 1 : SZ;
    const float rc = 1.0f / (float)cnt; const bool hasprev = ((tile * 16) & (SEQ - 1)) != 0;
    v4u cw[4], pw[4];
#pragma unroll
    for (int s4 = 0; s4 < 4; ++s4) { const bf16* zp = Z + (size_t)row * INW + ZP + 128 * g + 32 * s4 + 8 * qd;
        cw[s4] = *(const GAS v4u*)zp; pw[s4] = *(const GAS v4u*)(zp - (hasprev ? (size_t)16 * INW : (size_t)0)); }
    __builtin_amdgcn_sched_barrier(0);
#pragma unroll
    for (int s4 = 0; s4 < 4; ++s4) {
        const float c[8] = {bflo(cw[s4].x), bfhi(cw[s4].x), bflo(cw[s4].y), bfhi(cw[s4].y), bflo(cw[s4].z), bfhi(cw[s4].z), bflo(cw[s4].w), bfhi(cw[s4].w)};
        const float p[8] = {bflo(pw[s4].x), bfhi(pw[s4].x), bflo(pw[s4].y), bfhi(pw[s4].y), bflo(pw[s4].z), bfhi(pw[s4].z), bflo(pw[s4].w), bfhi(pw[s4].w)};
        float y[8];
#pragma unroll
        for (int e = 0; e < 8; ++e) {
            float Pc = c[e]; Pc += row_shr<1>(Pc); Pc += row_shr<2>(Pc); Pc += row_shr<4>(Pc); Pc += row_shr<8>(Pc);
            float Sp = hasprev ? p[e] : 0.f; Sp += row_shl<1>(Sp); Sp += row_shl<2>(Sp); Sp += row_shl<4>(Sp); Sp += row_shl<8>(Sp);
            float w = Pc + row_shl<17 - SZ>(Sp);
            if (SZ < 16) w -= row_shr<(SZ < 16 ? SZ : 1)>(Pc);
            y[e] = w * rc - c[e]; }
        v4u yw; yw.x = pk2(y[0], y[1]); yw.y = pk2(y[2], y[3]); yw.z = pk2(y[4], y[5]); yw.w = pk2(y[6], y[7]);
        yf[s4] = __builtin_bit_cast(bf16x8, yw); }
}
__device__ __forceinline__ void pool_mma(const bf16* WPt, const float* pscale, bf16* OP, int g, int tile, int lane, const bf16x8 (&yf)[4]) {
    const int qi = lane & 15, qd = lane >> 4, row = tile * 16 + qi;
#pragma unroll
    for (int h = 0; h < 2; ++h) {
        bf16x8 wf[4][4]; f32x4 ps[4];
#pragma unroll
        for (int k = 0; k < 4; ++k) { const int nt = 4 * h + k; const bf16* wp = WPt + ((size_t)g * 128 + 16 * nt + qi) * 128 + 8 * qd;
#pragma unroll
            for (int s4 = 0; s4 < 4; ++s4) wf[k][s4] = *(const GAS bf16x8*)(wp + 32 * s4);
            ps[k] = *(const GAS f32x4*)(pscale + 128 * g + 16 * nt + 4 * qd); }
        __builtin_amdgcn_sched_barrier(0);
#pragma unroll
        for (int k = 0; k < 4; ++k) { const int nt = 4 * h + k; f32x4 acc = (f32x4){0.f, 0.f, 0.f, 0.f};
#pragma unroll
            for (int s4 = 0; s4 < 4; ++s4) acc = __builtin_amdgcn_mfma_f32_16x16x32_bf16(wf[k][s4], yf[s4], acc, 0, 0, 0);
            v2u w; w.x = pk2(acc[0] * ps[k][0], acc[1] * ps[k][1]); w.y = pk2(acc[2] * ps[k][2], acc[3] * ps[k][3]);
            *(GAS v2u*)(OP + (size_t)row * 512 + 128 * g + 16 * nt + 4 * qd) = w; }
        __builtin_amdgcn_sched_barrier(0);
    }
}
__device__ __forceinline__ void combine_pool_phase(const bf16* Z, const bf16* OG, const float* LSE, const bf16* WPt, const float* pscale, bf16* OA, bf16* OP, int gw, int NGW, int lane) {
#pragma unroll 1
    for (int task = gw; task < (M / 16) * 4; task += NGW) { const int g = 3 - (task & 3), tile = task >> 2;
        bf16x8 yf[4];
        if (g == 3) pool_window<16>(Z, 3, tile, lane, yf); else if (g == 2) pool_window<8>(Z, 2, tile, lane, yf);
        else if (g == 1) pool_window<4>(Z, 1, tile, lane, yf); else pool_window<2>(Z, 0, tile, lane, yf);
        pool_mma(WPt, pscale, OP, g, tile, lane, yf); }
    const int hh = lane >> 4;
#pragma unroll 1
    for (int m0 = gw; m0 < M; m0 += 4 * NGW) {
        v4u a[4], b[4], c[4]; float l0[4], l1[4], l2[4];
#pragma unroll
        for (int k = 0; k < 4; ++k) { const int m = m0 + k * NGW; if (m < M) {
            l0[k] = LSE[(size_t)m * 4 + hh]; l1[k] = LSE[((size_t)M + m) * 4 + hh]; l2[k] = LSE[((size_t)2 * M + m) * 4 + hh];
            a[k] = *(const GAS v4u*)(OG + (size_t)m * 512 + lane * 8); b[k] = *(const GAS v4u*)(OG + ((size_t)M + m) * 512 + lane * 8); c[k] = *(const GAS v4u*)(OG + ((size_t)2 * M + m) * 512 + lane * 8); } }
#pragma unroll
        for (int k = 0; k < 4; ++k) { const int m = m0 + k * NGW; if (m < M) {
            const float mx = fmaxf(l0[k], fmaxf(l1[k], l2[k])); const float e0 = __expf(l0[k] - mx), e1 = __expf(l1[k] - mx), e2 = __expf(l2[k] - mx); const float inv = 1.0f / (e0 + e1 + e2);
            const float w0 = e0 * inv, w1 = e1 * inv, w2 = e2 * inv; const v4u A = a[k], B = b[k], C = c[k];
            v4u o;
            o.x = pk2(w0 * bflo(A.x) + w1 * bflo(B.x) + w2 * bflo(C.x), w0 * bfhi(A.x) + w1 * bfhi(B.x) + w2 * bfhi(C.x));
            o.y = pk2(w0 * bflo(A.y) + w1 * bflo(B.y) + w2 * bflo(C.y), w0 * bfhi(A.y) + w1 * bfhi(B.y) + w2 * bfhi(C.y));
            o.z = pk2(w0 * bflo(A.z) + w1 * bflo(B.z) + w2 * bflo(C.z), w0 * bfhi(A.z) + w1 * bfhi(B.z) + w2 * bfhi(C.z));
            o.w = pk2(w0 * bflo(A.w) + w1 * bflo(B.w) + w2 * bflo(C.w), w0 * bfhi(A.w) + w1 * bfhi(B.w) + w2 * bfhi(C.w));
            *(GAS v4u*)(OA + (size_t)m * 512 + lane * 8) = o; } }
    }
}
struct Args { const float* in[16]; float* out; unsigned char* ws; int ph_lo, ph_hi; };
__global__ void __launch_bounds__(NWAVES * 64, 2) mk_fwd(Args args) {
    extern __shared__ __attribute__((aligned(16))) unsigned char lds_raw[];
    LAS unsigned char* lds = (LAS unsigned char*)lds_raw;
    volatile LAS unsigned* MISC = (volatile LAS unsigned*)(lds + MISC_OFF);
    LAS int* tab = (LAS int*)(lds + TAB_OFF);
    const int tid = threadIdx.x, lane = tid & 63, wave = __builtin_amdgcn_readfirstlane(tid >> 6);
    const int G = gridDim.x; const int bx = blockIdx.x; const int vcu = (G % 8 == 0) ? (bx % 8) * (G / 8) + bx / 8 : bx;
    const int gw = vcu * NWAVES + wave, NGW = G * NWAVES;
    Ptrs P;
    P.x = args.in[0]; P.w_in = args.in[1]; P.relb = args.in[2]; P.w_pool = args.in[3]; P.pscale = args.in[4]; P.w_ao = args.in[5]; P.w_po = args.in[6]; P.w_out = args.in[7];
    P.gains = args.in[8]; P.dwg = args.in[9]; P.dwu = args.in[10]; P.dwd = args.in[11]; P.wr = args.in[12]; P.mwg = args.in[13]; P.mwu = args.in[14]; P.mwd = args.in[15];
    P.out = args.out; P.ws = args.ws;
    unsigned char* ws = args.ws;
    gu32* ctl = (gu32*)(ws + WS_CTL);
    bf16* XN = (bf16*)(ws + WS_XN); bf16* Z = (bf16*)(ws + WS_Z); bf16* OG = (bf16*)(ws + WS_OG); bf16* OA = (bf16*)(ws + WS_OA); bf16* OP = (bf16*)(ws + WS_OP);
    bf16* TB = (bf16*)(ws + WS_T); bf16* MRG = (bf16*)(ws + WS_MRG); bf16* MIXb = (bf16*)(ws + WS_MIX); float* LSE = (float*)(ws + WS_LSE);
    bf16* HB = (bf16*)(ws + WS_HB);
    int* toke = (int*)(ws + WS_TOKE); int* tokp = (int*)(ws + WS_TOKP); float* tokw = (float*)(ws + WS_TOKW);
    for (int u = tid; u < (LDS_BYTES - LDSCTL_OFF) / 4; u += NWAVES * 64) ((LAS unsigned*)(lds + LDSCTL_OFF))[u] = 0u;
    __syncthreads();
    XcdBarrier bar; bar.bar = (unsigned*)(ctl + CW_BAR); bar.x = 0; bar.st = nullptr;
    if (!MK_SPLIT) bar = xcd_barrier_post((unsigned*)(ctl + CW_BAR), MISC + 8);
    const int lo = args.ph_lo, hi = args.ph_hi;
#define IN(k) (lo <= (k) && (k) < hi)
#define SEAM(k) do { if (IN(k) && IN((k) + 1)) xcd_barrier(bar); } while (0)
#define FRESH() int tid_ = threadIdx.x; asm volatile("" : "+v"(tid_)); const int lane_ = tid_ & 63, wave_ = __builtin_amdgcn_readfirstlane(tid_ >> 6), gw_ = vcu * NWAVES + wave_; (void)lane_; (void)wave_; (void)gw_

    if (IN(0)) { FRESH(); p0_convert(P, lds, gw_, NGW, wave_, lane_); norm_first(P.x, P.gains, XN, ws + WS_XN8, gw_, NGW, lane_); }
    SEAM(0);
    for (int layer = 0; layer < 2; ++layer) {
        const int pb = layer == 0 ? 1 : 10;
        const float* gl = P.gains + (size_t)layer * 4 * DM;
        if (IN(pb + 0)) {
            const bool conv_first = layer == 0 && ((bx >> 3) & 1) != 0, conv_last = layer == 0 && ((bx >> 3) & 1) == 0;
            if (conv_first) { FRESH(); conv_share_a(P, lds, gw_, NGW, wave_, lane_); __syncthreads(); }
            { pg8::Gemm g{XN, (const bf16*)(ws + WS_WIN) + (size_t)layer * INW * DM + (size_t)ZV * DM, M, ZGA - ZV, DM, 0}; pg8::StaticOrder S; S.init(M, ZGA - ZV, G, bx);
              pg8::EpiZ E{Z, INW, ZV, 1.0f, 1000, 0};
              pg8::gemm_phase<pg8::EpiZ, pg8::StaticOrder, true, true>(lds + RING_OFF, g, S, E); }
            { pg8::Gemm g{(const bf16*)(ws + WS_XN8), (const bf16*)(ws + WS_WIN8) + (size_t)layer * 3584 * DM, M, 7168, DM / 2, 0}; pg8::StaticOrder S; S.init(M, 7168, G, bx);
              pg8::EpiZ E{Z, INW, 0, 1.0f / WSCALE, 12, ZGA - 3072};
              pg8::gemm_phase<pg8::EpiZ, pg8::StaticOrder, true, true, true>(lds + RING_OFF, g, S, E); }
            if (QW > 0 && bx >= 128) { FRESH(); conv_quota(P, lds, layer ? 2 : 0, bx, wave_, lane_); }
            if (conv_last) { FRESH(); conv_share_a(P, lds, gw_, NGW, wave_, lane_); }
        }
        SEAM(pb + 0);
        if (IN(pb + 1)) { FRESH(); attn_phase(Z, P.relb, OG, LSE, lds, G, tid_, wave_, lane_); }
        SEAM(pb + 1);
        if (IN(pb + 2)) { FRESH(); combine_pool_phase(Z, OG, LSE, (const bf16*)(ws + WS_WPOOL) + (size_t)layer * 4 * 128 * 128, P.pscale + (size_t)layer * 512, OA, OP, gw_, NGW, lane_); }
        SEAM(pb + 2);
        if (IN(pb + 3)) {
            { pg8::Gemm g{OA, (const bf16*)(ws + WS_WAO) + (size_t)layer * DM * 512, M, DM, 512}; pg8::StaticOrder S; S.init(M, DM, G, bx);
              pg8::EpiGate<0> E{Z + ZGA, INW, nullptr, TB, DM};
              pg8::gemm_phase<pg8::EpiGate<0>, pg8::StaticOrder, true, true>(lds + RING_OFF, g, S, E); }
            { pg8::Gemm g{OP, (const bf16*)(ws + WS_WPO) + (size_t)layer * DM * 512, M, DM, 512}; pg8::StaticOrder S; S.init(M, DM, G, bx);
              pg8::EpiGate<1> E{Z + ZGB, INW, TB, MRG, DM};
              pg8::gemm_phase<pg8::EpiGate<1>, pg8::StaticOrder, true, true>(lds + RING_OFF, g, S, E); }
        }
        SEAM(pb + 3);
        if (IN(pb + 4)) {
            pg8::Gemm g{MRG, (const bf16*)(ws + WS_WOUT) + (size_t)layer * DM * DM, M, DM, DM}; pg8::StaticOrder S; S.init(M, DM, G, bx);
            pg8::EpiZ E{MIXb, DM, 0, 1.0f, 1000, 0};
            const bool conv_first = layer == 1 && ((bx >> 3) & 1) != 0, conv_last = layer == 1 && ((bx >> 3) & 1) == 0;
            if (conv_first) { FRESH(); conv_share_gu(P, lds, gw_, NGW, wave_, lane_); __syncthreads(); }
            pg8::gemm_phase<pg8::EpiZ, pg8::StaticOrder, true, true>(lds + RING_OFF, g, S, E);
            if (conv_last) { FRESH(); conv_share_gu(P, lds, gw_, NGW, wave_, lane_); }
        }
        SEAM(pb + 4);
        if (IN(pb + 5)) {
            FRESH();
            if (layer == 0) norm_mid<false, false>(MIXb, P.x, HB, gl + DM, gl + 2 * DM, nullptr, ws + WS_XN8, nullptr, ctl, toke, tokp, tokw, nullptr, gw_, NGW, lane_);
            else {
                LAS float* wrl = (LAS float*)(lds + RING_OFF);
                { float tmp[32];
#pragma unroll
                  for (int k = 0; k < 32; ++k) tmp[k] = P.wr[tid_ + 512 * k];
                  __builtin_amdgcn_sched_barrier(0);
#pragma unroll
                  for (int k = 0; k < 32; ++k) { const int i = tid_ + 512 * k; wrl[(i & 7) * DM + (i >> 3)] = tmp[k]; } }
                __syncthreads();
                norm_mid<true, true>(MIXb, HB, HB, gl + DM, gl + 2 * DM, XN, nullptr, wrl, ctl, toke, tokp, tokw, ws + WS_XP, gw_, NGW, lane_);
            }
        }
        SEAM(pb + 5);
        if (layer == 0) {
            if (IN(7)) {
                pg8::Gemm g{(const bf16*)(ws + WS_XN8), (const bf16*)(ws + WS_DGU), M, 2 * DFF, DM / 2}; pg8::StaticOrder S; S.init(M, 2 * DFF, G, bx);
                pg8::EpiSwiGLU E{(bf16*)(ws + WS_HM), DFF, 1.0f / WSCALE};
                pg8::gemm_phase<pg8::EpiSwiGLU, pg8::StaticOrder, true, true, true>(lds + RING_OFF, g, S, E);
                if (QW > 0 && bx >= 128) { FRESH(); conv_quota(P, lds, 1, bx, wave_, lane_); }
            }
            SEAM(7);
            if (IN(8)) {
                pg8::Gemm g{(const bf16*)(ws + WS_HM), (const bf16*)(ws + WS_DD), M, DM, DFF}; pg8::StaticOrder S; S.init(M, DM, G, bx);
                pg8::EpiZ E{MIXb, DM, 0, 1.0f, 1000, 0};
                const bool conv_first = ((bx >> 3) & 1) != 0;
                pg8::gemm_phase<pg8::EpiZ, pg8::StaticOrder, true, true>(lds + RING_OFF, g, S, E);
            }
            SEAM(8);
            if (IN(9)) { FRESH(); norm_mid<false, true>(MIXb, HB, HB, P.gains + 3 * DM, P.gains + 4 * DM, XN, ws + WS_XN8, nullptr, ctl, toke, tokp, tokw, nullptr, gw_, NGW, lane_); }
            SEAM(9);
        } else {
            unsigned char* Xp = ws + WS_XP; unsigned char* HMp = ws + WS_HMP; bf16* Yp = (bf16*)(ws + WS_YP);
            if (IN(16)) { FRESH(); moe_tables(ctl, tab, tid_); }
            if (IN(17)) {
                if (MK_SPLIT) moe_tables(ctl, tab, tid);
                pg8::Gemm g{(const bf16*)Xp, (const bf16*)(ws + WS_MGU), MPAD, 2 * EFF, DM / 2}; pg8::MoeOrder S{__builtin_amdgcn_readfirstlane(tab[96]), (2 * EFF) / 256, G, bx, tab, XCAP / 256, 0, (2 * EFF) / 256, 0};
                pg8::EpiSwiGLU8 E{HMp, EFF, 1.0f / WSCALE};
                const int cut = 2 * ((bx >> 3) & 7);
#pragma unroll 1
                for (int part = 0; part < 2; ++part) {
                    pg8::SubOrder<pg8::MoeOrder> S2{S, part ? cut : 0, part ? (1 << 30) : cut};
                    pg8::gemm_phase<pg8::EpiSwiGLU8, pg8::SubOrder<pg8::MoeOrder>, true, true, true>(lds + RING_OFF, g, S2, E);
                    if (part == 0) { FRESH(); __syncthreads(); conv_share_down(P, lds, gw_, NGW, wave_, lane_); __syncthreads(); }
                }
            }
            SEAM(17);
            if (IN(18)) {
                if (MK_SPLIT) moe_tables(ctl, tab, tid);
                const int Pall = __builtin_amdgcn_readfirstlane(tab[96]), Pmain = Pall & ~31;
                pg8::EpiYp E{Yp, DM, 1.0f / WSCALE, (bf16*)(ws + WS_YT), Pmain};
                { pg8::Gemm g{(const bf16*)HMp, (const bf16*)(ws + WS_MD), MPAD, DM, EFF / 2, 0}; pg8::MoeOrder S{Pmain, DM / 256, G, bx, tab, 0, 0, DM / 256, 0};
                  pg8::gemm_phase<pg8::EpiYp, pg8::MoeOrder, true, true, true>(lds + RING_OFF, g, S, E); }
                if (Pall > Pmain) {
                  pg8::Gemm g{(const bf16*)HMp, (const bf16*)(ws + WS_MD), MPAD, DM, EFF / 8, EFF / 2}; pg8::MoeOrder S{Pall - Pmain, 4 * (DM / 256), G, bx, tab, 0, Pmain, DM / 256, EFF / 4};
                  pg8::gemm_phase<pg8::EpiYp, pg8::MoeOrder, true, true, true>(lds + RING_OFF, g, S, E); }
            }
            SEAM(18);
            if (IN(19)) {
                FRESH();
                if (MK_SPLIT) moe_tables(ctl, tab, tid_);
                norm_final(Yp, (const bf16*)(ws + WS_YT), P.gains + (size_t)(4 + 3) * DM, HB, P.out, toke, tokp, tokw, tab, gw_, NGW, lane_);
            }
        }
    }
#undef IN
#undef SEAM
}

extern "C" void kernel_launch(void* const* d_in, const int* in_sizes, int n_in, void* d_out, int out_size, void* d_ws, size_t ws_size, hipStream_t stream) {
    static int grid = 0;
    if (grid == 0) {
        if (n_in != 16 || out_size != M * DM || ws_size < WS_END) { fprintf(stderr, "kernel_launch: unexpected shapes (n_in %d out %d ws %zu, need %zu)\n", n_in, out_size, ws_size, (size_t)WS_END); grid = -1; return; }
        int dev = 0, cus = 0, per_cu = 0;
        if (hipGetDevice(&dev) != hipSuccess || hipDeviceGetAttribute(&cus, hipDeviceAttributeMultiprocessorCount, dev) != hipSuccess) { grid = -1; return; }
        if (hipFuncSetAttribute((const void*)mk_fwd, hipFuncAttributeMaxDynamicSharedMemorySize, LDS_BYTES) != hipSuccess) { fprintf(stderr, "kernel_launch: hipFuncSetAttribute failed\n"); grid = -1; return; }
        if (hipOccupancyMaxActiveBlocksPerMultiprocessor(&per_cu, (const void*)mk_fwd, NWAVES * 64, LDS_BYTES) != hipSuccess || per_cu < 1) { fprintf(stderr, "kernel_launch: occupancy query says %d\n", per_cu); }
        (void)hipGetLastError();
        if (cus < 256) { fprintf(stderr, "kernel_launch: built for a 256-CU device (got %d CUs)\n", cus); grid = -1; return; }
        grid = 256;
    }
    if (grid < 0) return;
    if (hipMemsetAsync((char*)d_ws + WS_CTL, 0, CTL_ZERO_BYTES, stream) != hipSuccess) return;
    Args a{};
    for (int i = 0; i < 16; ++i) a.in[i] = (const float*)d_in[i];
    a.out = (float*)d_out; a.ws = (unsigned char*)d_ws;
#if MK_SPLIT
    for (int ph = 0; ph < NPH; ++ph) { a.ph_lo = ph; a.ph_hi = ph + 1; hipLaunchKernelGGL(mk_fwd, dim3(grid), dim3(NWAVES * 64), LDS_BYTES, stream, a); }
#else
    a.ph_lo = 0; a.ph_hi = NPH;
    hipLaunchKernelGGL(mk_fwd, dim3(grid), dim3(NWAVES * 64), LDS_BYTES, stream, a);
#endif
    const hipError_t le = hipPeekAtLastError();
    if (le != hipSuccess) fprintf(stderr, "kernel_launch: launch failed: %s\n", hipGetErrorName(le));
}
```
